# Optimizing an MI355X kernel written in HIP

```python
import jax, jax.numpy as jnp
from jax import lax
import numpy as np

D_MODEL = 1024
BATCH = 8
SEQ = 4096
DEPTH = 1

N_META = 16
CONV_DIM = 512
CONV_WIDTH = 31
N_HEADS = 8
QK_NOPE_DIM = 64
QK_ROPE_DIM = 32
QK_HEAD_DIM = QK_NOPE_DIM + QK_ROPE_DIM
V_HEAD_DIM = 64
Q_LORA_RANK = 256
KV_LORA_RANK = 128
ROPE_THETA = 10000.0
Q_BLOCK = 128
N_BRANCHES = 2
N_EXPERTS = 32
TOP_K = 4
D_FF = 1024
SWIGLU_LIMIT = 7.0
SWIGLU_ALPHA = 1.702
MOE_BLOCK = 256
NORM_EPS = 1e-6
NEG_INF = -1e30

COLS_CONV = 2 * CONV_DIM
COLS_Q = Q_LORA_RANK
COLS_KV = KV_LORA_RANK + QK_ROPE_DIM
COLS_GATE = N_BRANCHES * D_MODEL
IN_COLS = COLS_CONV + COLS_Q + COLS_KV + COLS_GATE
SPLITS = (COLS_CONV, COLS_CONV + COLS_Q, COLS_CONV + COLS_Q + COLS_KV)

kernel_name = 'hybrid_meta_conv_mla_moe_layer'


def rms_norm(x, w):
    xf = x.astype(jnp.float32)
    y = xf * lax.rsqrt(jnp.mean(xf * xf, axis=-1, keepdims=True) + NORM_EPS)
    return (y * w.astype(jnp.float32)).astype(x.dtype)


def layer_norm(x, w, b):
    xf = x.astype(jnp.float32)
    mu = jnp.mean(xf, axis=-1, keepdims=True)
    xc = xf - mu
    y = xc * lax.rsqrt(jnp.mean(xc * xc, axis=-1, keepdims=True) + NORM_EPS)
    return (y * w.astype(jnp.float32) + b.astype(jnp.float32)).astype(x.dtype)


def apply_rope(x, pos):
    half = QK_ROPE_DIM // 2
    inv_freq = ROPE_THETA ** (-jnp.arange(half, dtype=jnp.float32) / half)
    ang = pos.astype(jnp.float32)[:, None] * inv_freq[None, :]
    cos = jnp.cos(ang)[:, None, :]
    sin = jnp.sin(ang)[:, None, :]
    xf = x.astype(jnp.float32)
    x1, x2 = xf[..., :half], xf[..., half:]
    return jnp.concatenate([x1 * cos - x2 * sin, x2 * cos + x1 * sin], axis=-1).astype(x.dtype)


def conformer_conv(u, dw_w, dw_b, ln_w, ln_b, w_pw2):
    a, g = u[..., :CONV_DIM], u[..., CONV_DIM:]
    h = a * jax.nn.sigmoid(g)
    h = lax.conv_general_dilated(
        h, dw_w[:, None, :].astype(h.dtype), window_strides=(1,),
        padding=[(CONV_WIDTH - 1, 0)], dimension_numbers=('NWC', 'WIO', 'NWC'),
        feature_group_count=CONV_DIM) + dw_b
    h = jax.nn.silu(layer_norm(h, ln_w, ln_b))
    return h @ w_pw2


def _attend(qb, qpos, k, v):
    s = jnp.einsum('bhqd,bhkd->bhqk', qb, k).astype(jnp.float32) * (QK_HEAD_DIM ** -0.5)
    kpos = jnp.arange(k.shape[2])
    s = jnp.where(kpos[None, :] <= qpos[:, None], s, NEG_INF)
    p = jax.nn.softmax(s, axis=-1).astype(v.dtype)
    return jnp.einsum('bhqk,bhkd->bhqd', p, v)


def causal_block_attention(q, k, v):
    B, H, L, dh = q.shape
    n_real = L - N_META
    nb = n_real // Q_BLOCK
    o_meta = _attend(q[:, :, :N_META], jnp.arange(N_META), k[:, :, :N_META], v[:, :, :N_META])
    q_blocks = q[:, :, N_META:].reshape(B, H, nb, Q_BLOCK, dh).transpose(2, 0, 1, 3, 4)
    pos_blocks = (N_META + jnp.arange(n_real)).reshape(nb, Q_BLOCK)
    o_real = lax.map(lambda a: _attend(a[0], a[1], k, v), (q_blocks, pos_blocks))
    o_real = o_real.transpose(1, 2, 0, 3, 4).reshape(B, H, n_real, V_HEAD_DIM)
    return jnp.concatenate([o_meta, o_real], axis=2)


def mla(q_lat, kv_lat, pos, q_a_norm_w, w_q_b, kv_a_norm_w, w_kv_b, q_norm_w, k_norm_w, w_o):
    B, L, _ = q_lat.shape
    q = (rms_norm(q_lat, q_a_norm_w) @ w_q_b).reshape(B, L, N_HEADS, QK_HEAD_DIM)
    c_kv, k_pe = kv_lat[..., :KV_LORA_RANK], kv_lat[..., KV_LORA_RANK:]
    kv = (rms_norm(c_kv, kv_a_norm_w) @ w_kv_b).reshape(B, L, N_HEADS, QK_NOPE_DIM + V_HEAD_DIM)
    k_nope, v = kv[..., :QK_NOPE_DIM], kv[..., QK_NOPE_DIM:]
    k_pe = jnp.broadcast_to(k_pe[:, :, None, :], (B, L, N_HEADS, QK_ROPE_DIM))
    k = jnp.concatenate([k_nope, k_pe], axis=-1)
    q = rms_norm(q, q_norm_w)
    k = rms_norm(k, k_norm_w)
    q = jnp.concatenate([q[..., :QK_NOPE_DIM], apply_rope(q[..., QK_NOPE_DIM:], pos)], axis=-1)
    k = jnp.concatenate([k[..., :QK_NOPE_DIM], apply_rope(k[..., QK_NOPE_DIM:], pos)], axis=-1)
    o = causal_block_attention(q.transpose(0, 2, 1, 3), k.transpose(0, 2, 1, 3), v.transpose(0, 2, 1, 3))
    o = o.transpose(0, 2, 1, 3).reshape(B, L, N_HEADS * V_HEAD_DIM)
    return o @ w_o


def moe(h, router_w, router_b, w_gate_up, b_gate_up, w_down, b_down):
    B, L, D = h.shape
    xt = h.reshape(-1, D)
    N = xt.shape[0]
    S = N * TOP_K
    logits = (xt @ router_w + router_b).astype(jnp.float32)
    top_val, top_idx = lax.top_k(logits, TOP_K)
    gates = jax.nn.softmax(top_val, axis=-1).astype(h.dtype)
    flat_e = top_idx.reshape(-1)
    order = jnp.argsort(flat_e)
    sorted_e = flat_e[order]
    counts = jnp.bincount(flat_e, length=N_EXPERTS)
    group_start = jnp.cumsum(counts) - counts
    padded = (counts + MOE_BLOCK - 1) // MOE_BLOCK * MOE_BLOCK
    padded_end = jnp.cumsum(padded)
    padded_start = padded_end - padded
    dest = (padded_start[sorted_e] + jnp.arange(S) - group_start[sorted_e]).astype(jnp.int32)
    n_blocks = S // MOE_BLOCK + N_EXPERTS + 1
    P = n_blocks * MOE_BLOCK
    row_token = jnp.zeros((P,), jnp.int32).at[dest].set((order // TOP_K).astype(jnp.int32))
    row_w = jnp.zeros((P,), h.dtype).at[dest].set(gates.reshape(-1)[order])
    block_expert = jnp.minimum(
        jnp.searchsorted(padded_end, jnp.arange(n_blocks) * MOE_BLOCK, side='right'), N_EXPERTS - 1)
    xs = xt[row_token].reshape(n_blocks, MOE_BLOCK, D)
    ws = row_w.reshape(n_blocks, MOE_BLOCK)

    def expert_block(args):
        xb, wb, e = args
        gu = xb @ w_gate_up[e] + b_gate_up[e]
        g, u = gu[:, :D_FF], gu[:, D_FF:]
        g = jnp.minimum(g, SWIGLU_LIMIT)
        u = jnp.clip(u, -SWIGLU_LIMIT, SWIGLU_LIMIT)
        act = (u + 1) * (g * jax.nn.sigmoid(SWIGLU_ALPHA * g))
        return (act @ w_down[e] + b_down[e]) * wb[:, None]

    ys = lax.map(expert_block, (xs, ws, block_expert)).reshape(P, D)
    y = jax.ops.segment_sum(ys, row_token, num_segments=N)
    return y.reshape(B, L, D)


def setup_inputs(seed: int = 0) -> dict:
    key = jax.random.key(seed)
    ks = jax.random.split(key, 32)
    f32 = jnp.float32

    def w(k, shape, fan_in):
        return jax.random.normal(k, shape, f32) * (fan_in ** -0.5)

    def gain(k, shape):
        return 1.0 + 0.02 * jax.random.normal(k, shape, f32)

    def bias(k, shape, s=0.02):
        return s * jax.random.normal(k, shape, f32)

    Dp = DEPTH
    return {
        'x': jax.random.normal(ks[0], (BATCH, SEQ, D_MODEL), f32),
        'meta_tokens': jax.random.normal(ks[1], (N_META, D_MODEL), f32),
        'attn_norm_w': gain(ks[2], (Dp, D_MODEL)),
        'w_in': w(ks[3], (Dp, D_MODEL, IN_COLS), D_MODEL),
        'conv_dw_w': w(ks[4], (Dp, CONV_WIDTH, CONV_DIM), CONV_WIDTH),
        'conv_dw_b': bias(ks[5], (Dp, CONV_DIM)),
        'conv_ln_w': gain(ks[6], (Dp, CONV_DIM)),
        'conv_ln_b': bias(ks[7], (Dp, CONV_DIM)),
        'conv_pw2_w': w(ks[8], (Dp, CONV_DIM, D_MODEL), CONV_DIM),
        'q_a_norm_w': gain(ks[9], (Dp, Q_LORA_RANK)),
        'w_q_b': w(ks[10], (Dp, Q_LORA_RANK, N_HEADS * QK_HEAD_DIM), Q_LORA_RANK),
        'kv_a_norm_w': gain(ks[11], (Dp, KV_LORA_RANK)),
        'w_kv_b': w(ks[12], (Dp, KV_LORA_RANK, N_HEADS * (QK_NOPE_DIM + V_HEAD_DIM)), KV_LORA_RANK),
        'q_norm_w': gain(ks[13], (Dp, QK_HEAD_DIM)),
        'k_norm_w': gain(ks[14], (Dp, QK_HEAD_DIM)),
        'w_o_mla': w(ks[15], (Dp, N_HEADS * V_HEAD_DIM, D_MODEL), N_HEADS * V_HEAD_DIM),
        'gate_b': bias(ks[16], (Dp, COLS_GATE)),
        'w_out': w(ks[17], (Dp, D_MODEL, D_MODEL), D_MODEL),
        'ffn_norm_w': gain(ks[18], (Dp, D_MODEL)),
        'router_w': w(ks[19], (Dp, D_MODEL, N_EXPERTS), D_MODEL),
        'router_b': bias(ks[20], (Dp, N_EXPERTS), 0.01),
        'w_gate_up': w(ks[21], (Dp, N_EXPERTS, D_MODEL, 2 * D_FF), D_MODEL),
        'b_gate_up': bias(ks[22], (Dp, N_EXPERTS, 2 * D_FF)),
        'w_down': w(ks[23], (Dp, N_EXPERTS, D_FF, D_MODEL), D_FF),
        'b_down': bias(ks[24], (Dp, N_EXPERTS, D_MODEL)),
    }


def reference(x, meta_tokens, attn_norm_w, w_in, conv_dw_w, conv_dw_b, conv_ln_w, conv_ln_b,
              conv_pw2_w, q_a_norm_w, w_q_b, kv_a_norm_w, w_kv_b, q_norm_w, k_norm_w, w_o_mla,
              gate_b, w_out, ffn_norm_w, router_w, router_b, w_gate_up, b_gate_up, w_down, b_down):
    B = x.shape[0]
    meta = jnp.broadcast_to(meta_tokens[None].astype(x.dtype), (B, N_META, D_MODEL))
    h = jnp.concatenate([meta, x], axis=1)
    L = h.shape[1]
    pos = jnp.arange(L)
    for l in range(DEPTH):
        hn = rms_norm(h, attn_norm_w[l])
        proj = hn @ w_in[l]
        u_conv, q_lat, kv_lat, g_lin = jnp.split(proj, SPLITS, axis=-1)
        y_conv = conformer_conv(u_conv, conv_dw_w[l], conv_dw_b[l], conv_ln_w[l], conv_ln_b[l], conv_pw2_w[l])
        y_mla = mla(q_lat, kv_lat, pos, q_a_norm_w[l], w_q_b[l], kv_a_norm_w[l], w_kv_b[l],
                    q_norm_w[l], k_norm_w[l], w_o_mla[l])
        g = jax.nn.sigmoid(g_lin + gate_b[l]).reshape(B, L, N_BRANCHES, D_MODEL)
        mixed = g[:, :, 0] * y_conv + g[:, :, 1] * y_mla
        h = h + mixed @ w_out[l]
        h = h + moe(rms_norm(h, ffn_norm_w[l]), router_w[l], router_b[l], w_gate_up[l], b_gate_up[l],
                    w_down[l], b_down[l])
    return h[:, N_META:]
```

```cpp
#include <hip/hip_runtime.h>
#include <cstdio>
#include <cstdint>

#define GAS __attribute__((address_space(1)))
#define LAS __attribute__((address_space(3)))
typedef unsigned short bf16;
typedef unsigned u32x4 __attribute__((ext_vector_type(4)));
typedef unsigned u32x2 __attribute__((ext_vector_type(2)));
typedef float f32x2 __attribute__((ext_vector_type(2)));
typedef float f32x4 __attribute__((ext_vector_type(4)));
typedef float f32x16 __attribute__((ext_vector_type(16)));
typedef short bf16x8 __attribute__((ext_vector_type(8)));
typedef short s16x4 __attribute__((ext_vector_type(4)));
typedef int i32x4 __attribute__((ext_vector_type(4)));
typedef int i32x8 __attribute__((ext_vector_type(8)));
typedef GAS unsigned gu32;

#ifndef PROBE_REPEAT
#define PROBE_REPEAT (-1)
#endif
#ifndef INPROJ_FP8
#define INPROJ_FP8 1
#endif
#ifndef PROBE_KLOOP2
#define PROBE_KLOOP2 0
#endif
#ifndef USE_REFRESH
#define USE_REFRESH 0
#endif
#ifndef RELAX_WAITS
#define RELAX_WAITS 0
#endif
#ifndef PROBE_EPI2
#define PROBE_EPI2 0
#endif
#ifndef PROBE_P2A
#define PROBE_P2A 0
#endif
#ifndef PROBE_P2B
#define PROBE_P2B 0
#endif
#ifndef MK_ONE_LAUNCH
#define MK_ONE_LAUNCH 1
#endif

constexpr int NB = 8, SEQ = 4096, DM = 1024, MT = NB * SEQ;
constexpr int NMETA = 16;
constexpr int CDIM = 512, CWID = 31;
constexpr int NH = 8, DNOPE = 64, DROPE = 32, DQK = 96, DV = 64, QLR = 256, KVLR = 128;
constexpr int INC = 3488, NINP = 3584;
constexpr int NE = 32, DFF = 1024, ECAP = 32768;
constexpr int LPC = 4128, HGOFF = 32;
constexpr int LPK = 4160, KOFF = 64;
constexpr int PMC = 1184;
constexpr float NORM_EPS = 1e-6f;
constexpr float SW_LIMIT = 7.0f, SW_ALPHA = 1.702f;
constexpr float QSCALE = 0.10206207261596577f * 1.4426950408889634f;
constexpr int NPH = 12;

constexpr size_t MiB = 1u << 20;
constexpr size_t WS_CTL = 0, CTL_ZERO_BYTES = 1 * MiB;
constexpr int CW_TMO = 0, CW_CODE = 1, CW_BAR = 4096, CW_CNT = 8192, CW_PM = 16384;
constexpr size_t WS_METARS = 1 * MiB;
constexpr size_t WS_KVMETA = 1 * MiB + 4096;
constexpr size_t WS_ROPE = 1 * MiB + 512 * 1024;
constexpr size_t WS_RSQ = 156 * MiB, WS_RSC = 157 * MiB;
constexpr size_t WS_KPESS = 2 * MiB + 384 * 1024;
constexpr size_t WS_RWP = 2 * MiB + 512 * 1024;
constexpr size_t WS_RW3 = 2 * MiB + 768 * 1024;
constexpr size_t WS_TOKPOS = 3 * MiB;
constexpr size_t WS_LTOK = 4 * MiB, WS_LW = 8 * MiB, WS_LRS = 12 * MiB;
constexpr size_t WS_WIN = 16 * MiB, WS_WPW2 = 23 * MiB, WS_WQB = 24 * MiB, WS_WKVB = 24 * MiB + 512 * 1024, WS_WO = 25 * MiB, WS_WOUT = 26 * MiB;
constexpr size_t WS_WGU = 28 * MiB, WS_WD = 92 * MiB;
constexpr size_t WS_XQ = 124 * MiB;
constexpr float XQ_SCALE = 16.f;
constexpr size_t WS_H1Q = 124 * MiB;
constexpr size_t WS_W2T = 220 * MiB, WS_H1B = 348 * MiB;
constexpr size_t WS_BIG = 412 * MiB;
constexpr size_t WS_ACT = WS_BIG, WS_Y = WS_BIG + 273 * MiB;
constexpr size_t WS_XN = WS_BIG + 289 * MiB, WS_QF = WS_BIG;
constexpr size_t WS_RSX = 2 * MiB + 640 * 1024;
constexpr size_t WS_G = WS_BIG + 64 * MiB, WS_HG = WS_BIG + 192 * MiB, WS_MIX = WS_BIG + 192 * MiB;
constexpr size_t WS_QLAT = WS_BIG + 225 * MiB, WS_KVLAT = WS_BIG + 241 * MiB, WS_HC = WS_BIG + 257 * MiB;
constexpr size_t WS_QRAW = WS_BIG + 289 * MiB, WS_KVRAW = WS_BIG + 353 * MiB, WS_HCO = WS_BIG + 418 * MiB, WS_KF = WS_BIG + 482 * MiB;
constexpr size_t WS_PMP = WS_BIG + 564 * MiB, WS_PMF = WS_BIG + 565 * MiB;
constexpr size_t WS_END = WS_BIG + 566 * MiB;
static_assert(WS_Y + (size_t)139520 * 2048 <= WS_END && WS_HG + (size_t)NB * LPC * CDIM * 2 <= WS_QLAT && WS_KVRAW + (size_t)NB * LPK * 2048 <= WS_HCO && WS_KF + (size_t)NB * LPK * 1536 <= WS_BIG + 531 * MiB, "ws map");

constexpr int RING_BYTES = 131072;
constexpr int LDSCTL_OFF = RING_BYTES;
constexpr int LDS_BYTES = 147456;

#define RLX_AGENT __ATOMIC_RELAXED, __HIP_MEMORY_SCOPE_AGENT
#define LDS_WAIT() asm volatile("s_waitcnt lgkmcnt(0)" ::: "memory")
#define VM_WAIT() asm volatile("s_waitcnt vmcnt(0)" ::: "memory")
__device__ __forceinline__ unsigned f2bf(float f) { unsigned u = __builtin_bit_cast(unsigned, f); return (u + 0x7fffu + ((u >> 16) & 1u)) >> 16; }
typedef __bf16 hwbf16x2 __attribute__((ext_vector_type(2)));
__device__ __forceinline__ unsigned pk2(float lo, float hi) { const f32x2 v = {lo, hi}; return __builtin_bit_cast(unsigned, __builtin_convertvector(v, hwbf16x2)); }
__device__ __forceinline__ float bflo(unsigned w) { return __builtin_bit_cast(float, w << 16); }
__device__ __forceinline__ float bfhi(unsigned w) { return __builtin_bit_cast(float, w & 0xffff0000u); }
constexpr float Y8_SCALE = 8.f, Y8_INV = 1.f / 8.f;
constexpr float W8_SCALE = 64.f, W8_INV = 1.f / 64.f;
__device__ __forceinline__ unsigned pk4_fp8(float a, float b, float c, float d) { int v = __builtin_amdgcn_cvt_pk_fp8_f32(a, b, 0, false); v = __builtin_amdgcn_cvt_pk_fp8_f32(c, d, v, true); return (unsigned)v; }
__device__ __forceinline__ float sigmoid_f(float x) { return __builtin_amdgcn_rcpf(1.f + __expf(-x)); }
__device__ __forceinline__ float sum16(float v) {
#pragma unroll
    for (int o = 1; o < 16; o <<= 1) v += __shfl_xor(v, o);
    return v;
}
__device__ __forceinline__ float wave_sum(float v) {
#pragma unroll
    for (int o = 1; o < 64; o <<= 1) v += __shfl_xor(v, o);
    return v;
}

#define XB_TMO      128
#define XB_XCNT(j)  (256  + 64 * (j))
#define XB_XSUB(j)  (1280 + 64 * (j))
#define XB_XGEN(j)  (2304 + 64 * (j))
#define XB_TOP      3328
#define XB_TOPGEN   3392
#define XCD_BAR_WORDS 3456
#define XB_SPIN_CAP (1u << 18)
__device__ __forceinline__ unsigned xb_ld(unsigned* p)              { return __hip_atomic_load(p, __ATOMIC_RELAXED, __HIP_MEMORY_SCOPE_AGENT); }
__device__ __forceinline__ unsigned xb_add(unsigned* p, unsigned v) { return __hip_atomic_fetch_add(p, v, __ATOMIC_RELAXED, __HIP_MEMORY_SCOPE_AGENT); }
__device__ __forceinline__ unsigned xb_xcc_id() { return (unsigned)__builtin_amdgcn_s_getreg((3 << 11) | 20) & 0xFu; }
#define XB_SPIN(cond, bar) do { unsigned _sp = 0; while (cond) { __builtin_amdgcn_s_sleep(1); \
    if ((++_sp & 255u) == 0u) { if (xb_ld(&(bar)[XB_TMO])) break; if (_sp > XB_SPIN_CAP) { atomicAdd(&(bar)[XB_TMO], 1u); break; } } } } while (0)
struct XcdBarrier { unsigned* bar; unsigned x; volatile LAS unsigned* st; };
__device__ __forceinline__ XcdBarrier xcd_barrier_post(unsigned* bar, volatile LAS unsigned* st) {
    XcdBarrier b; b.bar = bar; b.x = xb_xcc_id(); b.st = st;
    if (threadIdx.x == 0) (void)xb_add(&bar[XB_XCNT(b.x)], 1u);
    return b;
}
__device__ __forceinline__ void xcd_barrier_complete(unsigned* bar, unsigned x, unsigned& nloc, unsigned& nx) {
    const unsigned G = gridDim.x * gridDim.y * gridDim.z;
    unsigned sum, cnt, mine, sp = 0u;
    for (;;) {
        sum = 0u; cnt = 0u; mine = 0u;
#pragma unroll
        for (unsigned j = 0; j < 16; ++j) { const unsigned c = xb_ld(&bar[XB_XCNT(j)]); sum += c; cnt += (c > 0u) ? 1u : 0u; mine = (j == x) ? c : mine; }
        if (sum == G) break;
        __builtin_amdgcn_s_sleep(1);
        if ((++sp & 255u) == 0u) { if (xb_ld(&bar[XB_TMO])) break; if (sp > XB_SPIN_CAP) { atomicAdd(&bar[XB_TMO], 1u); break; } }
    }
    nloc = mine > 0u ? mine : 1u; nx = cnt > 0u ? cnt : 1u;
}
__device__ __forceinline__ void xcd_barrier(const XcdBarrier& b) {
    asm volatile("s_waitcnt vmcnt(0)" ::: "memory");
    __syncthreads();
    if (threadIdx.x == 0) {
        unsigned* bar = b.bar;
        __builtin_amdgcn_s_waitcnt(0);
        unsigned nloc = b.st[0], nx = b.st[1];
        if (nloc == 0u) { xcd_barrier_complete(bar, b.x, nloc, nx); b.st[0] = nloc; b.st[1] = nx; }
        const unsigned old = xb_add(&bar[XB_XSUB(b.x)], 1u);
        const unsigned gen = old / nloc;
        if (old + 1u == (gen + 1u) * nloc) {
            __builtin_amdgcn_fence(__ATOMIC_RELEASE, "agent");
            asm volatile("s_waitcnt vmcnt(0)" ::: "memory");
            const unsigned og = xb_add(&bar[XB_TOP], 1u);
            const unsigned tg = og / nx;
            if (og + 1u == (tg + 1u) * nx) xb_add(&bar[XB_TOPGEN], 1u);
            else XB_SPIN(xb_ld(&bar[XB_TOPGEN]) == tg, bar);
            xb_add(&bar[XB_XGEN(b.x)], 1u);
            __builtin_amdgcn_fence(__ATOMIC_ACQUIRE, "agent");
            asm volatile("s_waitcnt vmcnt(0)" ::: "memory");
        } else {
            XB_SPIN(xb_ld(&bar[XB_XGEN(b.x)]) == gen, bar);
            __builtin_amdgcn_fence(__ATOMIC_ACQUIRE, "agent");
            asm volatile("s_waitcnt vmcnt(0)" ::: "memory");
        }
    }
    __syncthreads();
}

namespace pg8 {
constexpr int BM = 256, BK = 64, HALF = 128, HTB = HALF * BK * 2, NXCD = 8, WGM = 8;
__host__ __device__ __forceinline__ int lds_byte(int r, int c) { const int st = (r >> 4) * 2 + (c >> 5), rr = r & 15, cc = c & 31, ob = rr * 64 + cc * 2; return st * 1024 + (ob ^ (((ob >> 9) & 1) << 5)); }
__host__ __device__ __forceinline__ void stage_rc(int b, int& R, int& C) { const int st = b / 1024, sb = b % 1024, swz = sb ^ (((sb >> 9) & 1) << 5); R = (st >> 1) * 16 + swz / 64; C = (st & 1) * 32 + (swz % 64) / 2; }
__host__ __device__ __forceinline__ int perm32(int rho) { const int n = rho >> 4, i = rho & 15; return 8 * (i >> 2) + 4 * n + (i & 3); }

struct Unit { int pm, pn, e, cnt; };

struct Dense {
    static constexpr bool GATHER = false;
    const bf16* A; const bf16* Bt; int K; int nM, nN, nwg, G, c;
    __device__ __forceinline__ void init(const bf16* A_, const bf16* Bt_, int M, int N, int K_, int G_, int c_) { A = A_; Bt = Bt_; K = K_; nM = M / BM; nN = N / BM; nwg = nM * nN; G = G_; c = c_; }
    __device__ __forceinline__ bool next(int i, Unit& u) const {
        const long L = (long)i * G + c; if (L >= nwg) return false;
        int wgid = (int)L; { const int q = nwg / NXCD, r = nwg % NXCD, xcd = wgid % NXCD, off = wgid / NXCD; wgid = (xcd < r ? xcd * (q + 1) : r * (q + 1) + (xcd - r) * q) + off; }
        const int nig = WGM * nN, gid = wgid / nig, fm = gid * WGM, gsz = (nM - fm) < WGM ? (nM - fm) : WGM;
        u.pm = fm + ((wgid % nig) % gsz); u.pn = (wgid % nig) / gsz; u.e = 0; u.cnt = 256; return true;
    }
    __device__ __forceinline__ const char* a_base(const Unit& u) const { return (const char*)A + (size_t)u.pm * BM * K * 2; }
    __device__ __forceinline__ const char* b_base(const Unit& u) const { return (const char*)Bt + (size_t)u.pn * BM * K * 2; }
    __device__ __forceinline__ void a_off(const Unit&, const int (&R)[2], const int (&C)[2], unsigned (&vo)[2][2]) const {
#pragma unroll
        for (int h = 0; h < 2; ++h)
#pragma unroll
            for (int i = 0; i < 2; ++i) vo[h][i] = (unsigned)((R[i] + HALF * h) * K + C[i]) * 2u;
    }
};

template <bool GATHER_> struct Moe {
    static constexpr bool GATHER = GATHER_;
    const bf16* A; const bf16* Bt; int K, nN, G, vcu; const int* ltok; const volatile LAS int* tb; const volatile LAS int* cnt;
    __device__ __forceinline__ bool next(int i, Unit& u) const {
        const int L = i * G + vcu; const int TT = __builtin_amdgcn_readfirstlane(tb[NE]); if (L >= TT * nN) return false;
        const int mt = L / nN; u.pn = L - mt * nN;
        const int e = __builtin_amdgcn_readfirstlane(tb[512 + mt]);
        u.e = e; u.pm = mt; const int rem = __builtin_amdgcn_readfirstlane(cnt[e]) - (mt - __builtin_amdgcn_readfirstlane(tb[e])) * BM; u.cnt = rem < BM ? rem : BM; return true;
    }
    __device__ __forceinline__ const char* a_base(const Unit& u) const { return GATHER ? (const char*)A : (const char*)A + (size_t)u.pm * BM * K * 2; }
    __device__ __forceinline__ const char* b_base(const Unit& u) const { return (const char*)Bt + ((size_t)u.e * nN + u.pn) * BM * K * 2; }
    __device__ __forceinline__ const int* idx_src(const Unit& u) const { return ltok + (size_t)u.e * ECAP + (u.pm - __builtin_amdgcn_readfirstlane(tb[u.e])) * BM; }
    __device__ __forceinline__ void a_idx(const Unit& u, const int (&R)[2], int (&tk)[2][2]) const {
        const int slot0 = (u.pm - __builtin_amdgcn_readfirstlane(tb[u.e])) * BM; const int* lt = ltok + (size_t)u.e * ECAP + slot0;
        const unsigned o0 = (unsigned)R[0] * 4u, o1 = (unsigned)R[1] * 4u;
        asm volatile("global_load_dword %0, %4, %6\n\tglobal_load_dword %1, %5, %6\n\tglobal_load_dword %2, %4, %6 offset:512\n\tglobal_load_dword %3, %5, %6 offset:512"
                     : "=&v"(tk[0][0]), "=&v"(tk[0][1]), "=&v"(tk[1][0]), "=&v"(tk[1][1]) : "v"(o0), "v"(o1), "s"(lt) : "memory");
    }
    __device__ __forceinline__ void a_fin(const Unit& u, const int (&R)[2], const int (&C)[2], int (&tk)[2][2], unsigned (&vo)[2][2]) const {
        asm volatile("" : "+v"(tk[0][0]), "+v"(tk[0][1]), "+v"(tk[1][0]), "+v"(tk[1][1]));
#pragma unroll
        for (int h = 0; h < 2; ++h)
#pragma unroll
            for (int i = 0; i < 2; ++i) { const int r = R[i] + HALF * h; const int tok = (r < u.cnt) ? tk[h][i] : 0; vo[h][i] = (unsigned)(tok * K + C[i]) * 2u; }
    }
    __device__ __forceinline__ void a_off(const Unit& u, const int (&R)[2], const int (&C)[2], unsigned (&vo)[2][2]) const {
        if constexpr (GATHER) {
            const int slot0 = (u.pm - __builtin_amdgcn_readfirstlane(tb[u.e])) * BM; const int* lt = ltok + (size_t)u.e * ECAP + slot0; int tk[2][2];
#pragma unroll
            for (int h = 0; h < 2; ++h)
#pragma unroll
                for (int i = 0; i < 2; ++i) tk[h][i] = lt[R[i] + HALF * h];
            asm volatile("" : "+v"(tk[0][0]), "+v"(tk[0][1]), "+v"(tk[1][0]), "+v"(tk[1][1]));
#pragma unroll
            for (int h = 0; h < 2; ++h)
#pragma unroll
                for (int i = 0; i < 2; ++i) { const int r = R[i] + HALF * h; const int tok = (r < u.cnt) ? tk[h][i] : 0; vo[h][i] = (unsigned)(tok * K + C[i]) * 2u; }
        } else {
#pragma unroll
            for (int h = 0; h < 2; ++h)
#pragma unroll
                for (int i = 0; i < 2; ++i) vo[h][i] = (unsigned)((R[i] + HALF * h) * K + C[i]) * 2u;
        }
    }
};

template <class Prob, class Epi, bool FP8 = false, bool ADJ = false>
__device__ __forceinline__ void gemm_phase(LAS unsigned char* lds, const Prob& P, const Epi& E) {
    const int tid = threadIdx.x, wid = __builtin_amdgcn_readfirstlane(tid >> 6), lane = tid & 63, wr = wid >> 2, wc = wid & 3, fr = lane & 15, fq = lane >> 4;
    const int K = P.K, nt = K / BK;
    constexpr bool PRE11 = RELAX_WAITS && !Epi::LDSX;
    int Rr[2], Cc[2]; unsigned voffB[2];
#pragma unroll
    for (int i = 0; i < 2; ++i) { int R, C; stage_rc(tid * 16 + i * 8192, R, C); const int rho = R & 31;
        const int Rb = ADJ ? (64 * (R >> 5) + 16 * ((rho >> 2) & 3) + 4 * (rho >> 4) + (rho & 3)) : ((R & ~31) + perm32(rho)); Rr[i] = R; Cc[i] = C; voffB[i] = (unsigned)(Rb * K + C) * 2u; }
    const size_t kstep = (size_t)(BK * 2);
    const size_t hstep = (size_t)(ADJ ? 8 : HALF) * K * 2;
    const unsigned ldsw = (unsigned)wid * 1024u;
    const int aoff = lds_byte(wr * 64 + fr, fq * 8), boff = lds_byte(wc * 32 + fr, fq * 8);
#define PG8_SA(b, h) (((b) * 2 + (h)) * HTB)
#define PG8_SB(b, h) ((4 + (b) * 2 + (h)) * HTB)
#define PG8_STAGE(bufoff, gbase, voff) do { const char* _g = (const char*)(gbase); asm volatile("" : "+s"(_g));     \
        _Pragma("unroll") for (int _i = 0; _i < 2; ++_i) \
        __builtin_amdgcn_global_load_lds((const unsigned*)(_g + (voff)[_i]), (LAS unsigned*)(lds + (bufoff) + ldsw + _i * 8192), 16, 0, 0); } while (0)
#define PG8_LD8(addr) __builtin_shufflevector(*(const LAS i32x4*)(addr), *(const LAS i32x4*)((addr) + 1024), 0, 1, 2, 3, 4, 5, 6, 7)
#define PG8_LDA(dst, b, h) do { _Pragma("unroll") for (int m = 0; m < 4; ++m) dst[m] = PG8_LD8(lds + PG8_SA(b, h) + aoff + m * 2048); } while (0)
#define PG8_LDB(dst, b, h) do { _Pragma("unroll") for (int n = 0; n < 2; ++n) dst[n] = PG8_LD8(lds + PG8_SB(b, h) + boff + n * 2048); } while (0)
#define PG8_LO(x) __builtin_bit_cast(bf16x8, __builtin_shufflevector(x, x, 0, 1, 2, 3))
#define PG8_HI(x) __builtin_bit_cast(bf16x8, __builtin_shufflevector(x, x, 4, 5, 6, 7))
#define PG8_MMA(ai, bj, At, Bt) do { __builtin_amdgcn_s_setprio(1); _Pragma("unroll") for (int m = 0; m < 4; ++m) _Pragma("unroll") for (int n = 0; n < 2; ++n) { \
        if constexpr (FP8) asm volatile("v_mfma_scale_f32_16x16x128_f8f6f4 %0, %1, %2, %0, %3, %3 op_sel_hi:[0,0,0]" : "+v"(acc[ai][bj][m][n]) : "v"(Bt[n]), "v"(At[m]), "v"(one_scale)); \
        else { acc[ai][bj][m][n] = __builtin_amdgcn_mfma_f32_16x16x32_bf16(PG8_LO(Bt[n]), PG8_LO(At[m]), acc[ai][bj][m][n], 0, 0, 0); \
               acc[ai][bj][m][n] = __builtin_amdgcn_mfma_f32_16x16x32_bf16(PG8_HI(Bt[n]), PG8_HI(At[m]), acc[ai][bj][m][n], 0, 0, 0); } } \
        __builtin_amdgcn_s_setprio(0); } while (0)
#define PG8_MMA_Z(ai, bj, At, Bt) do { __builtin_amdgcn_s_setprio(1); _Pragma("unroll") for (int m = 0; m < 4; ++m) _Pragma("unroll") for (int n = 0; n < 2; ++n) \
        asm volatile("v_mfma_scale_f32_16x16x128_f8f6f4 %0, %1, %2, 0, %3, %3 op_sel_hi:[0,0,0]" : "=&v"(acc[ai][bj][m][n]) : "v"(Bt[n]), "v"(At[m]), "v"(one_scale)); \
        __builtin_amdgcn_s_setprio(0); } while (0)
#define PG8_MMA2(ai, At, B0, B1) do { if constexpr (FP8) { if (zfirst) { PG8_MMA_Z(ai, 0, At, B0); PG8_MMA_Z(ai, 1, At, B1); } else { PG8_MMA(ai, 0, At, B0); PG8_MMA(ai, 1, At, B1); } } else { PG8_MMA(ai, 0, At, B0); PG8_MMA(ai, 1, At, B1); } } while (0)
#define PG8_WAIT_V(n) asm volatile("s_waitcnt vmcnt(" #n ")" ::: "memory")
#define PG8_WAIT_L(n) asm volatile("s_waitcnt lgkmcnt(" #n ")" ::: "memory")
#define PG8_BAR __builtin_amdgcn_s_barrier()
#define PG8_SCHED __builtin_amdgcn_sched_barrier(0)
    Unit cur, nxt; int ui = 0;
    if (!P.next(0, cur)) return;
    f32x4 acc[2][2][4][2];
    if constexpr (!FP8) {
#pragma unroll
    for (int a = 0; a < 2; ++a)
#pragma unroll
        for (int b = 0; b < 2; ++b)
#pragma unroll
            for (int m = 0; m < 4; ++m)
#pragma unroll
                for (int n = 0; n < 2; ++n) acc[a][b][m][n] = (f32x4){0.f, 0.f, 0.f, 0.f}; }
    int one_scale = 0x7f7f7f7f; asm volatile("" : "+v"(one_scale));
    i32x8 At[4], B0[2], B1[2];
    unsigned vc[2][2], vn[2][2];
    P.a_off(cur, Rr, Cc, vc);
    const char* cA = P.a_base(cur); const char* cB = P.b_base(cur);
    PG8_STAGE(PG8_SB(0, 0), cB, voffB); PG8_STAGE(PG8_SB(0, 1), cB + hstep, voffB); PG8_STAGE(PG8_SA(0, 0), cA, vc[0]); PG8_STAGE(PG8_SA(0, 1), cA, vc[1]);
    if (wr == 1) PG8_BAR;
    PG8_WAIT_V(2); PG8_BAR;
    PG8_STAGE(PG8_SB(1, 0), cB + kstep, voffB); PG8_STAGE(PG8_SA(1, 0), cA + kstep, vc[0]); PG8_STAGE(PG8_SB(1, 1), cB + hstep + kstep, voffB);
    PG8_WAIT_V(6); PG8_BAR;
    for (;;) {
        const bool has_next = P.next(ui + 1, nxt);
        const char* nA = has_next ? P.a_base(nxt) : cA; const char* nB = has_next ? P.b_base(nxt) : cB;
        int tkr[2][2] = {{0, 0}, {0, 0}};
        if constexpr (Prob::GATHER) { if (has_next) P.a_idx(nxt, Rr, tkr); }
#pragma unroll
        for (int h = 0; h < 2; ++h)
#pragma unroll
            for (int i = 0; i < 2; ++i) vn[h][i] = vc[h][i];
        if constexpr (Prob::GATHER) { if (nt < 6 && has_next) { PG8_WAIT_V(0); P.a_fin(nxt, Rr, Cc, tkr, vn); } }
        const bool post = ui > 0;
#if PROBE_KLOOP2
        const int ntt = ((PROBE_KLOOP2 == 1 && FP8) || (PROBE_KLOOP2 == 2 && !FP8 && nt == 16)) ? 2 * nt : nt;
#else
        const int ntt = nt;
#endif
        for (int t = 0; t < ntt; t += 2) {
#if PROBE_KLOOP2
            if (t == nt) {
#pragma unroll
                for (int a = 0; a < 2; ++a)
#pragma unroll
                    for (int b = 0; b < 2; ++b)
#pragma unroll
                        for (int m = 0; m < 4; ++m)
#pragma unroll
                            for (int n = 0; n < 2; ++n) acc[a][b][m][n] = (f32x4){0.f, 0.f, 0.f, 0.f};
            }
            const int tq = t >= nt ? t - nt : t;
#else
            const int tq = t;
#endif
            if constexpr (Epi::MID) { if (tq == nt / 2) { int l2 = 0; asm volatile("" : "+v"(l2)); l2 = (int)__builtin_amdgcn_mbcnt_hi(~0u, __builtin_amdgcn_mbcnt_lo(~0u, (unsigned)l2)); E.mid(acc, cur, wr, wc, l2 & 15, l2 >> 4); } }
            const bool last = (t == ntt - 2);
            const int tq2 = (tq + 2 == nt) ? 0 : tq + 2;
            const char* a1 = cA + (size_t)(tq + 1) * kstep;
            const char* a2 = last ? nA : cA + (size_t)tq2 * kstep; const char* b2 = last ? nB : cB + (size_t)tq2 * kstep;
            const char* a3 = a2 + kstep; const char* b3 = b2 + kstep;
            unsigned w0[2], w1[2];
            if constexpr (Prob::GATHER) { w0[0] = last ? vn[0][0] : vc[0][0]; w0[1] = last ? vn[0][1] : vc[0][1]; w1[0] = last ? vn[1][0] : vc[1][0]; w1[1] = last ? vn[1][1] : vc[1][1]; }
            else { w0[0] = vc[0][0]; w0[1] = vc[0][1]; w1[0] = vc[1][0]; w1[1] = vc[1][1]; }
            int tz = t; asm volatile("" : "+s"(tz));
            const bool relax = PRE11 && post && tz == 0;
            int tzq = tq; asm volatile("" : "+s"(tzq)); const bool zfirst = (tzq == 0);
            PG8_LDB(B0, 0, 0); PG8_LDB(B1, 0, 1); PG8_SCHED; PG8_LDA(At, 0, 0); if (!relax) PG8_STAGE(PG8_SA(1, 1), a1, vc[1]);
            if (!relax) PG8_WAIT_V(8); PG8_WAIT_L(0); PG8_BAR; PG8_MMA2(0, At, B0, B1); PG8_BAR; PG8_SCHED;
            PG8_LDA(At, 0, 1); PG8_STAGE(PG8_SB(0, 0), b2, voffB); PG8_STAGE(PG8_SB(0, 1), b2 + hstep, voffB); PG8_STAGE(PG8_SA(0, 0), a2, w0);
            if (!relax) PG8_WAIT_V(8); PG8_WAIT_L(0); PG8_BAR; PG8_MMA2(1, At, B0, B1); PG8_BAR; PG8_SCHED;
            PG8_LDB(B0, 1, 0); PG8_LDB(B1, 1, 1); PG8_SCHED; PG8_LDA(At, 1, 0); PG8_STAGE(PG8_SA(0, 1), a2, w1);
            if (!relax) PG8_WAIT_V(8); PG8_WAIT_L(0); PG8_BAR; PG8_MMA(0, 0, At, B0); PG8_MMA(0, 1, At, B1); PG8_BAR; PG8_SCHED;
            PG8_LDA(At, 1, 1); PG8_STAGE(PG8_SB(1, 0), b3, voffB); PG8_STAGE(PG8_SB(1, 1), b3 + hstep, voffB); PG8_STAGE(PG8_SA(1, 0), a3, w0);
            PG8_WAIT_V(8); PG8_WAIT_L(0); PG8_BAR; PG8_MMA(1, 0, At, B0); PG8_MMA(1, 1, At, B1); PG8_BAR; PG8_SCHED;
            if constexpr (Prob::GATHER) { if (nt >= 6 && t + 4 == ntt && has_next) P.a_fin(nxt, Rr, Cc, tkr, vn); }
        }
        if (wr == 0) PG8_BAR;
        if constexpr (PRE11) PG8_STAGE(PG8_SA(1, 1), nA + kstep, vn[1]);
        if constexpr (FP8) asm volatile("s_nop 15\n\ts_nop 3" ::: "memory");
        { int l2 = 0; asm volatile("" : "+v"(l2)); l2 = (int)__builtin_amdgcn_mbcnt_hi(~0u, __builtin_amdgcn_mbcnt_lo(~0u, (unsigned)l2));
          E(acc, cur, wr, wc, l2 & 15, l2 >> 4);
#if PROBE_EPI2
          if ((PROBE_EPI2 == 1 && FP8) || (PROBE_EPI2 == 2 && !FP8 && P.nN == 14)) { int l3 = threadIdx.x & 63; asm volatile("" : "+v"(l3)); E(acc, cur, wr, wc, l3 & 15, l3 >> 4); }
#endif
        }
        if (!has_next) break;
        if constexpr (!FP8) {
#pragma unroll
        for (int a = 0; a < 2; ++a)
#pragma unroll
            for (int b = 0; b < 2; ++b)
#pragma unroll
                for (int m = 0; m < 4; ++m)
#pragma unroll
                    for (int n = 0; n < 2; ++n) acc[a][b][m][n] = (f32x4){0.f, 0.f, 0.f, 0.f}; }
        cur = nxt; cA = nA; cB = nB; ++ui;
#pragma unroll
        for (int h = 0; h < 2; ++h)
#pragma unroll
            for (int i = 0; i < 2; ++i) vc[h][i] = vn[h][i];
        if (wr == 1) PG8_BAR;
    }
    PG8_WAIT_V(0);
    PG8_BAR;
#undef PG8_SA
#undef PG8_SB
#undef PG8_STAGE
#undef PG8_LDA
#undef PG8_LDB
#undef PG8_MMA
#undef PG8_MMA_Z
#undef PG8_MMA2
#undef PG8_LO
#undef PG8_HI
#undef PG8_LD8
#undef PG8_WAIT_V
#undef PG8_WAIT_L
#undef PG8_BAR
#undef PG8_SCHED
}
}

using pg8::Unit;
__device__ __forceinline__ u32x4 pack8(const f32x4& a, const f32x4& b) { u32x4 w; w.x = pk2(a[0], a[1]); w.y = pk2(a[2], a[3]); w.z = pk2(b[0], b[1]); w.w = pk2(b[2], b[3]); return w; }
#define EPI_LOOP_AI_M _Pragma("unroll") for (int ai = 0; ai < 2; ++ai) _Pragma("unroll") for (int m = 0; m < 4; ++m)
#define EPI_LOADS_DONE() asm volatile("s_waitcnt vmcnt(0)" ::: "memory")

struct EpiInProj {
    static constexpr bool MID = false, LDSX = false;
    bf16* HG; bf16* QLAT; bf16* KVLAT; bf16* G; bf16* GR; const float* gate_b; float* KPESS; const float* RSX; float* SSQ; float* SSC;
    __device__ __forceinline__ void operator()(const f32x4 (&acc)[2][2][4][2], const Unit& u, int wr, int wc, int fr, int fq) const {
        const int rowu = u.pm * 256 + wr * 64, cwu = wc * 32, cw = cwu + 8 * fq;
        float rx[2][4];
        { const float* rxp = RSX + rowu; EPI_LOOP_AI_M rx[ai][m] = rxp[fr + 128 * ai + 16 * m]; }
        f32x4 bv[2][2];
        { const int cbg = 128 * (u.pn < 6 ? 0 : u.pn - 6) + cw;
#pragma unroll
          for (int bj = 0; bj < 2; ++bj)
#pragma unroll
              for (int n = 0; n < 2; ++n) bv[bj][n] = *(const f32x4*)(gate_b + 1024 * bj + cbg + 4 * n); }
        __builtin_amdgcn_sched_barrier(0);
        EPI_LOADS_DONE();
        asm volatile("" : "+v"(bv[0][0]), "+v"(bv[0][1]), "+v"(bv[1][0]), "+v"(bv[1][1]));
        if (u.pn < 4) {
            const int bb = rowu >> 12, tu = rowu & 4095;
            char* hb = (char*)HG + (((size_t)bb * LPC + HGOFF + tu) * CDIM + 128 * u.pn + cwu) * 2; const unsigned lo = (unsigned)(fr * CDIM + 8 * fq) * 2u;
            EPI_LOOP_AI_M {
                const f32x2 r2 = {rx[ai][m], rx[ai][m]}, nr2 = r2 * -1.4426950408889634f; f32x4 v[2];
#pragma unroll
                for (int n = 0; n < 2; ++n)
#pragma unroll
                    for (int h = 0; h < 2; ++h) { const f32x2 a2 = {acc[ai][0][m][n][2 * h], acc[ai][0][m][n][2 * h + 1]}, g2 = {acc[ai][1][m][n][2 * h], acc[ai][1][m][n][2 * h + 1]};
                        const f32x2 t = g2 * nr2; f32x2 d = {__builtin_amdgcn_exp2f(t[0]), __builtin_amdgcn_exp2f(t[1])}; d = d + 1.f;
                        const f32x2 rc = {__builtin_amdgcn_rcpf(d[0]), __builtin_amdgcn_rcpf(d[1])}, o = (a2 * r2) * rc; v[n][2 * h] = o[0]; v[n][2 * h + 1] = o[1]; }
                *(u32x4*)(hb + (size_t)(128 * ai + 16 * m) * (CDIM * 2) + lo) = pack8(v[0], v[1]); }
        } else if (u.pn < 6) {
            char* db = (char*)((u.pn == 4) ? QLAT : KVLAT) + ((size_t)rowu * 256 + cwu) * 2; const unsigned lo = (unsigned)(fr * 256 + 8 * fq) * 2u;
            EPI_LOOP_AI_M {
#pragma unroll
                for (int bj = 0; bj < 2; ++bj) *(u32x4*)(db + (size_t)(128 * ai + 16 * m) * 512 + 256 * bj + lo) = pack8(acc[ai][bj][m][0] * rx[ai][m], acc[ai][bj][m][1] * rx[ai][m]); }
            { float* ssd = ((u.pn == 4) ? SSQ : SSC) + (size_t)rowu * 4 + wc; const int nbj = (u.pn == 4) ? 2 : 1;
                EPI_LOOP_AI_M { float ss = 0.f;
#pragma unroll
                    for (int bj = 0; bj < 2; ++bj) if (bj < nbj) { const f32x4 a = acc[ai][bj][m][0], b = acc[ai][bj][m][1]; ss += ((a[0] * a[0] + a[1] * a[1]) + (a[2] * a[2] + a[3] * a[3])) + ((b[0] * b[0] + b[1] * b[1]) + (b[2] * b[2] + b[3] * b[3])); }
                    ss += __shfl_xor(ss, 16); ss += __shfl_xor(ss, 32);
                    if (fq == 0) ssd[(fr + 128 * ai + 16 * m) * 4] = ss * rx[ai][m] * rx[ai][m]; } }
            if (u.pn == 5 && wc == 0) {
                float* kp = KPESS + rowu;
                EPI_LOOP_AI_M { const f32x4 a = acc[ai][1][m][0], b = acc[ai][1][m][1];
                    float ss = ((a[0] * a[0] + a[1] * a[1]) + (a[2] * a[2] + a[3] * a[3])) + ((b[0] * b[0] + b[1] * b[1]) + (b[2] * b[2] + b[3] * b[3]));
                    ss += __shfl_xor(ss, 16); ss += __shfl_xor(ss, 32);
                    if (fq == 0) kp[fr + 128 * ai + 16 * m] = ss * rx[ai][m] * rx[ai][m]; } }
        } else {
            const size_t ub = ((size_t)rowu * 1024 + 128 * (u.pn - 6) + cwu) * 2; char* rb = (char*)GR + ub; char* gb = (char*)G + ub; const unsigned lo = (unsigned)(fr * 1024 + 8 * fq) * 2u;
#pragma unroll
            for (int bj = 0; bj < 2; ++bj)
#pragma unroll
                for (int n = 0; n < 2; ++n) bv[bj][n] = bv[bj][n] * -1.4426950408889634f;
            EPI_LOOP_AI_M { f32x4 rr[2], gg[2]; const float nr = rx[ai][m] * -1.4426950408889634f; const f32x2 nr2 = {nr, nr};
#pragma unroll
                for (int n = 0; n < 2; ++n)
#pragma unroll
                    for (int h = 0; h < 2; ++h) { const f32x2 z0 = {acc[ai][0][m][n][2 * h], acc[ai][0][m][n][2 * h + 1]}, z1 = {acc[ai][1][m][n][2 * h], acc[ai][1][m][n][2 * h + 1]};
                        const f32x2 b0 = {bv[0][n][2 * h], bv[0][n][2 * h + 1]}, b1 = {bv[1][n][2 * h], bv[1][n][2 * h + 1]};
                        const f32x2 t0 = z0 * nr2 + b0, t1 = z1 * nr2 + b1;
                        f32x2 d0 = {__builtin_amdgcn_exp2f(t0[0]), __builtin_amdgcn_exp2f(t0[1])}, d1 = {__builtin_amdgcn_exp2f(t1[0]), __builtin_amdgcn_exp2f(t1[1])}; d0 = d0 + 1.f; d1 = d1 + 1.f;
                        const f32x2 q0 = {__builtin_amdgcn_rcpf(d0[0]), __builtin_amdgcn_rcpf(d0[1])}, g1 = {__builtin_amdgcn_rcpf(d1[0]), __builtin_amdgcn_rcpf(d1[1])}, r = d1 * q0;
                        gg[n][2 * h] = g1[0]; gg[n][2 * h + 1] = g1[1]; rr[n][2 * h] = r[0]; rr[n][2 * h + 1] = r[1]; }
                *(u32x4*)(rb + (size_t)(128 * ai + 16 * m) * 2048 + lo) = pack8(rr[0], rr[1]); *(u32x4*)(gb + (size_t)(128 * ai + 16 * m) * 2048 + lo) = pack8(gg[0], gg[1]); }
        }
    }
};
template <bool REMAP> struct EpiRowScale {
    static constexpr bool MID = false, LDSX = false;
    bf16* O; const float* rs;
    __device__ __forceinline__ void operator()(const f32x4 (&acc)[2][2][4][2], const Unit& u, int wr, int wc, int fr, int fq) const {
        const int rowt = u.pm * 256 + wr * 64 + fr, cb = 256 * u.pn + 64 * wc + 16 * fq;
        float sv[2][4];
        EPI_LOOP_AI_M sv[ai][m] = rs[rowt + 128 * ai + 16 * m];
        __builtin_amdgcn_sched_barrier(0);
        EPI_LOADS_DONE();
        EPI_LOOP_AI_M { const int row = rowt + 128 * ai + 16 * m; const float s = sv[ai][m];
            const size_t orow = REMAP ? ((size_t)(row >> 12) * LPK + KOFF + (row & 4095)) : (size_t)row;
#pragma unroll
            for (int bj = 0; bj < 2; ++bj) *(u32x4*)(O + orow * 1024 + cb + 8 * bj) = pack8(acc[ai][bj][m][0] * s, acc[ai][bj][m][1] * s); }
    }
};
__device__ __forceinline__ void unpack8(const u32x4& w, f32x4& a, f32x4& b) { a[0] = bflo(w.x); a[1] = bfhi(w.x); a[2] = bflo(w.y); a[3] = bfhi(w.y); b[0] = bflo(w.z); b[1] = bfhi(w.z); b[2] = bflo(w.w); b[3] = bfhi(w.w); }
struct EpiQHead {
    static constexpr bool MID = false, LDSX = true;
    bf16* QF; const float* rs; const float* q_nw; const float* ROPE; LAS unsigned char* lds;
    __device__ __forceinline__ void operator()(const f32x4 (&acc)[2][2][4][2], const Unit& u, int wr, int wc, int fr, int fq) const {
        LAS float* S = (LAS float*)(lds + 3 * 16384);
        const int rl0 = wr * 64 + fr, rowt = u.pm * 256 + rl0;
        float sv[2][4];
        { f32x4 pp[2][4];
          EPI_LOOP_AI_M pp[ai][m] = *(const f32x4*)(rs + (size_t)(rowt + 128 * ai + 16 * m) * 4);
          __builtin_amdgcn_sched_barrier(0);
          EPI_LOADS_DONE();
          EPI_LOOP_AI_M sv[ai][m] = 1.f / sqrtf(((pp[ai][m][0] + pp[ai][m][1]) + (pp[ai][m][2] + pp[ai][m][3])) * (1.f / QLR) + NORM_EPS); }
        EPI_LOOP_AI_M {
#pragma unroll
            for (int bj = 0; bj < 2; ++bj) { const f32x4 a = acc[ai][bj][m][0], b = acc[ai][bj][m][1];
                float ss = ((a[0] * a[0] + a[1] * a[1]) + (a[2] * a[2] + a[3] * a[3])) + ((b[0] * b[0] + b[1] * b[1]) + (b[2] * b[2] + b[3] * b[3]));
                ss += __shfl_xor(ss, 16); ss += __shfl_xor(ss, 32);
                if (fq == 0) S[((rl0 + 128 * ai + 16 * m) * 2 + bj) * 4 + wc] = ss; } }
        asm volatile("s_waitcnt lgkmcnt(0)\n\ts_barrier" ::: "memory");
        if (wc < 3) {
            const int d0 = 32 * wc + 8 * fq; const f32x4 w0 = *(const f32x4*)(q_nw + d0), w1 = *(const f32x4*)(q_nw + d0 + 4);
            EPI_LOOP_AI_M { const int rl = rl0 + 128 * ai + 16 * m, row = rowt + 128 * ai + 16 * m; const float rsq = sv[ai][m];
#pragma unroll
                for (int bj = 0; bj < 2; ++bj) { const f32x4 pt = *(const LAS f32x4*)(S + (rl * 2 + bj) * 4);
                    const float tot = ((pt[0] + pt[1]) + (pt[2] + pt[3])) * rsq * rsq, sc = rsq * QSCALE / sqrtf(tot * (1.f / DQK) + NORM_EPS);
                    f32x4 o0 = acc[ai][bj][m][0] * sc * w0, o1 = acc[ai][bj][m][1] * sc * w1;
                    if (wc == 2) {
                        const float* rp = ROPE + (size_t)(NMETA + (row & 4095)) * 32 + 16 * (fq & 1);
                        const f32x4 c0 = *(const f32x4*)rp, c1 = *(const f32x4*)(rp + 4), c2 = *(const f32x4*)(rp + 8), c3 = *(const f32x4*)(rp + 12);
                        const float sg = (fq < 2) ? -1.f : 1.f; f32x4 p0, p1;
#pragma unroll
                        for (int e = 0; e < 4; ++e) { p0[e] = __shfl_xor(o0[e], 32); p1[e] = __shfl_xor(o1[e], 32); }
                        o0 = (f32x4){o0[0] * c0[0] + sg * p0[0] * c0[1], o0[1] * c0[2] + sg * p0[1] * c0[3], o0[2] * c1[0] + sg * p0[2] * c1[1], o0[3] * c1[2] + sg * p0[3] * c1[3]};
                        o1 = (f32x4){o1[0] * c2[0] + sg * p1[0] * c2[1], o1[1] * c2[2] + sg * p1[1] * c2[3], o1[2] * c3[0] + sg * p1[2] * c3[1], o1[3] * c3[2] + sg * p1[3] * c3[3]}; }
                    *(u32x4*)(QF + (size_t)row * 768 + (2 * u.pn + bj) * DQK + d0) = pack8(o0, o1); } }
        }
        asm volatile("s_waitcnt lgkmcnt(0)\n\ts_barrier" ::: "memory");
    }
};
struct EpiKVHead {
    static constexpr bool MID = false, LDSX = true;
    bf16* KF; bf16* VO; const bf16* KVLAT; const float* rs; const float* kpess; const float* k_nw; const float* ROPE; LAS unsigned char* lds;
    __device__ __forceinline__ void operator()(const f32x4 (&acc)[2][2][4][2], const Unit& u, int wr, int wc, int fr, int fq) const {
        LAS float* S = (LAS float*)(lds + 3 * 16384);
        const int rl0 = wr * 64 + fr, rowt = u.pm * 256 + rl0;
        float sv[2][4];
        { f32x4 pp[2][4];
          EPI_LOOP_AI_M pp[ai][m] = *(const f32x4*)(rs + (size_t)(rowt + 128 * ai + 16 * m) * 4);
          __builtin_amdgcn_sched_barrier(0);
          EPI_LOADS_DONE();
          EPI_LOOP_AI_M sv[ai][m] = 1.f / sqrtf(((pp[ai][m][0] + pp[ai][m][1]) + (pp[ai][m][2] + pp[ai][m][3])) * (1.f / KVLR) + NORM_EPS); }
        if (wc < 2) {
            EPI_LOOP_AI_M {
#pragma unroll
                for (int bj = 0; bj < 2; ++bj) { const f32x4 a = acc[ai][bj][m][0], b = acc[ai][bj][m][1];
                    float ss = ((a[0] * a[0] + a[1] * a[1]) + (a[2] * a[2] + a[3] * a[3])) + ((b[0] * b[0] + b[1] * b[1]) + (b[2] * b[2] + b[3] * b[3]));
                    ss += __shfl_xor(ss, 16); ss += __shfl_xor(ss, 32);
                    if (fq == 0) S[((rl0 + 128 * ai + 16 * m) * 2 + bj) * 4 + wc] = ss; } }
        } else if (fq == 0) {
            EPI_LOOP_AI_M { const float val = (wc == 2) ? sv[ai][m] : kpess[rowt + 128 * ai + 16 * m];
                S[((rl0 + 128 * ai + 16 * m) * 2 + 0) * 4 + wc] = val; S[((rl0 + 128 * ai + 16 * m) * 2 + 1) * 4 + wc] = val; }
        }
        asm volatile("s_waitcnt lgkmcnt(0)\n\ts_barrier" ::: "memory");
        if (wc < 2) {
            const int d0 = 32 * wc + 8 * fq; const f32x4 w0 = *(const f32x4*)(k_nw + d0), w1 = *(const f32x4*)(k_nw + d0 + 4);
            EPI_LOOP_AI_M { const int rl = rl0 + 128 * ai + 16 * m, row = rowt + 128 * ai + 16 * m, b = row >> 12, t = row & 4095;
#pragma unroll
                for (int bj = 0; bj < 2; ++bj) { const f32x4 pt = *(const LAS f32x4*)(S + (rl * 2 + bj) * 4);
                    const float tot = (pt[0] + pt[1]) * pt[2] * pt[2] + pt[3], sc = pt[2] / sqrtf(tot * (1.f / DQK) + NORM_EPS);
                    *(u32x4*)(KF + ((size_t)(b * NH + 2 * u.pn + bj) * LPK + KOFF + t) * DQK + d0) = pack8(acc[ai][bj][m][0] * sc * w0, acc[ai][bj][m][1] * sc * w1); } }
        } else {
            const int d0 = 32 * (wc - 2) + 8 * fq;
            EPI_LOOP_AI_M { const int row = rowt + 128 * ai + 16 * m, b = row >> 12, t = row & 4095; const float rsc = sv[ai][m];
#pragma unroll
                for (int bj = 0; bj < 2; ++bj) *(u32x4*)(VO + ((size_t)b * LPK + KOFF + t) * 1024 + (2 * u.pn + bj) * 128 + 64 + d0) = pack8(acc[ai][bj][m][0] * rsc, acc[ai][bj][m][1] * rsc); }
        }
        __builtin_amdgcn_sched_barrier(0);
        if (wc == 2) {
            const f32x4 wo0 = *(const f32x4*)(k_nw + 64 + 8 * fq), wo1 = *(const f32x4*)(k_nw + 68 + 8 * fq), wp0 = *(const f32x4*)(k_nw + 64 + 8 * (fq ^ 2)), wp1 = *(const f32x4*)(k_nw + 68 + 8 * (fq ^ 2));
            const float sg = (fq < 2) ? -1.f : 1.f;
#pragma unroll 2
            for (int q = 0; q < 8; ++q) { const int rl = rl0 + 128 * (q >> 2) + 16 * (q & 3), row = u.pm * 256 + rl, b = row >> 12, t = row & 4095;
                f32x4 xo0, xo1, xp0, xp1; const bf16* pe = KVLAT + (size_t)row * 256 + KVLR; unpack8(*(const u32x4*)(pe + 8 * fq), xo0, xo1); unpack8(*(const u32x4*)(pe + 8 * (fq ^ 2)), xp0, xp1);
                const float* rp = ROPE + (size_t)(NMETA + t) * 32 + 16 * (fq & 1); const f32x4 c0 = *(const f32x4*)rp, c1 = *(const f32x4*)(rp + 4), c2 = *(const f32x4*)(rp + 8), c3 = *(const f32x4*)(rp + 12);
#pragma unroll
                for (int bj = 0; bj < 2; ++bj) { const f32x4 pt = *(const LAS f32x4*)(S + (rl * 2 + bj) * 4);
                    const float tot = (pt[0] + pt[1]) * pt[2] * pt[2] + pt[3], rh = 1.f / sqrtf(tot * (1.f / DQK) + NORM_EPS);
                    const f32x4 a0 = xo0 * rh * wo0, a1 = xo1 * rh * wo1, p0 = xp0 * rh * wp0, p1 = xp1 * rh * wp1;
                    const f32x4 o0 = {a0[0] * c0[0] + sg * p0[0] * c0[1], a0[1] * c0[2] + sg * p0[1] * c0[3], a0[2] * c1[0] + sg * p0[2] * c1[1], a0[3] * c1[2] + sg * p0[3] * c1[3]};
                    const f32x4 o1 = {a1[0] * c2[0] + sg * p1[0] * c2[1], a1[1] * c2[2] + sg * p1[1] * c2[3], a1[2] * c3[0] + sg * p1[2] * c3[1], a1[3] * c3[2] + sg * p1[3] * c3[3]};
                    *(u32x4*)(KF + ((size_t)(b * NH + 2 * u.pn + bj) * LPK + KOFF + t) * DQK + 64 + 8 * fq) = pack8(o0, o1); } }
        }
        asm volatile("s_waitcnt lgkmcnt(0)\n\ts_barrier" ::: "memory");
    }
};
struct EpiMix {
    static constexpr bool MID = true, LDSX = false;
    bf16* O; const bf16* G1; const bf16* GR;
    __device__ __forceinline__ void mid(f32x4 (&acc)[2][2][4][2], const Unit& u, int wr, int wc, int fr, int fq) const {
        const char* gb = (const char*)GR + ((size_t)(u.pm * 256 + wr * 64) * 1024 + 256 * u.pn + 64 * wc) * 2; const unsigned lo = (unsigned)(fr * 1024 + 16 * fq) * 2u;
#pragma unroll
        for (int ai = 0; ai < 2; ++ai) { u32x4 gw[4][2];
#pragma unroll
            for (int m = 0; m < 4; ++m)
#pragma unroll
                for (int bj = 0; bj < 2; ++bj) gw[m][bj] = *(const u32x4*)(gb + (size_t)(128 * ai + 16 * m) * 2048 + lo + 16 * bj);
            __builtin_amdgcn_sched_barrier(0);
#pragma unroll
            for (int m = 0; m < 4; ++m)
#pragma unroll
                for (int bj = 0; bj < 2; ++bj) { f32x4 g0, g1; unpack8(gw[m][bj], g0, g1); acc[ai][bj][m][0] *= g0; acc[ai][bj][m][1] *= g1; }
            __builtin_amdgcn_sched_barrier(0); }
    }
    __device__ __forceinline__ void operator()(const f32x4 (&acc)[2][2][4][2], const Unit& u, int wr, int wc, int fr, int fq) const {
        const size_t ub = ((size_t)(u.pm * 256 + wr * 64) * 1024 + 256 * u.pn + 64 * wc) * 2; const unsigned lo = (unsigned)(fr * 1024 + 16 * fq) * 2u;
        const char* gb = (const char*)G1 + ub; char* ob = (char*)O + ub;
        u32x4 gw[2][4][2];
        EPI_LOOP_AI_M {
#pragma unroll
            for (int bj = 0; bj < 2; ++bj) gw[ai][m][bj] = *(const u32x4*)(gb + (size_t)(128 * ai + 16 * m) * 2048 + lo + 16 * bj); }
        __builtin_amdgcn_sched_barrier(0);
        EPI_LOADS_DONE();
        EPI_LOOP_AI_M {
#pragma unroll
            for (int bj = 0; bj < 2; ++bj) { f32x4 g0, g1; unpack8(gw[ai][m][bj], g0, g1);
                *(u32x4*)(ob + (size_t)(128 * ai + 16 * m) * 2048 + lo + 16 * bj) = pack8(g0 * acc[ai][bj][m][0], g1 * acc[ai][bj][m][1]); } }
    }
};
struct EpiResid {
    static constexpr bool MID = false, LDSX = false;
    const bf16* X; bf16* H1B; unsigned char* H1Q;
    __device__ __forceinline__ void operator()(const f32x4 (&acc)[2][2][4][2], const Unit& u, int wr, int wc, int fr, int fq) const {
        const size_t ue = (size_t)(u.pm * 256 + wr * 64) * 1024 + 256 * u.pn + 64 * wc; const unsigned le = (unsigned)(fr * 1024 + 16 * fq);
        const char* xb = (const char*)X + ue * 2; char* hb = (char*)H1B + ue * 2; unsigned char* qb = H1Q + ue;
        u32x4 xv[2][4][2];
        EPI_LOOP_AI_M {
#pragma unroll
            for (int bj = 0; bj < 2; ++bj) xv[ai][m][bj] = *(const u32x4*)(xb + (size_t)(128 * ai + 16 * m) * 2048 + le * 2u + 16 * bj); }
        __builtin_amdgcn_sched_barrier(0);
        EPI_LOADS_DONE();
        EPI_LOOP_AI_M {
#pragma unroll
            for (int bj = 0; bj < 2; ++bj) {
                f32x4 x0, x1; unpack8(xv[ai][m][bj], x0, x1); const f32x4 v0 = x0 + acc[ai][bj][m][0], v1 = x1 + acc[ai][bj][m][1];
                *(u32x4*)(hb + (size_t)(128 * ai + 16 * m) * 2048 + le * 2u + 16 * bj) = pack8(v0, v1);
                *(u32x2*)(qb + (size_t)(128 * ai + 16 * m) * 1024 + le + 8 * bj) = (u32x2){pk4_fp8(v0[0], v0[1], v0[2], v0[3]), pk4_fp8(v1[0], v1[1], v1[2], v1[3])}; } }
    }
};
struct EpiSwiGLU {
    static constexpr bool MID = false, LDSX = false;
    unsigned char* ACT; const float* bgu; const float* lrs; const volatile LAS int* tb;
    __device__ __forceinline__ void operator()(const f32x4 (&acc)[2][2][4][2], const Unit& u, int wr, int wc, int fr, int fq) const {
        const int r0 = wr * 64 + fr, cw = wc * 32 + 8 * fq, slot0 = (u.pm - __builtin_amdgcn_readfirstlane(tb[u.e])) * 256;
        const float* bg = bgu + (size_t)u.e * 2048 + 128 * u.pn + cw; const float* lr = lrs + (size_t)u.e * ECAP + slot0;
        const f32x4 bg0 = *(const f32x4*)(bg), bg1 = *(const f32x4*)(bg + 4), bu0 = *(const f32x4*)(bg + 1024), bu1 = *(const f32x4*)(bg + 1028);
        float sv[2][4];
        EPI_LOOP_AI_M sv[ai][m] = lr[r0 + 128 * ai + 16 * m];
        asm volatile("" : "+v"(sv[0][0]), "+v"(sv[0][1]), "+v"(sv[0][2]), "+v"(sv[0][3]), "+v"(sv[1][0]), "+v"(sv[1][1]), "+v"(sv[1][2]), "+v"(sv[1][3]));
        EPI_LOADS_DONE();
        constexpr float NC = -SW_ALPHA * 1.4426950408889634f;
        f32x4 bgv[2] = {bg0, bg1}, buv[2] = {bu0 + 1.f, bu1 + 1.f};
        EPI_LOOP_AI_M { const int r = r0 + 128 * ai + 16 * m; const float s = (r < u.cnt) ? sv[ai][m] * W8_INV : 0.f; const f32x2 s2 = {s, s};
            f32x4 v[2];
#pragma unroll
            for (int n = 0; n < 2; ++n)
#pragma unroll
                for (int h = 0; h < 2; ++h) {
                    const f32x2 ag = {acc[ai][0][m][n][2 * h], acc[ai][0][m][n][2 * h + 1]}, au = {acc[ai][1][m][n][2 * h], acc[ai][1][m][n][2 * h + 1]};
                    const f32x2 bg2 = {bgv[n][2 * h], bgv[n][2 * h + 1]}, bu2 = {buv[n][2 * h], buv[n][2 * h + 1]};
                    f32x2 g = ag * s2 + bg2; g[0] = fminf(g[0], SW_LIMIT); g[1] = fminf(g[1], SW_LIMIT);
                    f32x2 uu = au * s2 + bu2; uu[0] = __builtin_amdgcn_fmed3f(uu[0], 1.f - SW_LIMIT, 1.f + SW_LIMIT); uu[1] = __builtin_amdgcn_fmed3f(uu[1], 1.f - SW_LIMIT, 1.f + SW_LIMIT);
                    const f32x2 x = g * NC; f32x2 d = {__builtin_amdgcn_exp2f(x[0]), __builtin_amdgcn_exp2f(x[1])}; d = d + 1.f;
                    const f32x2 rc = {__builtin_amdgcn_rcpf(d[0]), __builtin_amdgcn_rcpf(d[1])};
                    const f32x2 o = (uu * g) * rc; v[n][2 * h] = o[0]; v[n][2 * h + 1] = o[1]; }
            *(u32x2*)(ACT + ((size_t)u.pm * 256 + r) * 1024 + 128 * u.pn + cw) = (u32x2){pk4_fp8(v[0][0], v[0][1], v[0][2], v[0][3]), pk4_fp8(v[1][0], v[1][1], v[1][2], v[1][3])}; }
    }
};
struct EpiDown {
    static constexpr bool MID = false, LDSX = false;
    unsigned char* Y; const float* bd; const float* lw; const volatile LAS int* tb;
    __device__ __forceinline__ void operator()(const f32x4 (&acc)[2][2][4][2], const Unit& u, int wr, int wc, int fr, int fq) const {
        const int r0 = wr * 64 + fr, cb = 256 * u.pn + 64 * wc + 16 * fq, slot0 = (u.pm - __builtin_amdgcn_readfirstlane(tb[u.e])) * 256;
        const float* bp = bd + (size_t)u.e * 1024 + cb; const float* lwp = lw + (size_t)u.e * ECAP + slot0;
        f32x4 bv[2][2];
#pragma unroll
        for (int bj = 0; bj < 2; ++bj)
#pragma unroll
            for (int n = 0; n < 2; ++n) bv[bj][n] = *(const f32x4*)(bp + 8 * bj + 4 * n);
        float wv[2][4];
        EPI_LOOP_AI_M wv[ai][m] = lwp[r0 + 128 * ai + 16 * m];
        asm volatile("" : "+v"(wv[0][0]), "+v"(wv[0][1]), "+v"(wv[0][2]), "+v"(wv[0][3]), "+v"(wv[1][0]), "+v"(wv[1][1]), "+v"(wv[1][2]), "+v"(wv[1][3]));
        EPI_LOADS_DONE();
        EPI_LOOP_AI_M { const int r = r0 + 128 * ai + 16 * m; const float w = (r < u.cnt) ? wv[ai][m] * Y8_SCALE : 0.f; u32x4 o;
            { const f32x4 v0 = (acc[ai][0][m][0] * W8_INV + bv[0][0]) * w, v1 = (acc[ai][0][m][1] * W8_INV + bv[0][1]) * w; o.x = pk4_fp8(v0[0], v0[1], v0[2], v0[3]); o.y = pk4_fp8(v1[0], v1[1], v1[2], v1[3]); }
            { const f32x4 v0 = (acc[ai][1][m][0] * W8_INV + bv[1][0]) * w, v1 = (acc[ai][1][m][1] * W8_INV + bv[1][1]) * w; o.z = pk4_fp8(v0[0], v0[1], v0[2], v0[3]); o.w = pk4_fp8(v1[0], v1[1], v1[2], v1[3]); }
            *(u32x4*)(Y + ((size_t)u.pm * 256 + r) * 1024 + cb) = o; }
    }
};

struct Ctx {
    LAS unsigned char* lds; gu32* ctl; unsigned char* ws;
    int tid, lane, wave, vcu, G;
    const float *x, *meta, *attn_nw, *w_in, *dw_w, *dw_b, *ln_w, *ln_b, *pw2_w, *qa_nw, *w_qb, *kva_nw, *w_kvb, *q_nw, *k_nw, *w_o, *gate_b, *w_out, *ffn_nw, *router_w, *router_b, *w_gu, *b_gu, *w_d, *b_d;
    float* out;
};
#define WSP(T, off) ((T*)(F.ws + (off)))

__device__ __forceinline__ void tr_item(const float* src, int ld_src, int k0, int colA, int colB, const float* ks, bf16* dst, int ld_dst, LAS unsigned* scr, int lane) {
    const int nq = lane & 15, kq = lane >> 4; const int col = (nq >> 3) ? colB : colA; const int c4 = col + 4 * (nq & 7);
#pragma unroll
    for (int i = 0; i < 8; ++i) { const int kp = 4 * i + kq; f32x4 a = {0.f, 0.f, 0.f, 0.f}, b = {0.f, 0.f, 0.f, 0.f};
        if (col >= 0) { a = *(const f32x4*)(src + (size_t)(k0 + 2 * kp) * ld_src + c4); b = *(const f32x4*)(src + (size_t)(k0 + 2 * kp + 1) * ld_src + c4); }
        if (ks) { a *= ks[k0 + 2 * kp]; b *= ks[k0 + 2 * kp + 1]; }
        LAS unsigned* p = scr + kp * 65 + 4 * nq; p[0] = pk2(a[0], b[0]); p[1] = pk2(a[1], b[1]); p[2] = pk2(a[2], b[2]); p[3] = pk2(a[3], b[3]); }
    LDS_WAIT(); asm volatile("" ::: "memory");
    const int c = lane & 7;
#pragma unroll
    for (int j = 0; j < 8; ++j) { const int n = (lane >> 3) + 8 * j; const LAS unsigned* s = scr + (4 * c) * 65 + n;
        u32x4 o; o.x = s[0]; o.y = s[65]; o.z = s[130]; o.w = s[195];
        *(u32x4*)(dst + (size_t)n * ld_dst + 8 * c) = o; }
    LDS_WAIT(); asm volatile("" ::: "memory");
}
__device__ __forceinline__ void tr_item8(const float* src, int ld_src, int k0, int colA, int colB, const float* ks, unsigned char* dst, int ld_dst, LAS unsigned* scr, int lane) {
    const int nq = lane & 15, kq = lane >> 4; const int col = (nq >> 3) ? colB : colA; const int c4 = col + 4 * (nq & 7);
#pragma unroll
    for (int i = 0; i < 8; ++i) { const int kg = 4 * i + kq; const float* sp = src + (size_t)(k0 + 4 * kg) * ld_src + c4;
        f32x4 a = {0.f, 0.f, 0.f, 0.f}, b = a, c = a, d = a;
        if (col >= 0) { a = __builtin_nontemporal_load((const f32x4*)sp); b = __builtin_nontemporal_load((const f32x4*)(sp + ld_src)); c = __builtin_nontemporal_load((const f32x4*)(sp + 2 * (size_t)ld_src)); d = __builtin_nontemporal_load((const f32x4*)(sp + 3 * (size_t)ld_src)); }
        float s0 = W8_SCALE, s1 = W8_SCALE, s2 = W8_SCALE, s3 = W8_SCALE;
        if (ks) { const f32x4 kv = *(const f32x4*)(ks + k0 + 4 * kg); s0 *= kv[0]; s1 *= kv[1]; s2 *= kv[2]; s3 *= kv[3]; }
        a *= s0; b *= s1; c *= s2; d *= s3;
        LAS unsigned* p = scr + kg * 65 + 4 * nq;
        p[0] = pk4_fp8(a[0], b[0], c[0], d[0]); p[1] = pk4_fp8(a[1], b[1], c[1], d[1]); p[2] = pk4_fp8(a[2], b[2], c[2], d[2]); p[3] = pk4_fp8(a[3], b[3], c[3], d[3]); }
    LDS_WAIT(); asm volatile("" ::: "memory");
    const int c = lane & 7;
#pragma unroll
    for (int j = 0; j < 8; ++j) { const int n = (lane >> 3) + 8 * j; const LAS unsigned* s = scr + (4 * c) * 65 + n;
        u32x4 o; o.x = s[0]; o.y = s[65]; o.z = s[130]; o.w = s[195];
        *(u32x4*)(dst + (size_t)n * ld_dst + 16 * c) = o; }
    LDS_WAIT(); asm volatile("" ::: "memory");
}
__device__ __forceinline__ int colmap_in(int n32) { const int tile = n32 >> 3, j = n32 & 7;
    if (tile < 4) return (j < 4) ? 128 * tile + 32 * j : 512 + 128 * tile + 32 * (j - 4);
    if (tile == 4) return 1024 + 32 * j;
    if (tile == 5) return (j < 5) ? 1280 + 32 * j : -1;
    return (j < 4) ? 1440 + 128 * (tile - 6) + 32 * j : 1440 + 1024 + 128 * (tile - 6) + 32 * (j - 4); }
__device__ __forceinline__ int colmap_gu(int n32) { const int tile = n32 >> 3, j = n32 & 7; return (j < 4) ? 128 * tile + 32 * j : 1024 + 128 * tile + 32 * (j - 4); }
__device__ __forceinline__ int colmap_qb(int n32) { const int h = n32 >> 2, j = n32 & 3; return (j < 3) ? 96 * h + 32 * j : -1; }

__device__ __forceinline__ void p0_item(Ctx& F, int it, LAS unsigned* scr) {
    constexpr int I_GU = 256, I_D = 128, N_GU = NE * I_GU, N_D = NE * I_D, N_WIN = INPROJ_FP8 ? 56 * 8 : 56 * 16, N_WOUT = 256, N_PW2 = 128, N_WO = 128, N_QB = 64;
    int r = it;
    if (r < N_GU) { const int e = r / I_GU, q = r % I_GU, nb = q & 31, kb = q >> 5;
        tr_item8(F.w_gu + (size_t)e * 1024 * 2048, 2048, 128 * kb, colmap_gu(2 * nb), colmap_gu(2 * nb + 1), F.ffn_nw, WSP(unsigned char, WS_WGU) + ((size_t)e * 2048 + 64 * nb) * 1024 + 128 * kb, 1024, scr, F.lane); return; }
    r -= N_GU;
    if (r < N_D) { const int e = r / I_D, q = r % I_D, nb = q & 15, kb = q >> 4;
        tr_item8(F.w_d + (size_t)e * 1024 * 1024, 1024, 128 * kb, 64 * nb, 64 * nb + 32, nullptr, WSP(unsigned char, WS_WD) + ((size_t)e * 1024 + 64 * nb) * 1024 + 128 * kb, 1024, scr, F.lane); return; }
    r -= N_D;
#if INPROJ_FP8
    if (r < N_WIN) { const int nb = r >> 3, kb = r & 7;
        tr_item8(F.w_in, INC, 128 * kb, colmap_in(2 * nb), colmap_in(2 * nb + 1), F.attn_nw, WSP(unsigned char, WS_WIN) + (size_t)(64 * nb) * 1024 + 128 * kb, 1024, scr, F.lane); return; }
#else
    if (r < N_WIN) { const int nb = r >> 4, kb = r & 15;
        tr_item(F.w_in, INC, 64 * kb, colmap_in(2 * nb), colmap_in(2 * nb + 1), F.attn_nw, WSP(bf16, WS_WIN) + (size_t)(64 * nb) * 1024 + 64 * kb, 1024, scr, F.lane); return; }
#endif
    r -= N_WIN;
    if (r < N_WOUT) { const int nb = r >> 4, kb = r & 15;
        tr_item(F.w_out, 1024, 64 * kb, 64 * nb, 64 * nb + 32, nullptr, WSP(bf16, WS_WOUT) + (size_t)(64 * nb) * 1024 + 64 * kb, 1024, scr, F.lane); return; }
    r -= N_WOUT;
    if (r < N_PW2) { const int nb = r >> 3, kb = r & 7;
        tr_item(F.pw2_w, 1024, 64 * kb, 64 * nb, 64 * nb + 32, nullptr, WSP(bf16, WS_W2T) + (size_t)(64 * nb) * 1024 + 64 * kb, 1024, scr, F.lane); return; }
    r -= N_PW2;
    if (r < N_WO) { const int nb = r >> 3, kb = r & 7;
        tr_item(F.w_o, 1024, 64 * kb, 64 * nb, 64 * nb + 32, nullptr, WSP(bf16, WS_W2T) + (size_t)(64 * nb) * 1024 + 512 + 64 * kb, 1024, scr, F.lane); return; }
    r -= N_WO;
    if (r < N_QB) { const int nb = r >> 2, kb = r & 3;
        tr_item(F.w_qb, 768, 64 * kb, colmap_qb(2 * nb), colmap_qb(2 * nb + 1), F.qa_nw, WSP(bf16, WS_WQB) + (size_t)(64 * nb) * 256 + 64 * kb, 256, scr, F.lane); return; }
    r -= N_QB;
    { const int nb = r >> 2, kb = r & 3; const bool real = kb < 2;
        tr_item(F.w_kvb, 1024, real ? 64 * kb : 0, real ? 64 * nb : -1, real ? 64 * nb + 32 : -1, real ? F.kva_nw : nullptr, WSP(bf16, WS_WKVB) + (size_t)(64 * nb) * 256 + 64 * kb, 256, scr, F.lane); }
}
constexpr int P0_NITEMS = NE * 256 + NE * 128 + (INPROJ_FP8 ? 56 * 8 : 56 * 16) + 256 + 128 + 128 + 64 + 64;

__device__ __forceinline__ void p0_prologue(Ctx& F) {
    LAS unsigned* scr = (LAS unsigned*)F.lds + F.wave * 2080;
    const int gw = F.vcu * 8 + F.wave, NGW = F.G * 8, gth = gw * 64 + F.lane, NGT = NGW * 64;
    for (int it = gw; it < P0_NITEMS; it += NGW) p0_item(F, it, scr);
    bf16* XN = WSP(bf16, WS_XN);
    for (int m2 = gw; m2 < MT / 2; m2 += NGW) {
        f32x4 v[2][4]; float ss[2];
#pragma unroll
        for (int q = 0; q < 2; ++q) { const f32x4* xr = (const f32x4*)(F.x + (size_t)(2 * m2 + q) * DM) + F.lane;
#pragma unroll
            for (int j = 0; j < 4; ++j) v[q][j] = __builtin_nontemporal_load(xr + 64 * j); }
#pragma unroll
        for (int q = 0; q < 2; ++q) { float sq = 0.f;
#pragma unroll
            for (int j = 0; j < 4; ++j) sq += (v[q][j][0] * v[q][j][0] + v[q][j][1] * v[q][j][1]) + (v[q][j][2] * v[q][j][2] + v[q][j][3] * v[q][j][3]);
            ss[q] = sq; }
        ss[0] = wave_sum(ss[0]); ss[1] = wave_sum(ss[1]);
#pragma unroll
        for (int q = 0; q < 2; ++q) { if (F.lane == 0) WSP(float, WS_RSX)[2 * m2 + q] = (INPROJ_FP8 ? 1.f / (XQ_SCALE * W8_SCALE) : 1.f) / sqrtf(ss[q] * (1.f / DM) + NORM_EPS);
            u32x2* o8 = (u32x2*)(XN + (size_t)(2 * m2 + q) * DM) + F.lane;
#pragma unroll
            for (int j = 0; j < 4; ++j) { u32x2 o; o.x = pk2(v[q][j][0], v[q][j][1]); o.y = pk2(v[q][j][2], v[q][j][3]); o8[64 * j] = o; }
#if INPROJ_FP8
            unsigned* o4 = (unsigned*)(WSP(unsigned char, WS_XQ) + (size_t)(2 * m2 + q) * DM) + F.lane;
#pragma unroll
            for (int j = 0; j < 4; ++j) o4[64 * j] = pk4_fp8(v[q][j][0] * XQ_SCALE, v[q][j][1] * XQ_SCALE, v[q][j][2] * XQ_SCALE, v[q][j][3] * XQ_SCALE);
#endif
        }
    }
    float* PMP = WSP(float, WS_PMP);
    for (int task = gw; task < 19 * 8; task += NGW) { const int cg = task >> 3, kc = task & 7, cp = 64 * cg + F.lane; const bool valid = cp < PMC;
        const int sc = (cp < 1024) ? cp : 1280 + (cp - 1024);
        LAS float* ms = (LAS float*)scr;
#pragma unroll
        for (int r = 0; r < 16; ++r) { ms[r * 128 + F.lane] = F.meta[r * DM + kc * 128 + F.lane] * F.attn_nw[kc * 128 + F.lane]; ms[r * 128 + 64 + F.lane] = F.meta[r * DM + kc * 128 + 64 + F.lane] * F.attn_nw[kc * 128 + 64 + F.lane]; }
        LDS_WAIT(); asm volatile("" ::: "memory");
        float acc[16];
#pragma unroll
        for (int r = 0; r < 16; ++r) acc[r] = 0.f;
        const float* wp = F.w_in + (size_t)(kc * 128) * INC + (valid ? sc : 0);
        for (int k = 0; k < 128; k += 4) { const float w0 = wp[(size_t)k * INC], w1 = wp[(size_t)(k + 1) * INC], w2 = wp[(size_t)(k + 2) * INC], w3 = wp[(size_t)(k + 3) * INC];
#pragma unroll
            for (int r = 0; r < 16; ++r) { const f32x4 mv = *(const LAS f32x4*)(ms + r * 128 + k); acc[r] += (mv[0] * w0 + mv[1] * w1) + (mv[2] * w2 + mv[3] * w3); } }
        if (valid) {
#pragma unroll
            for (int r = 0; r < 16; ++r) PMP[(kc * 16 + r) * PMC + cp] = acc[r]; }
        LDS_WAIT(); asm volatile("" ::: "memory");
    }
    float* ROPE = WSP(float, WS_ROPE);
    for (int idx = gth; idx < (SEQ + NMETA) * 16; idx += NGT) { const int pos = idx >> 4, i = idx & 15;
        const double invf[16] = {1, 0.56234132519034907, 0.31622776601683794, 0.17782794100389229, 0.10000000000000001, 0.056234132519034911, 0.031622776601683791, 0.017782794100389229, 0.01, 0.005623413251903491, 0.0031622776601683794, 0.0017782794100389228, 0.001, 0.0005623413251903491, 0.00031622776601683794, 0.00017782794100389227};
        double fq = invf[0];
#pragma unroll
        for (int q = 1; q < 16; ++q) fq = (i == q) ? invf[q] : fq;
        const double ang = (double)pos * fq, red = ang - 6.283185307179586477 * __builtin_rint(ang * 0.15915494309189533577);
        float sn, cs; sincosf((float)red, &sn, &cs);
        ROPE[2 * idx] = cs; ROPE[2 * idx + 1] = sn; }
    for (int r = gw; r < NMETA; r += NGW) { float s = 0.f;
        for (int k = F.lane; k < DM; k += 64) { const float v = F.meta[r * DM + k]; s += v * v; }
        s = wave_sum(s); if (F.lane == 0) WSP(float, WS_METARS)[r] = 1.f / sqrtf(s * (1.f / DM) + NORM_EPS); }
    { unsigned short* RW3 = WSP(unsigned short, WS_RW3);
      for (int idx = gth; idx < DM * NE; idx += NGT) { const int k = idx >> 5, e = idx & 31; const float w = F.ffn_nw[k] * F.router_w[idx];
          const unsigned h = pk2(w, 0.f) & 0xffffu; const float r1 = w - __builtin_bit_cast(float, h << 16);
          const unsigned m = pk2(r1, 0.f) & 0xffffu; const float r2 = r1 - __builtin_bit_cast(float, m << 16);
          const unsigned l = pk2(r2, 0.f) & 0xffffu;
          const size_t o = ((size_t)((k >> 3) * NE + e)) * 8 + (k & 7);
          RW3[o] = (unsigned short)h; RW3[(size_t)NE * DM + o] = (unsigned short)m; RW3[(size_t)2 * NE * DM + o] = (unsigned short)l; } }
}

__device__ __forceinline__ float pm_sum(const float* PMP, int r, int c) { float s = 0.f;
#pragma unroll
    for (int kc = 0; kc < 8; ++kc) s += PMP[(kc * 16 + r) * PMC + c];
    return s; }
__device__ __forceinline__ void p1_meta(Ctx& F) {
    const float* PMP = WSP(float, WS_PMP); float* MRS = WSP(float, WS_METARS);
    const int bx = blockIdx.x;
    if (bx < 16) { const int rm = bx, c = F.tid; bf16* HG = WSP(bf16, WS_HG);
        const float rs = MRS[rm]; const float val = rs * pm_sum(PMP, rm, c) * sigmoid_f(rs * pm_sum(PMP, rm, 512 + c)); const bf16 hv = (bf16)f2bf(val);
#pragma unroll
        for (int b = 0; b < NB; ++b) { HG[((size_t)b * LPC + rm) * CDIM + c] = (bf16)0; HG[((size_t)b * LPC + 16 + rm) * CDIM + c] = hv; }
    } else if (bx == 16) {
#pragma unroll
        for (int q = 0; q < 2; ++q) { const int r = 2 * F.wave + q; const float rs = MRS[r];
            const float v0 = rs * pm_sum(PMP, r, 1024 + F.lane), v1 = rs * pm_sum(PMP, r, 1024 + 64 + F.lane);
            const float ss = wave_sum(v0 * v0 + v1 * v1); if (F.lane == 0) MRS[16 + r] = 1.f / sqrtf(ss * (1.f / KVLR) + NORM_EPS); }
    } else if (bx < 17 + 37) { float* PMF = WSP(float, WS_PMF);
        const int idx = (bx - 17) * 512 + F.tid; if (idx < 16 * PMC) PMF[idx] = pm_sum(PMP, idx / PMC, idx % PMC);
    } else if (bx < 54 + 8) {
        const int q = bx - 54, n = (q & 1) * 512 + F.tid, r0 = 4 * (q >> 1); LAS float* cs = (LAS float*)F.lds;
        { const int r = F.tid >> 7, k = F.tid & 127; cs[F.tid] = MRS[r0 + r] * pm_sum(PMP, r0 + r, 1024 + k); }
        __syncthreads();
        if (F.tid < 256) { const int r = F.tid >> 6, l = F.tid & 63; const float v0 = cs[r * 128 + l], v1 = cs[r * 128 + 64 + l]; const float ss = wave_sum(v0 * v0 + v1 * v1);
            if (l == 0) cs[512 + r] = 1.f / sqrtf(ss * (1.f / KVLR) + NORM_EPS); }
        __syncthreads();
        { const int r = F.tid >> 7, k = F.tid & 127; cs[F.tid] *= cs[512 + r] * F.kva_nw[k]; }
        __syncthreads();
        float acc[4] = {0.f, 0.f, 0.f, 0.f};
#pragma unroll 8
        for (int k = 0; k < KVLR; k += 4) { const float w0 = F.w_kvb[k * 1024 + n], w1 = F.w_kvb[(k + 1) * 1024 + n], w2 = F.w_kvb[(k + 2) * 1024 + n], w3 = F.w_kvb[(k + 3) * 1024 + n];
#pragma unroll
            for (int r = 0; r < 4; ++r) { const f32x4 c = *(const LAS f32x4*)(cs + r * 128 + k); acc[r] += (c[0] * w0 + c[1] * w1) + (c[2] * w2 + c[3] * w3); } }
#pragma unroll
        for (int r = 0; r < 4; ++r) WSP(float, WS_KVMETA)[(r0 + r) * 1024 + n] = acc[r];
        __syncthreads();
    }
}

__device__ __forceinline__ void p2_thin(Ctx& F) {
    {
        const bf16* HG = WSP(bf16, WS_HG); bf16* HC = WSP(bf16, WS_HCO);
        LAS unsigned char* lin = F.lds; LAS float* lout = (LAS float*)(F.lds + 63488);
        const int cp = F.tid & 255, th = F.tid >> 8;
        float wlo[CWID], whi[CWID];
#pragma unroll
        for (int j = 0; j < CWID; ++j) { const f32x2 w = *(const f32x2*)(F.dw_w + j * CDIM + 2 * cp); wlo[j] = w[0]; whi[j] = w[1]; }
        const f32x2 cb = *(const f32x2*)(F.dw_b + 2 * cp);
        for (int rp = 0; rp < 1 + PROBE_P2A; ++rp)
        for (int un = F.vcu; un < NB * (SEQ / 32); un += F.G) { const int b = un >> 7, t0 = (un & 127) * 32;
#pragma unroll
            for (int i = 0; i < 8; ++i) { const int p = F.tid + 512 * i; if (p < 62 * 64) { const int row = p >> 6, ch = p & 63;
                *(LAS u32x4*)(lin + row * 1024 + ch * 16) = *(const u32x4*)(HG + ((size_t)b * LPC + t0 + 2 + row) * CDIM + ch * 8); } }
            __syncthreads();
#pragma unroll
            for (int g = 0; g < 2; ++g) { const int tl0 = th * 16 + g * 8; float a0[8], a1[8];
#pragma unroll
                for (int o = 0; o < 8; ++o) { a0[o] = cb[0]; a1[o] = cb[1]; }
#pragma unroll
                for (int jj = 0; jj < 38; ++jj) { const unsigned v = *(const LAS unsigned*)(lin + (tl0 + jj) * 1024 + 4 * cp); const float lo = bflo(v), hi = bfhi(v);
#pragma unroll
                    for (int o = 0; o < 8; ++o) { const int j = jj - o; if (j >= 0 && j < CWID) { a0[o] += wlo[j] * lo; a1[o] += whi[j] * hi; } } }
#pragma unroll
                for (int o = 0; o < 8; ++o) *(LAS f32x2*)(lout + (tl0 + o) * CDIM + 2 * cp) = (f32x2){a0[o], a1[o]}; }
            __syncthreads();
            { const int tok = 4 * F.wave + (F.lane >> 4), l16 = F.lane & 15;
                f32x4 v[4][2]; float sm = 0.f;
#pragma unroll
                for (int j = 0; j < 4; ++j) { const LAS float* lr = lout + tok * CDIM + 128 * j + 8 * l16; v[j][0] = *(const LAS f32x4*)lr; v[j][1] = *(const LAS f32x4*)(lr + 4);
                    sm += (v[j][0][0] + v[j][0][1]) + (v[j][0][2] + v[j][0][3]) + (v[j][1][0] + v[j][1][1]) + (v[j][1][2] + v[j][1][3]); }
                const float mean = sum16(sm) * (1.f / CDIM); float sv = 0.f;
#pragma unroll
                for (int j = 0; j < 4; ++j)
#pragma unroll
                    for (int q = 0; q < 2; ++q) { v[j][q] = v[j][q] - mean; sv += (v[j][q][0] * v[j][q][0] + v[j][q][1] * v[j][q][1]) + (v[j][q][2] * v[j][q][2] + v[j][q][3] * v[j][q][3]); }
                const float rstd = 1.f / sqrtf(sum16(sv) * (1.f / CDIM) + NORM_EPS);
#pragma unroll
                for (int j = 0; j < 4; ++j) { const int c0 = 128 * j + 8 * l16;
                    const f32x4 w0 = *(const f32x4*)(F.ln_w + c0), w1 = *(const f32x4*)(F.ln_w + c0 + 4), b0 = *(const f32x4*)(F.ln_b + c0), b1 = *(const f32x4*)(F.ln_b + c0 + 4);
                    f32x4 y0 = v[j][0] * rstd * w0 + b0, y1 = v[j][1] * rstd * w1 + b1;
#pragma unroll
                    for (int e = 0; e < 4; ++e) { y0[e] = y0[e] * sigmoid_f(y0[e]); y1[e] = y1[e] * sigmoid_f(y1[e]); }
                    *(u32x4*)(HC + ((size_t)b * SEQ + t0 + tok) * 1024 + c0) = pack8(y0, y1); } }
            __syncthreads();
        }
    }
}

__device__ __forceinline__ void norm_rope_store(float (&v)[48], int part, const float* nw, const float* rp, float scale, bf16* dst) {
    float ss = 0.f;
#pragma unroll
    for (int d = 0; d < 48; ++d) ss += v[d] * v[d];
    ss += __shfl_xor(ss, 1);
    const float r = scale / sqrtf(ss * (1.f / DQK) + NORM_EPS);
    const float* nwp = nw + 48 * part;
#pragma unroll
    for (int d = 0; d < 48; ++d) v[d] *= r * nwp[d];
    if (part) {
#pragma unroll
        for (int i = 0; i < 16; ++i) { const float c = rp[2 * i], s = rp[2 * i + 1], x1 = v[16 + i], x2 = v[32 + i]; v[16 + i] = x1 * c - x2 * s; v[32 + i] = x2 * c + x1 * s; }
    }
#pragma unroll
    for (int q = 0; q < 6; ++q) { u32x4 w; w.x = pk2(v[8 * q], v[8 * q + 1]); w.y = pk2(v[8 * q + 2], v[8 * q + 3]); w.z = pk2(v[8 * q + 4], v[8 * q + 5]); w.w = pk2(v[8 * q + 6], v[8 * q + 7]); *(u32x4*)(dst + 8 * q) = w; }
}
__device__ __forceinline__ void ld8(const bf16* p, float* v) { const u32x4 w = *(const u32x4*)p; v[0] = bflo(w.x); v[1] = bfhi(w.x); v[2] = bflo(w.y); v[3] = bfhi(w.y); v[4] = bflo(w.z); v[5] = bfhi(w.z); v[6] = bflo(w.w); v[7] = bfhi(w.w); }

__device__ __forceinline__ void p4_headnorm(Ctx& F) {
    const int gw = F.vcu * 8 + F.wave, NGW = F.G * 8;
    const bf16* QRAW = WSP(bf16, WS_QRAW); bf16* KVRAW = WSP(bf16, WS_KVRAW); const bf16* KVLAT = WSP(bf16, WS_KVLAT);
    bf16* QF = WSP(bf16, WS_QF); bf16* KF = WSP(bf16, WS_KF); const float* ROPE = WSP(float, WS_ROPE);
    const float* PM = WSP(float, WS_PMF); const float* MRS = WSP(float, WS_METARS); const float* KVM = WSP(float, WS_KVMETA);
    constexpr int T_REAL = 0, T_META = NB * 4, T_DUMMY = NB * 48;
    const int part = F.lane & 1, h = (F.lane >> 1) & 7, tl = F.lane >> 4;
    for (int wt = gw; wt < T_REAL + T_META + T_DUMMY; wt += NGW) {
        if (false) {
        } else if (wt < T_REAL + T_META) {
            const int q = wt - T_REAL, b = q >> 2, r = tl + 4 * (q & 3); const float* rp = ROPE + (size_t)r * 32;
            float v[48]; const float* src = KVM + r * 1024 + h * 128; const float rs = MRS[r];
            if (part == 0) {
#pragma unroll
                for (int d = 0; d < 48; ++d) v[d] = src[d];
            } else {
#pragma unroll
                for (int d = 0; d < 16; ++d) v[d] = src[48 + d];
#pragma unroll
                for (int i = 0; i < 32; ++i) v[16 + i] = rs * PM[r * PMC + 1152 + i];
            }
            const size_t kr = (size_t)b * LPK + r;
            norm_rope_store(v, part, F.k_nw, rp, 1.f, KF + ((size_t)(b * NH + h) * LPK + r) * DQK + 48 * part);
            bf16* vd = KVRAW + kr * 1024 + h * 128 + 64 + 32 * part; const float* vs = src + 64 + 32 * part;
#pragma unroll
            for (int q8 = 0; q8 < 4; ++q8) { u32x4 w; w.x = pk2(vs[8 * q8], vs[8 * q8 + 1]); w.y = pk2(vs[8 * q8 + 2], vs[8 * q8 + 3]); w.z = pk2(vs[8 * q8 + 4], vs[8 * q8 + 5]); w.w = pk2(vs[8 * q8 + 6], vs[8 * q8 + 7]); *(u32x4*)(vd + 8 * q8) = w; }
        } else {
            const int q = wt - T_REAL - T_META, b = q / 48, r = 16 + q % 48; const size_t kr = (size_t)b * LPK + r; const u32x4 z = {0u, 0u, 0u, 0u};
            u32x4* vd = (u32x4*)(KVRAW + kr * 1024); vd[F.lane] = z; vd[64 + F.lane] = z;
            for (int q2 = F.lane; q2 < NH * 12; q2 += 64) { const int hh = q2 / 12, c = q2 % 12; *(u32x4*)(KF + ((size_t)(b * NH + hh) * LPK + r) * DQK + 8 * c) = z; }
        }
    }
}

namespace att {
constexpr int KSLOT = 16384, VSLOT = 8192, SLOT = KSLOT + VSLOT, NSLOT = 4, L_WS = NSLOT * SLOT, L_OST = 0, L_END = L_WS + 8 * 256;
static_assert(8 * 4096 <= 2 * SLOT && L_END <= RING_BYTES, "attention LDS map");
constexpr float THR = 8.f;
__device__ __forceinline__ int crow(int r, int hi) { return (r & 3) + 8 * (r >> 2) + 4 * hi; }
__device__ __forceinline__ float max3f(float a, float b, float c) { float r; asm("v_max3_f32 %0, %1, %2, %3" : "=v"(r) : "v"(a), "v"(b), "v"(c)); return r; }
__device__ __forceinline__ float max2f(float a, float b) { float r; asm("v_max_f32_e32 %0, %1, %2" : "=v"(r) : "v"(a), "v"(b)); return r; }
__device__ __forceinline__ void glds16(const void* gsrc, unsigned lds_dst) { unsigned keep;
    asm volatile("s_mov_b32 %0, m0\n\ts_mov_b32 m0, %2\n\ts_nop 0\n\tglobal_load_lds_dwordx4 %1, off\n\ts_mov_b32 m0, %0" : "=&s"(keep) : "v"(gsrc), "s"(lds_dst) : "memory"); }
typedef short v4i16_t __attribute__((ext_vector_type(4)));
__device__ __forceinline__ s16x4 vtr(const LAS unsigned char* p) { return __builtin_bit_cast(s16x4, __builtin_amdgcn_ds_read_tr16_b64_v4i16((LAS v4i16_t*)p)); }
__device__ __forceinline__ void pv(f32x16* o, const LAS unsigned char* vp, bf16x8 pa0, bf16x8 pa1, bf16x8 pa2, bf16x8 pa3) {
#pragma unroll
    for (int d0 = 0; d0 < 2; ++d0) { s16x4 lo[4], hi[4];
#pragma unroll
        for (int ks = 0; ks < 4; ++ks) { lo[ks] = vtr(vp + d0 * 4096 + ks * 1024); hi[ks] = vtr(vp + d0 * 4096 + ks * 1024 + 512); }
#define PK(k) (bf16x8){lo[k][0], lo[k][1], lo[k][2], lo[k][3], hi[k][0], hi[k][1], hi[k][2], hi[k][3]}
        o[d0] = __builtin_amdgcn_mfma_f32_32x32x16_bf16(pa0, PK(0), o[d0], 0, 0, 0);
        o[d0] = __builtin_amdgcn_mfma_f32_32x32x16_bf16(pa1, PK(1), o[d0], 0, 0, 0);
        o[d0] = __builtin_amdgcn_mfma_f32_32x32x16_bf16(pa2, PK(2), o[d0], 0, 0, 0);
        o[d0] = __builtin_amdgcn_mfma_f32_32x32x16_bf16(pa3, PK(3), o[d0], 0, 0, 0);
#undef PK
    }
}
__device__ __forceinline__ void attn_unit(Ctx& F, int b, int h, int qb) {
    const int lane = F.lane, r32 = lane & 31, hi = lane >> 5, wid = F.wave;
    const bf16* QF = WSP(bf16, WS_QF); const bf16* KF = WSP(bf16, WS_KF); const bf16* KVRAW = WSP(bf16, WS_KVRAW); bf16* O = WSP(bf16, WS_HCO) + 512;
    const size_t rowq0 = (size_t)b * SEQ + 256 * qb + 32 * wid;
    const bf16* Kh = KF + (size_t)(b * NH + h) * LPK * DQK; const bf16* Vh = KVRAW + (size_t)b * LPK * 1024 + h * 128 + 64;
    const unsigned lds0 = (unsigned)(uintptr_t)F.lds;
    const int NT = 4 * qb + 5;
    const bf16* ksrc0; const bf16* ksrc1;
    { const int row0 = 8 * wid + (lane >> 4), row1 = row0 + 4; int c0 = (lane & 15) ^ (row0 & 15), c1 = (lane & 15) ^ (row1 & 15); c0 -= (c0 >= 12) ? 4 : 0; c1 -= (c1 >= 12) ? 4 : 0;
      ksrc0 = Kh + (size_t)row0 * DQK + c0 * 8; ksrc1 = Kh + (size_t)row1 * DQK + c1 * 8; }
    const bf16* vsrc = Vh + (size_t)(16 * (wid & 3) + (lane >> 2)) * 1024 + (wid >> 2) * 32 + (lane & 3) * 8;
#define ATT_TIX(i) (((i) == 0) ? 0 : (((i) < 5) ? 4 * qb + (i) : (i) - 4))
#define ATT_DMA(i, slot) do { const int _t = ATT_TIX(i); const unsigned _s = lds0 + (slot); glds16(ksrc0 + (size_t)_t * 64 * DQK, (unsigned)__builtin_amdgcn_readfirstlane(_s + wid * 2048)); \
        glds16(ksrc1 + (size_t)_t * 64 * DQK, (unsigned)__builtin_amdgcn_readfirstlane(_s + wid * 2048 + 1024)); \
        glds16(vsrc + (size_t)_t * 64 * 1024, (unsigned)__builtin_amdgcn_readfirstlane(_s + KSLOT + wid * 1024)); } while (0)
#define ATT_BAR() asm volatile("s_waitcnt vmcnt(0) lgkmcnt(0)\n\ts_barrier" ::: "memory")
#define ATT_BARC(issued) do { if (issued) asm volatile("s_waitcnt vmcnt(3) lgkmcnt(0)\n\ts_barrier" ::: "memory"); else ATT_BAR(); } while (0)
#define ATT_KLD(slot, hh) do { const LAS unsigned char* kb_ = kp0 + (slot) + (hh) * 8192; int xk_ = xk; asm volatile("" : "+v"(xk_));     \
        _Pragma("unroll") for (int d0 = 0; d0 < 6; ++d0) kf[d0] = *(const LAS bf16x8*)(kb_ + (((2 * d0 + hi) ^ xk_) << 4)); } while (0)
#define ATT_QKM(S) do { S = __builtin_amdgcn_mfma_f32_32x32x16_bf16(kf[0], qr[0], negm, 0, 0, 0); _Pragma("unroll") for (int d0 = 1; d0 < 6; ++d0) S = __builtin_amdgcn_mfma_f32_32x32x16_bf16(kf[d0], qr[d0], S, 0, 0, 0); } while (0)
#define ATT_RMAX(S, RM) do { float a_ = max3f(S[0], S[1], S[2]), b_ = max3f(S[3], S[4], S[5]); a_ = max3f(a_, S[6], S[7]); b_ = max3f(b_, S[8], S[9]); a_ = max3f(a_, S[10], S[11]); b_ = max3f(b_, S[12], S[13]); a_ = max3f(a_, S[14], S[15]); a_ = max2f(a_, b_); \
        { const auto rr = __builtin_amdgcn_permlane32_swap(__float_as_uint(a_), __float_as_uint(a_), false, false); RM = max2f(__uint_as_float(rr[0]), __uint_as_float(rr[1])); } } while (0)
#define ATT_RESC(S, rm) do { \
        if (__any(rm > THR)) { const float dl = fmaxf(rm, 0.f), f = __builtin_amdgcn_exp2f(-dl); m_run += dl; l_run *= f; if (hi == 0) wsf[r32] = f; \
            _Pragma("unroll") for (int r = 0; r < 16; ++r) { const float fr_ = wsf[crow(r, hi)]; o[0][r] *= fr_; o[1][r] *= fr_; } \
            _Pragma("unroll") for (int r = 0; r < 16; ++r) { S[r] -= dl; negm[r] = -m_run; } } } while (0)
#define ATT_SMA(S) do { float rm_; ATT_RMAX(S, rm_); ATT_RESC(S, rm_); } while (0)
#define ATT_VLD(slot, hh) do { const LAS unsigned char* vp_ = vp0 + (slot) + (hh) * 2048; \
        _Pragma("unroll") for (int d0 = 0; d0 < 2; ++d0) _Pragma("unroll") for (int kk = 0; kk < 2; ++kk) { vl[d0 * 2 + kk] = vtr(vp_ + d0 * 4096 + kk * 1024); vh[d0 * 2 + kk] = vtr(vp_ + d0 * 4096 + kk * 1024 + 512); } } while (0)
#define ATT_VF(x) ((bf16x8){vl[x][0], vl[x][1], vl[x][2], vl[x][3], vh[x][0], vh[x][1], vh[x][2], vh[x][3]})
#define ATT_PVM(PA, PB) do { _Pragma("unroll") for (int d0 = 0; d0 < 2; ++d0) { \
            o[d0] = __builtin_amdgcn_mfma_f32_32x32x16_bf16(__builtin_bit_cast(bf16x8, PA), ATT_VF(d0 * 2), o[d0], 0, 0, 0); \
            o[d0] = __builtin_amdgcn_mfma_f32_32x32x16_bf16(__builtin_bit_cast(bf16x8, PB), ATT_VF(d0 * 2 + 1), o[d0], 0, 0, 0); } } while (0)
#define ATT_SMB(S, PA, PB) do { float sacc = 0.f; \
        _Pragma("unroll") for (int r = 0; r < 16; ++r) { S[r] = __builtin_amdgcn_exp2f(S[r]); sacc += S[r]; } \
        l_run += sacc; \
        PA = (u32x4){pk2(S[0], S[1]), pk2(S[2], S[3]), pk2(S[4], S[5]), pk2(S[6], S[7])}; PB = (u32x4){pk2(S[8], S[9]), pk2(S[10], S[11]), pk2(S[12], S[13]), pk2(S[14], S[15])}; } while (0)
#define ATT_PVH(slot, hh, PA, PB) do { const LAS unsigned char* vp_ = vp0 + (slot) + (hh) * 2048; \
        _Pragma("unroll") for (int d0 = 0; d0 < 2; ++d0) { const s16x4 l0_ = vtr(vp_ + d0 * 4096), h0_ = vtr(vp_ + d0 * 4096 + 512), l1_ = vtr(vp_ + d0 * 4096 + 1024), h1_ = vtr(vp_ + d0 * 4096 + 1536); \
            o[d0] = __builtin_amdgcn_mfma_f32_32x32x16_bf16(__builtin_bit_cast(bf16x8, PA), ((bf16x8){l0_[0], l0_[1], l0_[2], l0_[3], h0_[0], h0_[1], h0_[2], h0_[3]}), o[d0], 0, 0, 0); \
            o[d0] = __builtin_amdgcn_mfma_f32_32x32x16_bf16(__builtin_bit_cast(bf16x8, PB), ((bf16x8){l1_[0], l1_[1], l1_[2], l1_[3], h1_[0], h1_[1], h1_[2], h1_[3]}), o[d0], 0, 0, 0); } } while (0)
    ATT_DMA(0, 0); ATT_DMA(1, SLOT); if (2 < NT) ATT_DMA(2, 2 * SLOT);
    bf16x8 qr[6], kf[6];
    { const bf16* Qw = QF + (rowq0 + r32) * 768 + h * DQK + hi * 8;
#pragma unroll
        for (int d0 = 0; d0 < 6; ++d0) qr[d0] = *(const bf16x8*)(Qw + 16 * d0); }
    LAS float* wsf = (LAS float*)(F.lds + L_WS) + wid * 64;
    float m_run = 0.f, l_run = 0.f; f32x16 o[2]; o[0] = f32x16{}; o[1] = f32x16{}; f32x16 negm = f32x16{};
    const LAS unsigned char* kp0 = F.lds + r32 * 256;
    const int xk = r32 & 15;
    const LAS unsigned char* vp0 = F.lds + KSLOT + ((lane >> 4) & 1) * 32 + (lane & 3) * 8 + (4 * hi + ((lane & 15) >> 2)) * 64;
    u32x4 pw0, pw1; f32x16 sa, sb;
    ATT_BAR();
    int sl = 0, sl3 = 3 * SLOT;
#define ATT_ROT() do { sl = (sl == 3 * SLOT) ? 0 : sl + SLOT; sl3 = (sl3 == 3 * SLOT) ? 0 : sl3 + SLOT; } while (0)
#pragma unroll 1
    for (int i = 0; i < 5; ++i) {
        if (i + 3 < NT) ATT_DMA(i + 3, sl3);
        const int jb = i - 1;
#pragma unroll
        for (int hh = 0; hh < 2; ++hh) {
            const bool skip = (i == 0) ? (hh == 1) : (64 * jb + 32 * hh > 32 * wid + 31);
            if (!skip) {
                ATT_KLD(sl, hh); ATT_QKM(sa);
                if (i == 0) {
#pragma unroll
                    for (int r = 0; r < 16; ++r) if (crow(r, hi) >= NMETA) sa[r] = -INFINITY;
                } else if (64 * jb + 32 * hh + 31 > 32 * wid) {
                    const int qrel = 32 * wid + r32 - 64 * jb - 32 * hh;
#pragma unroll
                    for (int r = 0; r < 16; ++r) if (crow(r, hi) > qrel) sa[r] = -INFINITY;
                }
                ATT_SMA(sa); ATT_SMB(sa, pw0, pw1); ATT_PVH(sl, hh, pw0, pw1);
            }
        }
        ATT_BARC(i + 3 < NT); ATT_ROT();
    }
    if (NT > 5) {
        s16x4 vl[4], vh[4]; float rm;
        ATT_KLD(sl, 0); ATT_QKM(sa);
        ATT_KLD(sl, 1); __builtin_amdgcn_sched_barrier(0);
        ATT_RMAX(sa, rm); ATT_RESC(sa, rm);
        ATT_QKM(sb); ATT_SMB(sa, pw0, pw1);
        ATT_VLD(sl, 0);
#pragma unroll 1
        for (int i = 5; i < NT - 1; ++i) {
            if (i + 3 < NT) ATT_DMA(i + 3, sl3);
            const int sln = (sl == 3 * SLOT) ? 0 : sl + SLOT;
            ATT_KLD(sln, 0); __builtin_amdgcn_sched_barrier(0);
            ATT_PVM(pw0, pw1); ATT_RMAX(sb, rm);
            ATT_RESC(sb, rm);
            ATT_QKM(sa); ATT_SMB(sb, pw0, pw1);
            ATT_VLD(sl, 1);
            ATT_BARC(i + 3 < NT); ATT_ROT();
            ATT_KLD(sl, 1); __builtin_amdgcn_sched_barrier(0);
            ATT_PVM(pw0, pw1); ATT_RMAX(sa, rm);
            ATT_RESC(sa, rm);
            ATT_QKM(sb); ATT_SMB(sa, pw0, pw1);
            ATT_VLD(sl, 0);
        }
        ATT_PVM(pw0, pw1); ATT_RMAX(sb, rm);
        ATT_RESC(sb, rm);
        ATT_SMB(sb, pw0, pw1);
        ATT_VLD(sl, 1);
        ATT_PVM(pw0, pw1);
        ATT_BAR();
    }
    { const auto rr = __builtin_amdgcn_permlane32_swap(__float_as_uint(l_run), __float_as_uint(l_run), false, false); l_run = __uint_as_float(rr[0]) + __uint_as_float(rr[1]); }
    if (hi == 0) wsf[32 + r32] = l_run;
    float rli[16];
#pragma unroll
    for (int r = 0; r < 16; ++r) rli[r] = __builtin_amdgcn_rcpf(wsf[32 + crow(r, hi)]);
    { LAS bf16* stg = (LAS bf16*)(F.lds + L_OST) + wid * 2048;
#pragma unroll
        for (int r = 0; r < 16; ++r) { const int orow = crow(r, hi);
#pragma unroll
            for (int d0 = 0; d0 < 2; ++d0) stg[orow * 64 + d0 * 32 + r32] = (bf16)f2bf(o[d0][r] * rli[r]); }
        asm volatile("s_waitcnt lgkmcnt(0)" ::: "memory");
#pragma unroll
        for (int i = 0; i < 4; ++i) { const int row = i * 8 + (lane >> 3), ch = lane & 7; const u32x4 v = *(const LAS u32x4*)(stg + row * 64 + ch * 8);
            *(u32x4*)(O + (rowq0 + row) * 1024 + h * DV + ch * 8) = v; } }
    asm volatile("s_waitcnt lgkmcnt(0)\n\ts_barrier" ::: "memory");
#undef ATT_TIX
#undef ATT_DMA
#undef ATT_BAR
#undef ATT_BARC
#undef ATT_KLD
#undef ATT_QKM
#undef ATT_SMA
#undef ATT_RMAX
#undef ATT_RESC
#undef ATT_VLD
#undef ATT_VF
#undef ATT_PVM
#undef ATT_SMB
#undef ATT_PVH
#undef ATT_ROT
}
__device__ __forceinline__ void attn_phase(Ctx& F) {
    for (int v = F.vcu; v < 256; v += F.G) { const int bh = v >> 2, s = v & 3;
#pragma unroll 1
        for (int i = 0; i < 4; ++i) { const int qb = (i == 0) ? s : (i == 1) ? 7 - s : (i == 2) ? 8 + s : 15 - s; attn_unit(F, bh >> 3, bh & 7, qb); } }
}
}

__device__ __forceinline__ void p8_router(Ctx& F) {
    LAS float* xch = (LAS float*)F.lds;
    volatile LAS int* cnt_l = (volatile LAS int*)(F.lds + LDSCTL_OFF + 1024); volatile LAS int* base_l = cnt_l + 32;
    const bf16* H1 = WSP(bf16, WS_H1B);
    int* gcount = (int*)(F.ctl + CW_CNT); int* LTOK = WSP(int, WS_LTOK); float* LW = WSP(float, WS_LW); float* LRS = WSP(float, WS_LRS); int* TOKPOS = WSP(int, WS_TOKPOS);
    for (int un = F.vcu; un < MT / 128; un += F.G) {
        if (F.tid < 32) cnt_l[F.tid] = 0;
        const int j = F.lane & 31, kh = F.lane >> 5, grp = F.wave & 3, kq = F.wave >> 2; const int token = un * 128 + 32 * grp + j;
        int te[4] = {0, 0, 0, 0}, sl[4] = {0, 0, 0, 0}; float tg[4] = {0.f, 0.f, 0.f, 0.f}; float rstd = 0.f;
        f32x16 acc = f32x16{}; float ss = 0.f;
        { const bf16* row = H1 + (size_t)token * DM + 512 * kq + 8 * kh;
          const bf16* a0 = WSP(bf16, WS_RW3) + ((size_t)(64 * kq + kh) * NE + j) * 8;
#pragma unroll 1
          for (int hf = 0; hf < 2; ++hf) {
            u32x4 hwa[16];
#pragma unroll
            for (int s2 = 0; s2 < 16; ++s2) hwa[s2] = *(const u32x4*)(row + 16 * (16 * hf + s2));
            __builtin_amdgcn_sched_barrier(0);
#pragma unroll
            for (int s2 = 0; s2 < 16; ++s2) { const int st = 16 * hf + s2; const u32x4 hw = hwa[s2]; f32x4 h0, h1; unpack8(hw, h0, h1);
                ss += ((h0[0] * h0[0] + h0[1] * h0[1]) + (h0[2] * h0[2] + h0[3] * h0[3])) + ((h1[0] * h1[0] + h1[1] * h1[1]) + (h1[2] * h1[2] + h1[3] * h1[3]));
                const bf16x8 hb = __builtin_bit_cast(bf16x8, hw);
                const bf16x8 ah = *(const bf16x8*)(a0 + 512 * st), am = *(const bf16x8*)(a0 + (size_t)NE * DM + 512 * st), al = *(const bf16x8*)(a0 + (size_t)2 * NE * DM + 512 * st);
                acc = __builtin_amdgcn_mfma_f32_32x32x16_bf16(al, hb, acc, 0, 0, 0); acc = __builtin_amdgcn_mfma_f32_32x32x16_bf16(am, hb, acc, 0, 0, 0); acc = __builtin_amdgcn_mfma_f32_32x32x16_bf16(ah, hb, acc, 0, 0, 0); } } }
        if (kq == 1) { LAS float* xp = xch + grp * 17 * 64 + F.lane;
#pragma unroll
            for (int r = 0; r < 16; ++r) xp[r * 64] = acc[r];
            xp[16 * 64] = ss; }
        __syncthreads();
        if (kq == 0) {
            { const LAS float* xp = xch + grp * 17 * 64 + F.lane;
#pragma unroll
                for (int r = 0; r < 16; ++r) acc[r] += xp[r * 64];
                ss += xp[16 * 64]; }
            ss += __shfl_xor(ss, 32);
            rstd = 1.f / sqrtf(ss * (1.f / DM) + NORM_EPS);
            float cv[8]; int ci[8];
            float lv[16];
#pragma unroll
            for (int r = 0; r < 16; ++r) lv[r] = acc[r] * rstd + F.router_b[att::crow(r, kh)];
#pragma unroll
            for (int k = 0; k < 4; ++k) { float bv = -INFINITY; int bi = 0;
#pragma unroll
                for (int r = 0; r < 16; ++r) { const bool better = lv[r] > bv; bv = better ? lv[r] : bv; bi = better ? r : bi; }
#pragma unroll
                for (int r = 0; r < 16; ++r) if (r == bi) lv[r] = -INFINITY;
                cv[k] = bv; ci[k] = att::crow(bi, kh); }
#pragma unroll
            for (int k = 0; k < 4; ++k) { cv[4 + k] = __shfl_xor(cv[k], 32); ci[4 + k] = __shfl_xor(ci[k], 32); }
#pragma unroll
            for (int k = 0; k < 4; ++k) { float bv = -INFINITY; int bi = 1 << 20, bp = 0;
#pragma unroll
                for (int c = 0; c < 8; ++c) { const bool better = (cv[c] > bv) || (cv[c] == bv && ci[c] < bi); bv = better ? cv[c] : bv; bi = better ? ci[c] : bi; bp = better ? c : bp; }
#pragma unroll
                for (int c = 0; c < 8; ++c) if (c == bp) cv[c] = -INFINITY;
                tg[k] = bv; te[k] = bi; }
            { const float e1 = __expf(tg[1] - tg[0]), e2 = __expf(tg[2] - tg[0]), e3 = __expf(tg[3] - tg[0]); const float inv = 1.f / (1.f + e1 + e2 + e3); tg[0] = inv; tg[1] = e1 * inv; tg[2] = e2 * inv; tg[3] = e3 * inv; }
            if (kh == 0) {
#pragma unroll
                for (int k = 0; k < 4; ++k) sl[k] = __hip_atomic_fetch_add((LAS int*)&cnt_l[te[k]], 1, __ATOMIC_RELAXED, __HIP_MEMORY_SCOPE_WORKGROUP); }
        }
        __syncthreads();
        if (F.tid < 32) base_l[F.tid] = atomicAdd(gcount + F.tid, cnt_l[F.tid]);
        __syncthreads();
        if (kq == 0 && kh == 0) {
#pragma unroll
            for (int k = 0; k < 4; ++k) { const int slot = base_l[te[k]] + sl[k]; const size_t li = (size_t)te[k] * ECAP + slot;
                LTOK[li] = token; LW[li] = tg[k]; LRS[li] = rstd; TOKPOS[token * 4 + k] = te[k] * ECAP + slot; } }
        __syncthreads();
    }
}

__device__ __forceinline__ void moe_table(Ctx& F) {
    volatile LAS int* tb = (volatile LAS int*)(F.lds + LDSCTL_OFF); volatile LAS int* cnt = (volatile LAS int*)(F.lds + LDSCTL_OFF + 256);
    if (F.tid < 64) { const int* gcount = (const int*)(F.ctl + CW_CNT); const int c = (F.lane < NE) ? gcount[F.lane] : 0; const int nt = (c + 255) >> 8;
        int incl = nt;
#pragma unroll
        for (int o = 1; o < 32; o <<= 1) { const int v = __shfl_up(incl, o); if ((F.lane & 31) >= o) incl += v; }
        if (F.lane < NE) { cnt[F.lane] = c; tb[F.lane] = incl - nt; if (F.lane == NE - 1) tb[NE] = incl; } }
    __syncthreads();
    { const int TT = tb[NE];
      for (int mt = F.tid; mt < TT; mt += 512) { int e = 0;
#pragma unroll
          for (int st = 16; st >= 1; st >>= 1) if (e + st < NE && tb[e + st] <= mt) e += st;
          tb[512 + mt] = e; } }
    __syncthreads();
}

__device__ __forceinline__ void p11_combine(Ctx& F) {
    const volatile LAS int* tb = (const volatile LAS int*)(F.lds + LDSCTL_OFF);
    const int gw = F.vcu * 8 + F.wave, NGW = F.G * 8;
    const bf16* H1 = WSP(bf16, WS_H1B); const unsigned char* Y = WSP(unsigned char, WS_Y); const int* TOKPOS = WSP(int, WS_TOKPOS);
    typedef int i32x4v __attribute__((ext_vector_type(4)));
    const i32x4v* TP4 = (const i32x4v*)TOKPOS;
    i32x4v tp[2]; { const int m0 = gw, m1 = gw + NGW; tp[0] = TP4[m0 < MT ? m0 : 0]; tp[1] = TP4[m1 < MT ? m1 : 0]; }
    for (int mb = gw; mb < MT; mb += 2 * NGW) {
        i32x4v tn[2]; { const int n0 = mb + 2 * NGW, n1 = mb + 3 * NGW; tn[0] = TP4[n0 < MT ? n0 : 0]; tn[1] = TP4[n1 < MT ? n1 : 0]; }
        u32x4 hw[2][2], yw[2][4];
#pragma unroll
        for (int q = 0; q < 2; ++q) { const int m = mb + q * NGW; const int mm = m < MT ? m : mb;
            const u32x4* hp = (const u32x4*)(H1 + (size_t)mm * DM + 16 * F.lane); hw[q][0] = __builtin_nontemporal_load(hp); hw[q][1] = __builtin_nontemporal_load(hp + 1);
#pragma unroll
            for (int k = 0; k < 4; ++k) { const int p = tp[q][k], e = p >> 15, slot = p & (ECAP - 1); const size_t yr = (size_t)tb[e] * 256 + slot;
                yw[q][k] = __builtin_nontemporal_load((const u32x4*)(Y + yr * DM + 16 * F.lane)); } }
#pragma unroll
        for (int q = 0; q < 2; ++q) { const int m = mb + q * NGW; if (m < MT) {
            f32x4 a0, a1, a2, a3; unpack8(hw[q][0], a0, a1); unpack8(hw[q][1], a2, a3);
            f32x4 s0 = {0.f, 0.f, 0.f, 0.f}, s1 = s0, s2 = s0, s3 = s0;
#pragma unroll
            for (int k = 0; k < 4; ++k) { const u32x4 y = yw[q][k];
                { const f32x2 p0 = __builtin_amdgcn_cvt_pk_f32_fp8((int)y.x, false), p1 = __builtin_amdgcn_cvt_pk_f32_fp8((int)y.x, true); s0[0] += p0[0]; s0[1] += p0[1]; s0[2] += p1[0]; s0[3] += p1[1]; }
                { const f32x2 p0 = __builtin_amdgcn_cvt_pk_f32_fp8((int)y.y, false), p1 = __builtin_amdgcn_cvt_pk_f32_fp8((int)y.y, true); s1[0] += p0[0]; s1[1] += p0[1]; s1[2] += p1[0]; s1[3] += p1[1]; }
                { const f32x2 p0 = __builtin_amdgcn_cvt_pk_f32_fp8((int)y.z, false), p1 = __builtin_amdgcn_cvt_pk_f32_fp8((int)y.z, true); s2[0] += p0[0]; s2[1] += p0[1]; s2[2] += p1[0]; s2[3] += p1[1]; }
                { const f32x2 p0 = __builtin_amdgcn_cvt_pk_f32_fp8((int)y.w, false), p1 = __builtin_amdgcn_cvt_pk_f32_fp8((int)y.w, true); s3[0] += p0[0]; s3[1] += p0[1]; s3[2] += p1[0]; s3[3] += p1[1]; } }
            a0 += s0 * Y8_INV; a1 += s1 * Y8_INV; a2 += s2 * Y8_INV; a3 += s3 * Y8_INV;
            f32x4* op = (f32x4*)(F.out + (size_t)m * DM + 16 * F.lane); op[0] = a0; op[1] = a1; op[2] = a2; op[3] = a3; } }
        tp[0] = tn[0]; tp[1] = tn[1];
    }
}

#define LDS_TB ((const volatile LAS int*)(F.lds + LDSCTL_OFF))
#define LDS_CNT ((const volatile LAS int*)(F.lds + LDSCTL_OFF + 256))
__device__ __forceinline__ void ph1_inproj(Ctx& F) { p1_meta(F);
    pg8::Dense P; P.init(WSP(bf16, INPROJ_FP8 ? WS_XQ : WS_XN), WSP(bf16, WS_WIN), MT, NINP, INPROJ_FP8 ? DM / 2 : DM, F.G, (int)blockIdx.x);
    EpiInProj E{WSP(bf16, WS_HG), WSP(bf16, WS_QLAT), WSP(bf16, WS_KVLAT), WSP(bf16, WS_G), WSP(bf16, WS_G) + (size_t)MT * 1024, F.gate_b, WSP(float, WS_KPESS), WSP(float, WS_RSX), WSP(float, WS_RSQ), WSP(float, WS_RSC)};
    pg8::gemm_phase<pg8::Dense, EpiInProj, INPROJ_FP8 != 0>(F.lds, P, E); }
#ifndef PROBE_P3
#define PROBE_P3 0
#endif
__device__ __forceinline__ void ph3_smallgemms(Ctx& F) { p2_thin(F); p4_headnorm(F);
#if PROBE_P3 == 1
    __syncthreads(); p2_thin(F); p4_headnorm(F);
#endif
    { pg8::Dense P; P.init(WSP(bf16, WS_QLAT), WSP(bf16, WS_WQB), MT, 1024, 256, F.G, (int)blockIdx.x); EpiQHead E{WSP(bf16, WS_QF), WSP(float, WS_RSQ), F.q_nw, WSP(float, WS_ROPE), F.lds}; pg8::gemm_phase(F.lds, P, E); }
    { pg8::Dense P; P.init(WSP(bf16, WS_KVLAT), WSP(bf16, WS_WKVB), MT, 1024, 256, F.G, (int)blockIdx.x); EpiKVHead E{WSP(bf16, WS_KF), WSP(bf16, WS_KVRAW), WSP(bf16, WS_KVLAT), WSP(float, WS_RSC), WSP(float, WS_KPESS), F.k_nw, WSP(float, WS_ROPE), F.lds}; pg8::gemm_phase(F.lds, P, E); }
 }
__device__ __forceinline__ void ph6_wo(Ctx& F) { pg8::Dense P; P.init(WSP(bf16, WS_HCO), WSP(bf16, WS_W2T), MT, 1024, 1024, F.G, (int)blockIdx.x); EpiMix E{WSP(bf16, WS_MIX), WSP(bf16, WS_G), WSP(bf16, WS_G) + (size_t)MT * 1024}; pg8::gemm_phase<pg8::Dense, EpiMix, false, true>(F.lds, P, E); }
__device__ __forceinline__ void ph7_wout(Ctx& F) { pg8::Dense P; P.init(WSP(bf16, WS_MIX), WSP(bf16, WS_WOUT), MT, 1024, 1024, F.G, (int)blockIdx.x); EpiResid E{WSP(bf16, WS_XN), WSP(bf16, WS_H1B), WSP(unsigned char, WS_H1Q)}; pg8::gemm_phase<pg8::Dense, EpiResid, false, true>(F.lds, P, E); }
__device__ __forceinline__ void ph9_moe1(Ctx& F) { moe_table(F);
    pg8::Moe<true> P{WSP(bf16, WS_H1Q), WSP(bf16, WS_WGU), DM / 2, 8, F.G, F.vcu, WSP(int, WS_LTOK), LDS_TB, LDS_CNT};
    EpiSwiGLU E{WSP(unsigned char, WS_ACT), F.b_gu, WSP(float, WS_LRS), LDS_TB}; pg8::gemm_phase<pg8::Moe<true>, EpiSwiGLU, true>(F.lds, P, E); }
__device__ __forceinline__ void ph10_moe2(Ctx& F) { moe_table(F);
    pg8::Moe<false> P{WSP(bf16, WS_ACT), WSP(bf16, WS_WD), DFF / 2, 4, F.G, F.vcu, nullptr, LDS_TB, LDS_CNT};
    EpiDown E{WSP(unsigned char, WS_Y), F.b_d, WSP(float, WS_LW), LDS_TB}; pg8::gemm_phase<pg8::Moe<false>, EpiDown, true, true>(F.lds, P, E); }
__device__ __forceinline__ void ph11_combine(Ctx& F) { moe_table(F); p11_combine(F); }

struct Args { const float* in[25]; float* out; unsigned char* ws; int ph_lo, ph_hi; };
__global__ void __launch_bounds__(512, 2) mk_fwd(Args args) {
    extern __shared__ __attribute__((aligned(16))) unsigned char lds_raw[];
    Ctx F;
    F.lds = (LAS unsigned char*)lds_raw; F.ws = args.ws; F.ctl = (gu32*)(args.ws + WS_CTL);
    F.tid = threadIdx.x; F.lane = F.tid & 63; F.wave = __builtin_amdgcn_readfirstlane(F.tid >> 6);
    F.G = gridDim.x; { const int bx = blockIdx.x; F.vcu = (F.G % 8 == 0) ? (bx % 8) * (F.G / 8) + bx / 8 : bx; }
    F.x = args.in[0]; F.meta = args.in[1]; F.attn_nw = args.in[2]; F.w_in = args.in[3]; F.dw_w = args.in[4]; F.dw_b = args.in[5]; F.ln_w = args.in[6]; F.ln_b = args.in[7]; F.pw2_w = args.in[8];
    F.qa_nw = args.in[9]; F.w_qb = args.in[10]; F.kva_nw = args.in[11]; F.w_kvb = args.in[12]; F.q_nw = args.in[13]; F.k_nw = args.in[14]; F.w_o = args.in[15]; F.gate_b = args.in[16]; F.w_out = args.in[17];
    F.ffn_nw = args.in[18]; F.router_w = args.in[19]; F.router_b = args.in[20]; F.w_gu = args.in[21]; F.b_gu = args.in[22]; F.w_d = args.in[23]; F.b_d = args.in[24]; F.out = args.out;
    for (int u = F.tid; u < (LDS_BYTES - LDSCTL_OFF) / 4; u += 512) ((LAS unsigned*)(F.lds + LDSCTL_OFF))[u] = 0u;
    __syncthreads();
    const int lo = args.ph_lo, hi = args.ph_hi;
    XcdBarrier bar; bar.bar = (unsigned*)(F.ctl + CW_BAR); bar.x = 0; bar.st = nullptr;
    if (hi - lo > 1) bar = xcd_barrier_post((unsigned*)(F.ctl + CW_BAR), (volatile LAS unsigned*)(F.lds + LDSCTL_OFF + 512));
#ifdef ONLY_PHASE
#define IN(k) ((k) == ONLY_PHASE && lo <= (k) && (k) < hi)
#else
#define IN(k) (lo <= (k) && (k) < hi)
#endif
#define SEAM(k) do { if (IN(k) && IN((k) + 1)) xcd_barrier(bar); } while (0)
#if USE_REFRESH
#define REFRESH() do { int _t = threadIdx.x; asm volatile("" : "+v"(_t)); F.tid = _t; F.lane = _t & 63; F.wave = __builtin_amdgcn_readfirstlane(_t >> 6); } while (0)
#else
#define REFRESH() do { } while (0)
#endif
#define PHASE(k, call) do { if (IN(k)) { REFRESH(); call; if (PROBE_REPEAT == (k)) { xcd_barrier(bar); call; } } SEAM(k); } while (0)

    PHASE(0, p0_prologue(F));
    PHASE(1, ph1_inproj(F));
    PHASE(3, ph3_smallgemms(F));
    PHASE(5, att::attn_phase(F));
    PHASE(6, ph6_wo(F));
    PHASE(7, ph7_wout(F));
#if PROBE_REPEAT == 8
    if (IN(8)) { REFRESH(); p8_router(F); xcd_barrier(bar); if (blockIdx.x == 0 && F.tid < NE) ((int*)(F.ctl + CW_CNT))[F.tid] = 0; xcd_barrier(bar); p8_router(F); } SEAM(8);
#else
    PHASE(8, p8_router(F));
#endif
    PHASE(9, ph9_moe1(F));
    PHASE(10, ph10_moe2(F));
    PHASE(11, ph11_combine(F));
#undef IN
#undef SEAM
#undef PHASE
}

extern "C" void kernel_launch(void* const* d_in, const int* in_sizes, int n_in, void* d_out, int out_size, void* d_ws, size_t ws_size, hipStream_t stream) {
    static int grid = 0;
    if (grid == 0) {
        if (n_in != 25 || in_sizes[0] != MT * DM || out_size != MT * DM || ws_size < WS_END) { fprintf(stderr, "kernel_launch: unexpected shapes (n_in %d, in0 %d, out %d, ws %zu < %zu); nothing launched\n", n_in, n_in > 0 ? in_sizes[0] : -1, out_size, ws_size, (size_t)WS_END); grid = -1; return; }
        int dev = 0, cus = 0, per_cu = 0;
        if (hipGetDevice(&dev) != hipSuccess || hipDeviceGetAttribute(&cus, hipDeviceAttributeMultiprocessorCount, dev) != hipSuccess) { grid = -1; return; }
        if (hipFuncSetAttribute((const void*)mk_fwd, hipFuncAttributeMaxDynamicSharedMemorySize, LDS_BYTES) != hipSuccess) { fprintf(stderr, "kernel_launch: hipFuncSetAttribute failed\n"); grid = -1; return; }
        if (hipOccupancyMaxActiveBlocksPerMultiprocessor(&per_cu, (const void*)mk_fwd, 512, LDS_BYTES) != hipSuccess || per_cu < 1) fprintf(stderr, "kernel_launch: note: occupancy query reports %d\n", per_cu);
        (void)hipGetLastError();
        grid = cus;
    }
    if (grid < 0) return;
    if (hipMemsetAsync((char*)d_ws + WS_CTL, 0, CTL_ZERO_BYTES, stream) != hipSuccess) return;
    Args a{};
    for (int i = 0; i < 25; ++i) a.in[i] = (const float*)d_in[i];
    a.out = (float*)d_out; a.ws = (unsigned char*)d_ws;
#if MK_ONE_LAUNCH
    a.ph_lo = 0; a.ph_hi = NPH;
    hipLaunchKernelGGL(mk_fwd, dim3(grid), dim3(512), LDS_BYTES, stream, a);
#else
    for (int p = 0; p < NPH; ++p) { a.ph_lo = p; a.ph_hi = p + 1; hipLaunchKernelGGL(mk_fwd, dim3(grid), dim3(512), LDS_BYTES, stream, a); }
#endif
}
```

```cpp
#include <hip/hip_runtime.h>
#include <cstdio>
#include <cstdint>

#define GAS __attribute__((address_space(1)))
#define LAS __attribute__((address_space(3)))
typedef unsigned short bf16;
typedef unsigned u32x4 __attribute__((ext_vector_type(4)));
typedef unsigned u32x2 __attribute__((ext_vector_type(2)));
typedef float f32x2 __attribute__((ext_vector_type(2)));
typedef float f32x4 __attribute__((ext_vector_type(4)));
typedef float f32x16 __attribute__((ext_vector_type(16)));
typedef short bf16x8 __attribute__((ext_vector_type(8)));
typedef short s16x4 __attribute__((ext_vector_type(4)));
typedef int i32x4 __attribute__((ext_vector_type(4)));
typedef int i32x8 __attribute__((ext_vector_type(8)));
typedef GAS unsigned gu32;

#ifndef PROBE_REPEAT
#define PROBE_REPEAT (-1)
#endif
#ifndef INPROJ_FP8
#define INPROJ_FP8 1
#endif
#ifndef PROBE_KLOOP2
#define PROBE_KLOOP2 0
#endif
#ifndef USE_REFRESH
#define USE_REFRESH 0
#endif
#ifndef RELAX_WAITS
#define RELAX_WAITS 0
#endif
#ifndef PROBE_EPI2
#define PROBE_EPI2 0
#endif
#ifndef PROBE_P2A
#define PROBE_P2A 0
#endif
#ifndef PROBE_P2B
#define PROBE_P2B 0
#endif
#ifndef MK_ONE_LAUNCH
#define MK_ONE_LAUNCH 1
#endif

constexpr int NB = 8, SEQ = 4096, DM = 1024, MT = NB * SEQ;
constexpr int NMETA = 16;
constexpr int CDIM = 512, CWID = 31;
constexpr int NH = 8, DNOPE = 64, DROPE = 32, DQK = 96, DV = 64, QLR = 256, KVLR = 128;
constexpr int INC = 3488, NINP = 3584;
constexpr int NE = 32, DFF = 1024, ECAP = 32768;
constexpr int LPC = 4128, HGOFF = 32;
constexpr int LPK = 4160, KOFF = 64;
constexpr int PMC = 1184;
constexpr float NORM_EPS = 1e-6f;
constexpr float SW_LIMIT = 7.0f, SW_ALPHA = 1.702f;
constexpr float QSCALE = 0.10206207261596577f * 1.4426950408889634f;
constexpr int NPH = 12;

constexpr size_t MiB = 1u << 20;
constexpr size_t WS_CTL = 0, CTL_ZERO_BYTES = 1 * MiB;
constexpr int CW_TMO = 0, CW_CODE = 1, CW_BAR = 4096, CW_CNT = 8192, CW_PM = 16384;
constexpr size_t WS_METARS = 1 * MiB;
constexpr size_t WS_KVMETA = 1 * MiB + 4096;
constexpr size_t WS_ROPE = 1 * MiB + 512 * 1024;
constexpr size_t WS_RSQ = 156 * MiB, WS_RSC = 157 * MiB;
constexpr size_t WS_KPESS = 2 * MiB + 384 * 1024;
constexpr size_t WS_RWP = 2 * MiB + 512 * 1024;
constexpr size_t WS_RW3 = 2 * MiB + 768 * 1024;
constexpr size_t WS_TOKPOS = 3 * MiB;
constexpr size_t WS_LTOK = 4 * MiB, WS_LW = 8 * MiB, WS_LRS = 12 * MiB;
constexpr size_t WS_WIN = 16 * MiB, WS_WPW2 = 23 * MiB, WS_WQB = 24 * MiB, WS_WKVB = 24 * MiB + 512 * 1024, WS_WO = 25 * MiB, WS_WOUT = 26 * MiB;
constexpr size_t WS_WGU = 28 * MiB, WS_WD = 92 * MiB;
constexpr size_t WS_XQ = 124 * MiB;
constexpr float XQ_SCALE = 16.f;
constexpr size_t WS_H1Q = 124 * MiB;
constexpr size_t WS_W2T = 220 * MiB, WS_H1B = 348 * MiB;
constexpr size_t WS_BIG = 412 * MiB;
constexpr size_t WS_ACT = WS_BIG, WS_Y = WS_BIG + 273 * MiB;
constexpr size_t WS_XN = WS_BIG + 289 * MiB, WS_QF = WS_BIG;
constexpr size_t WS_RSX = 2 * MiB + 640 * 1024;
constexpr size_t WS_G = WS_BIG + 64 * MiB, WS_HG = WS_BIG + 192 * MiB, WS_MIX = WS_BIG + 192 * MiB;
constexpr size_t WS_QLAT = WS_BIG + 225 * MiB, WS_KVLAT = WS_BIG + 241 * MiB, WS_HC = WS_BIG + 257 * MiB;
constexpr size_t WS_QRAW = WS_BIG + 289 * MiB, WS_KVRAW = WS_BIG + 353 * MiB, WS_HCO = WS_BIG + 418 * MiB, WS_KF = WS_BIG + 482 * MiB;
constexpr size_t WS_PMP = WS_BIG + 564 * MiB, WS_PMF = WS_BIG + 565 * MiB;
constexpr size_t WS_END = WS_BIG + 566 * MiB;
static_assert(WS_Y + (size_t)139520 * 2048 <= WS_END && WS_HG + (size_t)NB * LPC * CDIM * 2 <= WS_QLAT && WS_KVRAW + (size_t)NB * LPK * 2048 <= WS_HCO && WS_KF + (size_t)NB * LPK * 1536 <= WS_BIG + 531 * MiB, "ws map");

constexpr int RING_BYTES = 131072;
constexpr int LDSCTL_OFF = RING_BYTES;
constexpr int LDS_BYTES = 147456;

#define RLX_AGENT __ATOMIC_RELAXED, __HIP_MEMORY_SCOPE_AGENT
#define LDS_WAIT() asm volatile("s_waitcnt lgkmcnt(0)" ::: "memory")
#define VM_WAIT() asm volatile("s_waitcnt vmcnt(0)" ::: "memory")
__device__ __forceinline__ unsigned f2bf(float f) { unsigned u = __builtin_bit_cast(unsigned, f); return (u + 0x7fffu + ((u >> 16) & 1u)) >> 16; }
typedef __bf16 hwbf16x2 __attribute__((ext_vector_type(2)));
__device__ __forceinline__ unsigned pk2(float lo, float hi) { const f32x2 v = {lo, hi}; return __builtin_bit_cast(unsigned, __builtin_convertvector(v, hwbf16x2)); }
__device__ __forceinline__ float bflo(unsigned w) { return __builtin_bit_cast(float, w << 16); }
__device__ __forceinline__ float bfhi(unsigned w) { return __builtin_bit_cast(float, w & 0xffff0000u); }
constexpr float Y8_SCALE = 8.f, Y8_INV = 1.f / 8.f;
constexpr float W8_SCALE = 64.f, W8_INV = 1.f / 64.f;
__device__ __forceinline__ unsigned pk4_fp8(float a, float b, float c, float d) { int v = __builtin_amdgcn_cvt_pk_fp8_f32(a, b, 0, false); v = __builtin_amdgcn_cvt_pk_fp8_f32(c, d, v, true); return (unsigned)v; }
__device__ __forceinline__ float sigmoid_f(float x) { return __builtin_amdgcn_rcpf(1.f + __expf(-x)); }
__device__ __forceinline__ float sum16(float v) {
#pragma unroll
    for (int o = 1; o < 16; o <<= 1) v += __shfl_xor(v, o);
    return v;
}
__device__ __forceinline__ float wave_sum(float v) {
#pragma unroll
    for (int o = 1; o < 64; o <<= 1) v += __shfl_xor(v, o);
    return v;
}

#define XB_TMO      128
#define XB_XCNT(j)  (256  + 64 * (j))
#define XB_XSUB(j)  (1280 + 64 * (j))
#define XB_XGEN(j)  (2304 + 64 * (j))
#define XB_TOP      3328
#define XB_TOPGEN   3392
#define XCD_BAR_WORDS 3456
#define XB_SPIN_CAP (1u << 18)
__device__ __forceinline__ unsigned xb_ld(unsigned* p)              { return __hip_atomic_load(p, __ATOMIC_RELAXED, __HIP_MEMORY_SCOPE_AGENT); }
__device__ __forceinline__ unsigned xb_add(unsigned* p, unsigned v) { return __hip_atomic_fetch_add(p, v, __ATOMIC_RELAXED, __HIP_MEMORY_SCOPE_AGENT); }
__device__ __forceinline__ unsigned xb_xcc_id() { return (unsigned)__builtin_amdgcn_s_getreg((3 << 11) | 20) & 0xFu; }
#define XB_SPIN(cond, bar) do { unsigned _sp = 0; while (cond) { __builtin_amdgcn_s_sleep(1); \
    if ((++_sp & 255u) == 0u) { if (xb_ld(&(bar)[XB_TMO])) break; if (_sp > XB_SPIN_CAP) { atomicAdd(&(bar)[XB_TMO], 1u); break; } } } } while (0)
struct XcdBarrier { unsigned* bar; unsigned x; volatile LAS unsigned* st; };
__device__ __forceinline__ XcdBarrier xcd_barrier_post(unsigned* bar, volatile LAS unsigned* st) {
    XcdBarrier b; b.bar = bar; b.x = xb_xcc_id(); b.st = st;
    if (threadIdx.x == 0) (void)xb_add(&bar[XB_XCNT(b.x)], 1u);
    return b;
}
__device__ __forceinline__ void xcd_barrier_complete(unsigned* bar, unsigned x, unsigned& nloc, unsigned& nx) {
    const unsigned G = gridDim.x * gridDim.y * gridDim.z;
    unsigned sum, cnt, mine, sp = 0u;
    for (;;) {
        sum = 0u; cnt = 0u; mine = 0u;
#pragma unroll
        for (unsigned j = 0; j < 16; ++j) { const unsigned c = xb_ld(&bar[XB_XCNT(j)]); sum += c; cnt += (c > 0u) ? 1u : 0u; mine = (j == x) ? c : mine; }
        if (sum == G) break;
        __builtin_amdgcn_s_sleep(1);
        if ((++sp & 255u) == 0u) { if (xb_ld(&bar[XB_TMO])) break; if (sp > XB_SPIN_CAP) { atomicAdd(&bar[XB_TMO], 1u); break; } }
    }
    nloc = mine > 0u ? mine : 1u; nx = cnt > 0u ? cnt : 1u;
}
__device__ __forceinline__ void xcd_barrier(const XcdBarrier& b) {
    asm volatile("s_waitcnt vmcnt(0)" ::: "memory");
    __syncthreads();
    if (threadIdx.x == 0) {
        unsigned* bar = b.bar;
        __builtin_amdgcn_s_waitcnt(0);
        unsigned nloc = b.st[0], nx = b.st[1];
        if (nloc == 0u) { xcd_barrier_complete(bar, b.x, nloc, nx); b.st[0] = nloc; b.st[1] = nx; }
        const unsigned old = xb_add(&bar[XB_XSUB(b.x)], 1u);
        const unsigned gen = old / nloc;
        if (old + 1u == (gen + 1u) * nloc) {
            __builtin_amdgcn_fence(__ATOMIC_RELEASE, "agent");
            asm volatile("s_waitcnt vmcnt(0)" ::: "memory");
            const unsigned og = xb_add(&bar[XB_TOP], 1u);
            const unsigned tg = og / nx;
            if (og + 1u == (tg + 1u) * nx) xb_add(&bar[XB_TOPGEN], 1u);
            else XB_SPIN(xb_ld(&bar[XB_TOPGEN]) == tg, bar);
            xb_add(&bar[XB_XGEN(b.x)], 1u);
            __builtin_amdgcn_fence(__ATOMIC_ACQUIRE, "agent");
            asm volatile("s_waitcnt vmcnt(0)" ::: "memory");
        } else {
            XB_SPIN(xb_ld(&bar[XB_XGEN(b.x)]) == gen, bar);
            __builtin_amdgcn_fence(__ATOMIC_ACQUIRE, "agent");
            asm volatile("s_waitcnt vmcnt(0)" ::: "memory");
        }
    }
    __syncthreads();
}

namespace pg8 {
constexpr int BM = 256, BK = 64, HALF = 128, HTB = HALF * BK * 2, NXCD = 8, WGM = 8;
__host__ __device__ __forceinline__ int lds_byte(int r, int c) { const int st = (r >> 4) * 2 + (c >> 5), rr = r & 15, cc = c & 31, ob = rr * 64 + cc * 2; return st * 1024 + (ob ^ (((ob >> 9) & 1) << 5)); }
__host__ __device__ __forceinline__ void stage_rc(int b, int& R, int& C) { const int st = b / 1024, sb = b % 1024, swz = sb ^ (((sb >> 9) & 1) << 5); R = (st >> 1) * 16 + swz / 64; C = (st & 1) * 32 + (swz % 64) / 2; }
__host__ __device__ __forceinline__ int perm32(int rho) { const int n = rho >> 4, i = rho & 15; return 8 * (i >> 2) + 4 * n + (i & 3); }

struct Unit { int pm, pn, e, cnt; };

struct Dense {
    static constexpr bool GATHER = false;
    const bf16* A; const bf16* Bt; int K; int nM, nN, nwg, G, c;
    __device__ __forceinline__ void init(const bf16* A_, const bf16* Bt_, int M, int N, int K_, int G_, int c_) { A = A_; Bt = Bt_; K = K_; nM = M / BM; nN = N / BM; nwg = nM * nN; G = G_; c = c_; }
    __device__ __forceinline__ bool next(int i, Unit& u) const {
        const long L = (long)i * G + c; if (L >= nwg) return false;
        int wgid = (int)L; { const int q = nwg / NXCD, r = nwg % NXCD, xcd = wgid % NXCD, off = wgid / NXCD; wgid = (xcd < r ? xcd * (q + 1) : r * (q + 1) + (xcd - r) * q) + off; }
        const int nig = WGM * nN, gid = wgid / nig, fm = gid * WGM, gsz = (nM - fm) < WGM ? (nM - fm) : WGM;
        u.pm = fm + ((wgid % nig) % gsz); u.pn = (wgid % nig) / gsz; u.e = 0; u.cnt = 256; return true;
    }
    __device__ __forceinline__ const char* a_base(const Unit& u) const { return (const char*)A + (size_t)u.pm * BM * K * 2; }
    __device__ __forceinline__ const char* b_base(const Unit& u) const { return (const char*)Bt + (size_t)u.pn * BM * K * 2; }
    __device__ __forceinline__ void a_off(const Unit&, const int (&R)[2], const int (&C)[2], unsigned (&vo)[2][2]) const {
#pragma unroll
        for (int h = 0; h < 2; ++h)
#pragma unroll
            for (int i = 0; i < 2; ++i) vo[h][i] = (unsigned)((R[i] + HALF * h) * K + C[i]) * 2u;
    }
};

template <bool GATHER_> struct Moe {
    static constexpr bool GATHER = GATHER_;
    const bf16* A; const bf16* Bt; int K, nN, G, vcu; const int* ltok; const volatile LAS int* tb; const volatile LAS int* cnt;
    __device__ __forceinline__ bool next(int i, Unit& u) const {
        const int L = i * G + vcu; const int TT = __builtin_amdgcn_readfirstlane(tb[NE]); if (L >= TT * nN) return false;
        const int mt = L / nN; u.pn = L - mt * nN;
        const int e = __builtin_amdgcn_readfirstlane(tb[512 + mt]);
        u.e = e; u.pm = mt; const int rem = __builtin_amdgcn_readfirstlane(cnt[e]) - (mt - __builtin_amdgcn_readfirstlane(tb[e])) * BM; u.cnt = rem < BM ? rem : BM; return true;
    }
    __device__ __forceinline__ const char* a_base(const Unit& u) const { return GATHER ? (const char*)A : (const char*)A + (size_t)u.pm * BM * K * 2; }
    __device__ __forceinline__ const char* b_base(const Unit& u) const { return (const char*)Bt + ((size_t)u.e * nN + u.pn) * BM * K * 2; }
    __device__ __forceinline__ const int* idx_src(const Unit& u) const { return ltok + (size_t)u.e * ECAP + (u.pm - __builtin_amdgcn_readfirstlane(tb[u.e])) * BM; }
    __device__ __forceinline__ void a_idx(const Unit& u, const int (&R)[2], int (&tk)[2][2]) const {
        const int slot0 = (u.pm - __builtin_amdgcn_readfirstlane(tb[u.e])) * BM; const int* lt = ltok + (size_t)u.e * ECAP + slot0;
        const unsigned o0 = (unsigned)R[0] * 4u, o1 = (unsigned)R[1] * 4u;
        asm volatile("global_load_dword %0, %4, %6\n\tglobal_load_dword %1, %5, %6\n\tglobal_load_dword %2, %4, %6 offset:512\n\tglobal_load_dword %3, %5, %6 offset:512"
                     : "=&v"(tk[0][0]), "=&v"(tk[0][1]), "=&v"(tk[1][0]), "=&v"(tk[1][1]) : "v"(o0), "v"(o1), "s"(lt) : "memory");
    }
    __device__ __forceinline__ void a_fin(const Unit& u, const int (&R)[2], const int (&C)[2], int (&tk)[2][2], unsigned (&vo)[2][2]) const {
        asm volatile("" : "+v"(tk[0][0]), "+v"(tk[0][1]), "+v"(tk[1][0]), "+v"(tk[1][1]));
#pragma unroll
        for (int h = 0; h < 2; ++h)
#pragma unroll
            for (int i = 0; i < 2; ++i) { const int r = R[i] + HALF * h; const int tok = (r < u.cnt) ? tk[h][i] : 0; vo[h][i] = (unsigned)(tok * K + C[i]) * 2u; }
    }
    __device__ __forceinline__ void a_off(const Unit& u, const int (&R)[2], const int (&C)[2], unsigned (&vo)[2][2]) const {
        if constexpr (GATHER) {
            const int slot0 = (u.pm - __builtin_amdgcn_readfirstlane(tb[u.e])) * BM; const int* lt = ltok + (size_t)u.e * ECAP + slot0; int tk[2][2];
#pragma unroll
            for (int h = 0; h < 2; ++h)
#pragma unroll
                for (int i = 0; i < 2; ++i) tk[h][i] = lt[R[i] + HALF * h];
            asm volatile("" : "+v"(tk[0][0]), "+v"(tk[0][1]), "+v"(tk[1][0]), "+v"(tk[1][1]));
#pragma unroll
            for (int h = 0; h < 2; ++h)
#pragma unroll
                for (int i = 0; i < 2; ++i) { const int r = R[i] + HALF * h; const int tok = (r < u.cnt) ? tk[h][i] : 0; vo[h][i] = (unsigned)(tok * K + C[i]) * 2u; }
        } else {
#pragma unroll
            for (int h = 0; h < 2; ++h)
#pragma unroll
                for (int i = 0; i < 2; ++i) vo[h][i] = (unsigned)((R[i] + HALF * h) * K + C[i]) * 2u;
        }
    }
};

template <class Prob, class Epi, bool FP8 = false, bool ADJ = false>
__device__ __forceinline__ void gemm_phase(LAS unsigned char* lds, const Prob& P, const Epi& E) {
    const int tid = threadIdx.x, wid = __builtin_amdgcn_readfirstlane(tid >> 6), lane = tid & 63, wr = wid >> 2, wc = wid & 3, fr = lane & 15, fq = lane >> 4;
    const int K = P.K, nt = K / BK;
    constexpr bool PRE11 = RELAX_WAITS && !Epi::LDSX;
    int Rr[2], Cc[2]; unsigned voffB[2];
#pragma unroll
    for (int i = 0; i < 2; ++i) { int R, C; stage_rc(tid * 16 + i * 8192, R, C); const int rho = R & 31;
        const int Rb = ADJ ? (64 * (R >> 5) + 16 * ((rho >> 2) & 3) + 4 * (rho >> 4) + (rho & 3)) : ((R & ~31) + perm32(rho)); Rr[i] = R; Cc[i] = C; voffB[i] = (unsigned)(Rb * K + C) * 2u; }
    const size_t kstep = (size_t)(BK * 2);
    const size_t hstep = (size_t)(ADJ ? 8 : HALF) * K * 2;
    const unsigned ldsw = (unsigned)wid * 1024u;
    const int aoff = lds_byte(wr * 64 + fr, fq * 8), boff = lds_byte(wc * 32 + fr, fq * 8);
#define PG8_SA(b, h) (((b) * 2 + (h)) * HTB)
#define PG8_SB(b, h) ((4 + (b) * 2 + (h)) * HTB)
#define PG8_STAGE(bufoff, gbase, voff) do { const char* _g = (const char*)(gbase); asm volatile("" : "+s"(_g));     \
        _Pragma("unroll") for (int _i = 0; _i < 2; ++_i) \
        __builtin_amdgcn_global_load_lds((const unsigned*)(_g + (voff)[_i]), (LAS unsigned*)(lds + (bufoff) + ldsw + _i * 8192), 16, 0, 0); } while (0)
#define PG8_LD8(addr) __builtin_shufflevector(*(const LAS i32x4*)(addr), *(const LAS i32x4*)((addr) + 1024), 0, 1, 2, 3, 4, 5, 6, 7)
#define PG8_LDA(dst, b, h) do { _Pragma("unroll") for (int m = 0; m < 4; ++m) dst[m] = PG8_LD8(lds + PG8_SA(b, h) + aoff + m * 2048); } while (0)
#define PG8_LDB(dst, b, h) do { _Pragma("unroll") for (int n = 0; n < 2; ++n) dst[n] = PG8_LD8(lds + PG8_SB(b, h) + boff + n * 2048); } while (0)
#define PG8_LO(x) __builtin_bit_cast(bf16x8, __builtin_shufflevector(x, x, 0, 1, 2, 3))
#define PG8_HI(x) __builtin_bit_cast(bf16x8, __builtin_shufflevector(x, x, 4, 5, 6, 7))
#define PG8_MMA(ai, bj, At, Bt) do { __builtin_amdgcn_s_setprio(1); _Pragma("unroll") for (int m = 0; m < 4; ++m) _Pragma("unroll") for (int n = 0; n < 2; ++n) { \
        if constexpr (FP8) asm volatile("v_mfma_scale_f32_16x16x128_f8f6f4 %0, %1, %2, %0, %3, %3 op_sel_hi:[0,0,0]" : "+v"(acc[ai][bj][m][n]) : "v"(Bt[n]), "v"(At[m]), "v"(one_scale)); \
        else { acc[ai][bj][m][n] = __builtin_amdgcn_mfma_f32_16x16x32_bf16(PG8_LO(Bt[n]), PG8_LO(At[m]), acc[ai][bj][m][n], 0, 0, 0); \
               acc[ai][bj][m][n] = __builtin_amdgcn_mfma_f32_16x16x32_bf16(PG8_HI(Bt[n]), PG8_HI(At[m]), acc[ai][bj][m][n], 0, 0, 0); } } \
        __builtin_amdgcn_s_setprio(0); } while (0)
#define PG8_MMA_Z(ai, bj, At, Bt) do { __builtin_amdgcn_s_setprio(1); _Pragma("unroll") for (int m = 0; m < 4; ++m) _Pragma("unroll") for (int n = 0; n < 2; ++n) \
        asm volatile("v_mfma_scale_f32_16x16x128_f8f6f4 %0, %1, %2, 0, %3, %3 op_sel_hi:[0,0,0]" : "=&v"(acc[ai][bj][m][n]) : "v"(Bt[n]), "v"(At[m]), "v"(one_scale)); \
        __builtin_amdgcn_s_setprio(0); } while (0)
#define PG8_MMA2(ai, At, B0, B1) do { if constexpr (FP8) { if (zfirst) { PG8_MMA_Z(ai, 0, At, B0); PG8_MMA_Z(ai, 1, At, B1); } else { PG8_MMA(ai, 0, At, B0); PG8_MMA(ai, 1, At, B1); } } else { PG8_MMA(ai, 0, At, B0); PG8_MMA(ai, 1, At, B1); } } while (0)
#define PG8_WAIT_V(n) asm volatile("s_waitcnt vmcnt(" #n ")" ::: "memory")
#define PG8_WAIT_L(n) asm volatile("s_waitcnt lgkmcnt(" #n ")" ::: "memory")
#define PG8_BAR __builtin_amdgcn_s_barrier()
#define PG8_SCHED __builtin_amdgcn_sched_barrier(0)
    Unit cur, nxt; int ui = 0;
    if (!P.next(0, cur)) return;
    f32x4 acc[2][2][4][2];
    if constexpr (!FP8) {
#pragma unroll
    for (int a = 0; a < 2; ++a)
#pragma unroll
        for (int b = 0; b < 2; ++b)
#pragma unroll
            for (int m = 0; m < 4; ++m)
#pragma unroll
                for (int n = 0; n < 2; ++n) acc[a][b][m][n] = (f32x4){0.f, 0.f, 0.f, 0.f}; }
    int one_scale = 0x7f7f7f7f; asm volatile("" : "+v"(one_scale));
    i32x8 At[4], B0[2], B1[2];
    unsigned vc[2][2], vn[2][2];
    P.a_off(cur, Rr, Cc, vc);
    const char* cA = P.a_base(cur); const char* cB = P.b_base(cur);
    PG8_STAGE(PG8_SB(0, 0), cB, voffB); PG8_STAGE(PG8_SB(0, 1), cB + hstep, voffB); PG8_STAGE(PG8_SA(0, 0), cA, vc[0]); PG8_STAGE(PG8_SA(0, 1), cA, vc[1]);
    if (wr == 1) PG8_BAR;
    PG8_WAIT_V(2); PG8_BAR;
    PG8_STAGE(PG8_SB(1, 0), cB + kstep, voffB); PG8_STAGE(PG8_SA(1, 0), cA + kstep, vc[0]); PG8_STAGE(PG8_SB(1, 1), cB + hstep + kstep, voffB);
    PG8_WAIT_V(6); PG8_BAR;
    for (;;) {
        const bool has_next = P.next(ui + 1, nxt);
        const char* nA = has_next ? P.a_base(nxt) : cA; const char* nB = has_next ? P.b_base(nxt) : cB;
        int tkr[2][2] = {{0, 0}, {0, 0}};
        if constexpr (Prob::GATHER) { if (has_next) P.a_idx(nxt, Rr, tkr); }
#pragma unroll
        for (int h = 0; h < 2; ++h)
#pragma unroll
            for (int i = 0; i < 2; ++i) vn[h][i] = vc[h][i];
        if constexpr (Prob::GATHER) { if (nt < 6 && has_next) { PG8_WAIT_V(0); P.a_fin(nxt, Rr, Cc, tkr, vn); } }
        const bool post = ui > 0;
#if PROBE_KLOOP2
        const int ntt = ((PROBE_KLOOP2 == 1 && FP8) || (PROBE_KLOOP2 == 2 && !FP8 && nt == 16)) ? 2 * nt : nt;
#else
        const int ntt = nt;
#endif
        for (int t = 0; t < ntt; t += 2) {
#if PROBE_KLOOP2
            if (t == nt) {
#pragma unroll
                for (int a = 0; a < 2; ++a)
#pragma unroll
                    for (int b = 0; b < 2; ++b)
#pragma unroll
                        for (int m = 0; m < 4; ++m)
#pragma unroll
                            for (int n = 0; n < 2; ++n) acc[a][b][m][n] = (f32x4){0.f, 0.f, 0.f, 0.f};
            }
            const int tq = t >= nt ? t - nt : t;
#else
            const int tq = t;
#endif
            if constexpr (Epi::MID) { if (tq == nt / 2) { int l2 = 0; asm volatile("" : "+v"(l2)); l2 = (int)__builtin_amdgcn_mbcnt_hi(~0u, __builtin_amdgcn_mbcnt_lo(~0u, (unsigned)l2)); E.mid(acc, cur, wr, wc, l2 & 15, l2 >> 4); } }
            const bool last = (t == ntt - 2);
            const int tq2 = (tq + 2 == nt) ? 0 : tq + 2;
            const char* a1 = cA + (size_t)(tq + 1) * kstep;
            const char* a2 = last ? nA : cA + (size_t)tq2 * kstep; const char* b2 = last ? nB : cB + (size_t)tq2 * kstep;
            const char* a3 = a2 + kstep; const char* b3 = b2 + kstep;
            unsigned w0[2], w1[2];
            if constexpr (Prob::GATHER) { w0[0] = last ? vn[0][0] : vc[0][0]; w0[1] = last ? vn[0][1] : vc[0][1]; w1[0] = last ? vn[1][0] : vc[1][0]; w1[1] = last ? vn[1][1] : vc[1][1]; }
            else { w0[0] = vc[0][0]; w0[1] = vc[0][1]; w1[0] = vc[1][0]; w1[1] = vc[1][1]; }
            int tz = t; asm volatile("" : "+s"(tz));
            const bool relax = PRE11 && post && tz == 0;
            int tzq = tq; asm volatile("" : "+s"(tzq)); const bool zfirst = (tzq == 0);
            PG8_LDB(B0, 0, 0); PG8_LDB(B1, 0, 1); PG8_SCHED; PG8_LDA(At, 0, 0); if (!relax) PG8_STAGE(PG8_SA(1, 1), a1, vc[1]);
            if (!relax) PG8_WAIT_V(8); PG8_WAIT_L(0); PG8_BAR; PG8_MMA2(0, At, B0, B1); PG8_BAR; PG8_SCHED;
            PG8_LDA(At, 0, 1); PG8_STAGE(PG8_SB(0, 0), b2, voffB); PG8_STAGE(PG8_SB(0, 1), b2 + hstep, voffB); PG8_STAGE(PG8_SA(0, 0), a2, w0);
            if (!relax) PG8_WAIT_V(8); PG8_WAIT_L(0); PG8_BAR; PG8_MMA2(1, At, B0, B1); PG8_BAR; PG8_SCHED;
            PG8_LDB(B0, 1, 0); PG8_LDB(B1, 1, 1); PG8_SCHED; PG8_LDA(At, 1, 0); PG8_STAGE(PG8_SA(0, 1), a2, w1);
            if (!relax) PG8_WAIT_V(8); PG8_WAIT_L(0); PG8_BAR; PG8_MMA(0, 0, At, B0); PG8_MMA(0, 1, At, B1); PG8_BAR; PG8_SCHED;
            PG8_LDA(At, 1, 1); PG8_STAGE(PG8_SB(1, 0), b3, voffB); PG8_STAGE(PG8_SB(1, 1), b3 + hstep, voffB); PG8_STAGE(PG8_SA(1, 0), a3, w0);
            PG8_WAIT_V(8); PG8_WAIT_L(0); PG8_BAR; PG8_MMA(1, 0, At, B0); PG8_MMA(1, 1, At, B1); PG8_BAR; PG8_SCHED;
            if constexpr (Prob::GATHER) { if (nt >= 6 && t + 4 == ntt && has_next) P.a_fin(nxt, Rr, Cc, tkr, vn); }
        }
        if (wr == 0) PG8_BAR;
        if constexpr (PRE11) PG8_STAGE(PG8_SA(1, 1), nA + kstep, vn[1]);
        if constexpr (FP8) asm volatile("s_nop 15\n\ts_nop 3" ::: "memory");
        { int l2 = 0; asm volatile("" : "+v"(l2)); l2 = (int)__builtin_amdgcn_mbcnt_hi(~0u, __builtin_amdgcn_mbcnt_lo(~0u, (unsigned)l2));
          E(acc, cur, wr, wc, l2 & 15, l2 >> 4);
#if PROBE_EPI2
          if ((PROBE_EPI2 == 1 && FP8) || (PROBE_EPI2 == 2 && !FP8 && P.nN == 14)) { int l3 = threadIdx.x & 63; asm volatile("" : "+v"(l3)); E(acc, cur, wr, wc, l3 & 15, l3 >> 4); }
#endif
        }
        if (!has_next) break;
        if constexpr (!FP8) {
#pragma unroll
        for (int a = 0; a < 2; ++a)
#pragma unroll
            for (int b = 0; b < 2; ++b)
#pragma unroll
                for (int m = 0; m < 4; ++m)
#pragma unroll
                    for (int n = 0; n < 2; ++n) acc[a][b][m][n] = (f32x4){0.f, 0.f, 0.f, 0.f}; }
        cur = nxt; cA = nA; cB = nB; ++ui;
#pragma unroll
        for (int h = 0; h < 2; ++h)
#pragma unroll
            for (int i = 0; i < 2; ++i) vc[h][i] = vn[h][i];
        if (wr == 1) PG8_BAR;
    }
    PG8_WAIT_V(0);
    PG8_BAR;
#undef PG8_SA
#undef PG8_SB
#undef PG8_STAGE
#undef PG8_LDA
#undef PG8_LDB
#undef PG8_MMA
#undef PG8_MMA_Z
#undef PG8_MMA2
#undef PG8_LO
#undef PG8_HI
#undef PG8_LD8
#undef PG8_WAIT_V
#undef PG8_WAIT_L
#undef PG8_BAR
#undef PG8_SCHED
}
}

using pg8::Unit;
__device__ __forceinline__ u32x4 pack8(const f32x4& a, const f32x4& b) { u32x4 w; w.x = pk2(a[0], a[1]); w.y = pk2(a[2], a[3]); w.z = pk2(b[0], b[1]); w.w = pk2(b[2], b[3]); return w; }
#define EPI_LOOP_AI_M _Pragma("unroll") for (int ai = 0; ai < 2; ++ai) _Pragma("unroll") for (int m = 0; m < 4; ++m)
#define EPI_LOADS_DONE() asm volatile("s_waitcnt vmcnt(0)" ::: "memory")

struct EpiInProj {
    static constexpr bool MID = false, LDSX = false;
    bf16* HG; bf16* QLAT; bf16* KVLAT; bf16* G; bf16* GR; const float* gate_b; float* KPESS; const float* RSX; float* SSQ; float* SSC;
    __device__ __forceinline__ void operator()(const f32x4 (&acc)[2][2][4][2], const Unit& u, int wr, int wc, int fr, int fq) const {
        const int rowu = u.pm * 256 + wr * 64, cwu = wc * 32, cw = cwu + 8 * fq;
        float rx[2][4];
        { const float* rxp = RSX + rowu; EPI_LOOP_AI_M rx[ai][m] = rxp[fr + 128 * ai + 16 * m]; }
        f32x4 bv[2][2];
        { const int cbg = 128 * (u.pn < 6 ? 0 : u.pn - 6) + cw;
#pragma unroll
          for (int bj = 0; bj < 2; ++bj)
#pragma unroll
              for (int n = 0; n < 2; ++n) bv[bj][n] = *(const f32x4*)(gate_b + 1024 * bj + cbg + 4 * n); }
        __builtin_amdgcn_sched_barrier(0);
        EPI_LOADS_DONE();
        asm volatile("" : "+v"(bv[0][0]), "+v"(bv[0][1]), "+v"(bv[1][0]), "+v"(bv[1][1]));
        if (u.pn < 4) {
            const int bb = rowu >> 12, tu = rowu & 4095;
            char* hb = (char*)HG + (((size_t)bb * LPC + HGOFF + tu) * CDIM + 128 * u.pn + cwu) * 2; const unsigned lo = (unsigned)(fr * CDIM + 8 * fq) * 2u;
            EPI_LOOP_AI_M {
                const f32x2 r2 = {rx[ai][m], rx[ai][m]}, nr2 = r2 * -1.4426950408889634f; f32x4 v[2];
#pragma unroll
                for (int n = 0; n < 2; ++n)
#pragma unroll
                    for (int h = 0; h < 2; ++h) { const f32x2 a2 = {acc[ai][0][m][n][2 * h], acc[ai][0][m][n][2 * h + 1]}, g2 = {acc[ai][1][m][n][2 * h], acc[ai][1][m][n][2 * h + 1]};
                        const f32x2 t = g2 * nr2; f32x2 d = {__builtin_amdgcn_exp2f(t[0]), __builtin_amdgcn_exp2f(t[1])}; d = d + 1.f;
                        const f32x2 rc = {__builtin_amdgcn_rcpf(d[0]), __builtin_amdgcn_rcpf(d[1])}, o = (a2 * r2) * rc; v[n][2 * h] = o[0]; v[n][2 * h + 1] = o[1]; }
                *(u32x4*)(hb + (size_t)(128 * ai + 16 * m) * (CDIM * 2) + lo) = pack8(v[0], v[1]); }
        } else if (u.pn < 6) {
            char* db = (char*)((u.pn == 4) ? QLAT : KVLAT) + ((size_t)rowu * 256 + cwu) * 2; const unsigned lo = (unsigned)(fr * 256 + 8 * fq) * 2u;
            EPI_LOOP_AI_M {
#pragma unroll
                for (int bj = 0; bj < 2; ++bj) *(u32x4*)(db + (size_t)(128 * ai + 16 * m) * 512 + 256 * bj + lo) = pack8(acc[ai][bj][m][0] * rx[ai][m], acc[ai][bj][m][1] * rx[ai][m]); }
            { float* ssd = ((u.pn == 4) ? SSQ : SSC) + (size_t)rowu * 4 + wc; const int nbj = (u.pn == 4) ? 2 : 1;
                EPI_LOOP_AI_M { float ss = 0.f;
#pragma unroll
                    for (int bj = 0; bj < 2; ++bj) if (bj < nbj) { const f32x4 a = acc[ai][bj][m][0], b = acc[ai][bj][m][1]; ss += ((a[0] * a[0] + a[1] * a[1]) + (a[2] * a[2] + a[3] * a[3])) + ((b[0] * b[0] + b[1] * b[1]) + (b[2] * b[2] + b[3] * b[3])); }
                    ss += __shfl_xor(ss, 16); ss += __shfl_xor(ss, 32);
                    if (fq == 0) ssd[(fr + 128 * ai + 16 * m) * 4] = ss * rx[ai][m] * rx[ai][m]; } }
            if (u.pn == 5 && wc == 0) {
                float* kp = KPESS + rowu;
                EPI_LOOP_AI_M { const f32x4 a = acc[ai][1][m][0], b = acc[ai][1][m][1];
                    float ss = ((a[0] * a[0] + a[1] * a[1]) + (a[2] * a[2] + a[3] * a[3])) + ((b[0] * b[0] + b[1] * b[1]) + (b[2] * b[2] + b[3] * b[3]));
                    ss += __shfl_xor(ss, 16); ss += __shfl_xor(ss, 32);
                    if (fq == 0) kp[fr + 128 * ai + 16 * m] = ss * rx[ai][m] * rx[ai][m]; } }
        } else {
            const size_t ub = ((size_t)rowu * 1024 + 128 * (u.pn - 6) + cwu) * 2; char* rb = (char*)GR + ub; char* gb = (char*)G + ub; const unsigned lo = (unsigned)(fr * 1024 + 8 * fq) * 2u;
#pragma unroll
            for (int bj = 0; bj < 2; ++bj)
#pragma unroll
                for (int n = 0; n < 2; ++n) bv[bj][n] = bv[bj][n] * -1.4426950408889634f;
            EPI_LOOP_AI_M { f32x4 rr[2], gg[2]; const float nr = rx[ai][m] * -1.4426950408889634f; const f32x2 nr2 = {nr, nr};
#pragma unroll
                for (int n = 0; n < 2; ++n)
#pragma unroll
                    for (int h = 0; h < 2; ++h) { const f32x2 z0 = {acc[ai][0][m][n][2 * h], acc[ai][0][m][n][2 * h + 1]}, z1 = {acc[ai][1][m][n][2 * h], acc[ai][1][m][n][2 * h + 1]};
                        const f32x2 b0 = {bv[0][n][2 * h], bv[0][n][2 * h + 1]}, b1 = {bv[1][n][2 * h], bv[1][n][2 * h + 1]};
                        const f32x2 t0 = z0 * nr2 + b0, t1 = z1 * nr2 + b1;
                        f32x2 d0 = {__builtin_amdgcn_exp2f(t0[0]), __builtin_amdgcn_exp2f(t0[1])}, d1 = {__builtin_amdgcn_exp2f(t1[0]), __builtin_amdgcn_exp2f(t1[1])}; d0 = d0 + 1.f; d1 = d1 + 1.f;
                        const f32x2 q0 = {__builtin_amdgcn_rcpf(d0[0]), __builtin_amdgcn_rcpf(d0[1])}, g1 = {__builtin_amdgcn_rcpf(d1[0]), __builtin_amdgcn_rcpf(d1[1])}, r = d1 * q0;
                        gg[n][2 * h] = g1[0]; gg[n][2 * h + 1] = g1[1]; rr[n][2 * h] = r[0]; rr[n][2 * h + 1] = r[1]; }
                *(u32x4*)(rb + (size_t)(128 * ai + 16 * m) * 2048 + lo) = pack8(rr[0], rr[1]); *(u32x4*)(gb + (size_t)(128 * ai + 16 * m) * 2048 + lo) = pack8(gg[0], gg[1]); }
        }
    }
};
template <bool REMAP> struct EpiRowScale {
    static constexpr bool MID = false, LDSX = false;
    bf16* O; const float* rs;
    __device__ __forceinline__ void operator()(const f32x4 (&acc)[2][2][4][2], const Unit& u, int wr, int wc, int fr, int fq) const {
        const int rowt = u.pm * 256 + wr * 64 + fr, cb = 256 * u.pn + 64 * wc + 16 * fq;
        float sv[2][4];
        EPI_LOOP_AI_M sv[ai][m] = rs[rowt + 128 * ai + 16 * m];
        __builtin_amdgcn_sched_barrier(0);
        EPI_LOADS_DONE();
        EPI_LOOP_AI_M { const int row = rowt + 128 * ai + 16 * m; const float s = sv[ai][m];
            const size_t orow = REMAP ? ((size_t)(row >> 12) * LPK + KOFF + (row & 4095)) : (size_t)row;
#pragma unroll
            for (int bj = 0; bj < 2; ++bj) *(u32x4*)(O + orow * 1024 + cb + 8 * bj) = pack8(acc[ai][bj][m][0] * s, acc[ai][bj][m][1] * s); }
    }
};
__device__ __forceinline__ void unpack8(const u32x4& w, f32x4& a, f32x4& b) { a[0] = bflo(w.x); a[1] = bfhi(w.x); a[2] = bflo(w.y); a[3] = bfhi(w.y); b[0] = bflo(w.z); b[1] = bfhi(w.z); b[2] = bflo(w.w); b[3] = bfhi(w.w); }
struct EpiQHead {
    static constexpr bool MID = false, LDSX = true;
    bf16* QF; const float* rs; const float* q_nw; const float* ROPE; LAS unsigned char* lds;
    __device__ __forceinline__ void operator()(const f32x4 (&acc)[2][2][4][2], const Unit& u, int wr, int wc, int fr, int fq) const {
        LAS float* S = (LAS float*)(lds + 3 * 16384);
        const int rl0 = wr * 64 + fr, rowt = u.pm * 256 + rl0;
        float sv[2][4];
        { f32x4 pp[2][4];
          EPI_LOOP_AI_M pp[ai][m] = *(const f32x4*)(rs + (size_t)(rowt + 128 * ai + 16 * m) * 4);
          __builtin_amdgcn_sched_barrier(0);
          EPI_LOADS_DONE();
          EPI_LOOP_AI_M sv[ai][m] = 1.f / sqrtf(((pp[ai][m][0] + pp[ai][m][1]) + (pp[ai][m][2] + pp[ai][m][3])) * (1.f / QLR) + NORM_EPS); }
        EPI_LOOP_AI_M {
#pragma unroll
            for (int bj = 0; bj < 2; ++bj) { const f32x4 a = acc[ai][bj][m][0], b = acc[ai][bj][m][1];
                float ss = ((a[0] * a[0] + a[1] * a[1]) + (a[2] * a[2] + a[3] * a[3])) + ((b[0] * b[0] + b[1] * b[1]) + (b[2] * b[2] + b[3] * b[3]));
                ss += __shfl_xor(ss, 16); ss += __shfl_xor(ss, 32);
                if (fq == 0) S[((rl0 + 128 * ai + 16 * m) * 2 + bj) * 4 + wc] = ss; } }
        asm volatile("s_waitcnt lgkmcnt(0)\n\ts_barrier" ::: "memory");
        if (wc < 3) {
            const int d0 = 32 * wc + 8 * fq; const f32x4 w0 = *(const f32x4*)(q_nw + d0), w1 = *(const f32x4*)(q_nw + d0 + 4);
            EPI_LOOP_AI_M { const int rl = rl0 + 128 * ai + 16 * m, row = rowt + 128 * ai + 16 * m; const float rsq = sv[ai][m];
#pragma unroll
                for (int bj = 0; bj < 2; ++bj) { const f32x4 pt = *(const LAS f32x4*)(S + (rl * 2 + bj) * 4);
                    const float tot = ((pt[0] + pt[1]) + (pt[2] + pt[3])) * rsq * rsq, sc = rsq * QSCALE / sqrtf(tot * (1.f / DQK) + NORM_EPS);
                    f32x4 o0 = acc[ai][bj][m][0] * sc * w0, o1 = acc[ai][bj][m][1] * sc * w1;
                    if (wc == 2) {
                        const float* rp = ROPE + (size_t)(NMETA + (row & 4095)) * 32 + 16 * (fq & 1);
                        const f32x4 c0 = *(const f32x4*)rp, c1 = *(const f32x4*)(rp + 4), c2 = *(const f32x4*)(rp + 8), c3 = *(const f32x4*)(rp + 12);
                        const float sg = (fq < 2) ? -1.f : 1.f; f32x4 p0, p1;
#pragma unroll
                        for (int e = 0; e < 4; ++e) { p0[e] = __shfl_xor(o0[e], 32); p1[e] = __shfl_xor(o1[e], 32); }
                        o0 = (f32x4){o0[0] * c0[0] + sg * p0[0] * c0[1], o0[1] * c0[2] + sg * p0[1] * c0[3], o0[2] * c1[0] + sg * p0[2] * c1[1], o0[3] * c1[2] + sg * p0[3] * c1[3]};
                        o1 = (f32x4){o1[0] * c2[0] + sg * p1[0] * c2[1], o1[1] * c2[2] + sg * p1[1] * c2[3], o1[2] * c3[0] + sg * p1[2] * c3[1], o1[3] * c3[2] + sg * p1[3] * c3[3]}; }
                    *(u32x4*)(QF + (size_t)row * 768 + (2 * u.pn + bj) * DQK + d0) = pack8(o0, o1); } }
        }
        asm volatile("s_waitcnt lgkmcnt(0)\n\ts_barrier" ::: "memory");
    }
};
struct EpiKVHead {
    static constexpr bool MID = false, LDSX = true;
    bf16* KF; bf16* VO; const bf16* KVLAT; const float* rs; const float* kpess; const float* k_nw; const float* ROPE; LAS unsigned char* lds;
    __device__ __forceinline__ void operator()(const f32x4 (&acc)[2][2][4][2], const Unit& u, int wr, int wc, int fr, int fq) const {
        LAS float* S = (LAS float*)(lds + 3 * 16384);
        const int rl0 = wr * 64 + fr, rowt = u.pm * 256 + rl0;
        float sv[2][4];
        { f32x4 pp[2][4];
          EPI_LOOP_AI_M pp[ai][m] = *(const f32x4*)(rs + (size_t)(rowt + 128 * ai + 16 * m) * 4);
          __builtin_amdgcn_sched_barrier(0);
          EPI_LOADS_DONE();
          EPI_LOOP_AI_M sv[ai][m] = 1.f / sqrtf(((pp[ai][m][0] + pp[ai][m][1]) + (pp[ai][m][2] + pp[ai][m][3])) * (1.f / KVLR) + NORM_EPS); }
        if (wc < 2) {
            EPI_LOOP_AI_M {
#pragma unroll
                for (int bj = 0; bj < 2; ++bj) { const f32x4 a = acc[ai][bj][m][0], b = acc[ai][bj][m][1];
                    float ss = ((a[0] * a[0] + a[1] * a[1]) + (a[2] * a[2] + a[3] * a[3])) + ((b[0] * b[0] + b[1] * b[1]) + (b[2] * b[2] + b[3] * b[3]));
                    ss += __shfl_xor(ss, 16); ss += __shfl_xor(ss, 32);
                    if (fq == 0) S[((rl0 + 128 * ai + 16 * m) * 2 + bj) * 4 + wc] = ss; } }
        } else if (fq == 0) {
            EPI_LOOP_AI_M { const float val = (wc == 2) ? sv[ai][m] : kpess[rowt + 128 * ai + 16 * m];
                S[((rl0 + 128 * ai + 16 * m) * 2 + 0) * 4 + wc] = val; S[((rl0 + 128 * ai + 16 * m) * 2 + 1) * 4 + wc] = val; }
        }
        asm volatile("s_waitcnt lgkmcnt(0)\n\ts_barrier" ::: "memory");
        if (wc < 2) {
            const int d0 = 32 * wc + 8 * fq; const f32x4 w0 = *(const f32x4*)(k_nw + d0), w1 = *(const f32x4*)(k_nw + d0 + 4);
            EPI_LOOP_AI_M { const int rl = rl0 + 128 * ai + 16 * m, row = rowt + 128 * ai + 16 * m, b = row >> 12, t = row & 4095;
#pragma unroll
                for (int bj = 0; bj < 2; ++bj) { const f32x4 pt = *(const LAS f32x4*)(S + (rl * 2 + bj) * 4);
                    const float tot = (pt[0] + pt[1]) * pt[2] * pt[2] + pt[3], sc = pt[2] / sqrtf(tot * (1.f / DQK) + NORM_EPS);
                    *(u32x4*)(KF + ((size_t)(b * NH + 2 * u.pn + bj) * LPK + KOFF + t) * DQK + d0) = pack8(acc[ai][bj][m][0] * sc * w0, acc[ai][bj][m][1] * sc * w1); } }
        } else {
            const int d0 = 32 * (wc - 2) + 8 * fq;
            EPI_LOOP_AI_M { const int row = rowt + 128 * ai + 16 * m, b = row >> 12, t = row & 4095; const float rsc = sv[ai][m];
#pragma unroll
                for (int bj = 0; bj < 2; ++bj) *(u32x4*)(VO + ((size_t)b * LPK + KOFF + t) * 1024 + (2 * u.pn + bj) * 128 + 64 + d0) = pack8(acc[ai][bj][m][0] * rsc, acc[ai][bj][m][1] * rsc); }
        }
        __builtin_amdgcn_sched_barrier(0);
        if (wc == 2) {
            const f32x4 wo0 = *(const f32x4*)(k_nw + 64 + 8 * fq), wo1 = *(const f32x4*)(k_nw + 68 + 8 * fq), wp0 = *(const f32x4*)(k_nw + 64 + 8 * (fq ^ 2)), wp1 = *(const f32x4*)(k_nw + 68 + 8 * (fq ^ 2));
            const float sg = (fq < 2) ? -1.f : 1.f;
#pragma unroll 2
            for (int q = 0; q < 8; ++q) { const int rl = rl0 + 128 * (q >> 2) + 16 * (q & 3), row = u.pm * 256 + rl, b = row >> 12, t = row & 4095;
                f32x4 xo0, xo1, xp0, xp1; const bf16* pe = KVLAT + (size_t)row * 256 + KVLR; unpack8(*(const u32x4*)(pe + 8 * fq), xo0, xo1); unpack8(*(const u32x4*)(pe + 8 * (fq ^ 2)), xp0, xp1);
                const float* rp = ROPE + (size_t)(NMETA + t) * 32 + 16 * (fq & 1); const f32x4 c0 = *(const f32x4*)rp, c1 = *(const f32x4*)(rp + 4), c2 = *(const f32x4*)(rp + 8), c3 = *(const f32x4*)(rp + 12);
#pragma unroll
                for (int bj = 0; bj < 2; ++bj) { const f32x4 pt = *(const LAS f32x4*)(S + (rl * 2 + bj) * 4);
                    const float tot = (pt[0] + pt[1]) * pt[2] * pt[2] + pt[3], rh = 1.f / sqrtf(tot * (1.f / DQK) + NORM_EPS);
                    const f32x4 a0 = xo0 * rh * wo0, a1 = xo1 * rh * wo1, p0 = xp0 * rh * wp0, p1 = xp1 * rh * wp1;
                    const f32x4 o0 = {a0[0] * c0[0] + sg * p0[0] * c0[1], a0[1] * c0[2] + sg * p0[1] * c0[3], a0[2] * c1[0] + sg * p0[2] * c1[1], a0[3] * c1[2] + sg * p0[3] * c1[3]};
                    const f32x4 o1 = {a1[0] * c2[0] + sg * p1[0] * c2[1], a1[1] * c2[2] + sg * p1[1] * c2[3], a1[2] * c3[0] + sg * p1[2] * c3[1], a1[3] * c3[2] + sg * p1[3] * c3[3]};
                    *(u32x4*)(KF + ((size_t)(b * NH + 2 * u.pn + bj) * LPK + KOFF + t) * DQK + 64 + 8 * fq) = pack8(o0, o1); } }
        }
        asm volatile("s_waitcnt lgkmcnt(0)\n\ts_barrier" ::: "memory");
    }
};
struct EpiMix {
    static constexpr bool MID = true, LDSX = false;
    bf16* O; const bf16* G1; const bf16* GR;
    __device__ __forceinline__ void mid(f32x4 (&acc)[2][2][4][2], const Unit& u, int wr, int wc, int fr, int fq) const {
        const char* gb = (const char*)GR + ((size_t)(u.pm * 256 + wr * 64) * 1024 + 256 * u.pn + 64 * wc) * 2; const unsigned lo = (unsigned)(fr * 1024 + 16 * fq) * 2u;
#pragma unroll
        for (int ai = 0; ai < 2; ++ai) { u32x4 gw[4][2];
#pragma unroll
            for (int m = 0; m < 4; ++m)
#pragma unroll
                for (int bj = 0; bj < 2; ++bj) gw[m][bj] = *(const u32x4*)(gb + (size_t)(128 * ai + 16 * m) * 2048 + lo + 16 * bj);
            __builtin_amdgcn_sched_barrier(0);
#pragma unroll
            for (int m = 0; m < 4; ++m)
#pragma unroll
                for (int bj = 0; bj < 2; ++bj) { f32x4 g0, g1; unpack8(gw[m][bj], g0, g1); acc[ai][bj][m][0] *= g0; acc[ai][bj][m][1] *= g1; }
            __builtin_amdgcn_sched_barrier(0); }
    }
    __device__ __forceinline__ void operator()(const f32x4 (&acc)[2][2][4][2], const Unit& u, int wr, int wc, int fr, int fq) const {
        const size_t ub = ((size_t)(u.pm * 256 + wr * 64) * 1024 + 256 * u.pn + 64 * wc) * 2; const unsigned lo = (unsigned)(fr * 1024 + 16 * fq) * 2u;
        const char* gb = (const char*)G1 + ub; char* ob = (char*)O + ub;
        u32x4 gw[2][4][2];
        EPI_LOOP_AI_M {
#pragma unroll
            for (int bj = 0; bj < 2; ++bj) gw[ai][m][bj] = *(const u32x4*)(gb + (size_t)(128 * ai + 16 * m) * 2048 + lo + 16 * bj); }
        __builtin_amdgcn_sched_barrier(0);
        EPI_LOADS_DONE();
        EPI_LOOP_AI_M {
#pragma unroll
            for (int bj = 0; bj < 2; ++bj) { f32x4 g0, g1; unpack8(gw[ai][m][bj], g0, g1);
                *(u32x4*)(ob + (size_t)(128 * ai + 16 * m) * 2048 + lo + 16 * bj) = pack8(g0 * acc[ai][bj][m][0], g1 * acc[ai][bj][m][1]); } }
    }
};
struct EpiResid {
    static constexpr bool MID = false, LDSX = false;
    const bf16* X; bf16* H1B; unsigned char* H1Q;
    __device__ __forceinline__ void operator()(const f32x4 (&acc)[2][2][4][2], const Unit& u, int wr, int wc, int fr, int fq) const {
        const size_t ue = (size_t)(u.pm * 256 + wr * 64) * 1024 + 256 * u.pn + 64 * wc; const unsigned le = (unsigned)(fr * 1024 + 16 * fq);
        const char* xb = (const char*)X + ue * 2; char* hb = (char*)H1B + ue * 2; unsigned char* qb = H1Q + ue;
        u32x4 xv[2][4][2];
        EPI_LOOP_AI_M {
#pragma unroll
            for (int bj = 0; bj < 2; ++bj) xv[ai][m][bj] = *(const u32x4*)(xb + (size_t)(128 * ai + 16 * m) * 2048 + le * 2u + 16 * bj); }
        __builtin_amdgcn_sched_barrier(0);
        EPI_LOADS_DONE();
        EPI_LOOP_AI_M {
#pragma unroll
            for (int bj = 0; bj < 2; ++bj) {
                f32x4 x0, x1; unpack8(xv[ai][m][bj], x0, x1); const f32x4 v0 = x0 + acc[ai][bj][m][0], v1 = x1 + acc[ai][bj][m][1];
                *(u32x4*)(hb + (size_t)(128 * ai + 16 * m) * 2048 + le * 2u + 16 * bj) = pack8(v0, v1);
                *(u32x2*)(qb + (size_t)(128 * ai + 16 * m) * 1024 + le + 8 * bj) = (u32x2){pk4_fp8(v0[0], v0[1], v0[2], v0[3]), pk4_fp8(v1[0], v1[1], v1[2], v1[3])}; } }
    }
};
struct EpiSwiGLU {
    static constexpr bool MID = false, LDSX = false;
    unsigned char* ACT; const float* bgu; const float* lrs; const volatile LAS int* tb;
    __device__ __forceinline__ void operator()(const f32x4 (&acc)[2][2][4][2], const Unit& u, int wr, int wc, int fr, int fq) const {
        const int r0 = wr * 64 + fr, cw = wc * 32 + 8 * fq, slot0 = (u.pm - __builtin_amdgcn_readfirstlane(tb[u.e])) * 256;
        const float* bg = bgu + (size_t)u.e * 2048 + 128 * u.pn + cw; const float* lr = lrs + (size_t)u.e * ECAP + slot0;
        const f32x4 bg0 = *(const f32x4*)(bg), bg1 = *(const f32x4*)(bg + 4), bu0 = *(const f32x4*)(bg + 1024), bu1 = *(const f32x4*)(bg + 1028);
        float sv[2][4];
        EPI_LOOP_AI_M sv[ai][m] = lr[r0 + 128 * ai + 16 * m];
        asm volatile("" : "+v"(sv[0][0]), "+v"(sv[0][1]), "+v"(sv[0][2]), "+v"(sv[0][3]), "+v"(sv[1][0]), "+v"(sv[1][1]), "+v"(sv[1][2]), "+v"(sv[1][3]));
        EPI_LOADS_DONE();
        constexpr float NC = -SW_ALPHA * 1.4426950408889634f;
        f32x4 bgv[2] = {bg0, bg1}, buv[2] = {bu0 + 1.f, bu1 + 1.f};
        EPI_LOOP_AI_M { const int r = r0 + 128 * ai + 16 * m; const float s = (r < u.cnt) ? sv[ai][m] * W8_INV : 0.f; const f32x2 s2 = {s, s};
            f32x4 v[2];
#pragma unroll
            for (int n = 0; n < 2; ++n)
#pragma unroll
                for (int h = 0; h < 2; ++h) {
                    const f32x2 ag = {acc[ai][0][m][n][2 * h], acc[ai][0][m][n][2 * h + 1]}, au = {acc[ai][1][m][n][2 * h], acc[ai][1][m][n][2 * h + 1]};
                    const f32x2 bg2 = {bgv[n][2 * h], bgv[n][2 * h + 1]}, bu2 = {buv[n][2 * h], buv[n][2 * h + 1]};
                    f32x2 g = ag * s2 + bg2; g[0] = fminf(g[0], SW_LIMIT); g[1] = fminf(g[1], SW_LIMIT);
                    f32x2 uu = au * s2 + bu2; uu[0] = __builtin_amdgcn_fmed3f(uu[0], 1.f - SW_LIMIT, 1.f + SW_LIMIT); uu[1] = __builtin_amdgcn_fmed3f(uu[1], 1.f - SW_LIMIT, 1.f + SW_LIMIT);
                    const f32x2 x = g * NC; f32x2 d = {__builtin_amdgcn_exp2f(x[0]), __builtin_amdgcn_exp2f(x[1])}; d = d + 1.f;
                    const f32x2 rc = {__builtin_amdgcn_rcpf(d[0]), __builtin_amdgcn_rcpf(d[1])};
                    const f32x2 o = (uu * g) * rc; v[n][2 * h] = o[0]; v[n][2 * h + 1] = o[1]; }
            *(u32x2*)(ACT + ((size_t)u.pm * 256 + r) * 1024 + 128 * u.pn + cw) = (u32x2){pk4_fp8(v[0][0], v[0][1], v[0][2], v[0][3]), pk4_fp8(v[1][0], v[1][1], v[1][2], v[1][3])}; }
    }
};
struct EpiDown {
    static constexpr bool MID = false, LDSX = false;
    unsigned char* Y; const float* bd; const float* lw; const volatile LAS int* tb;
    __device__ __forceinline__ void operator()(const f32x4 (&acc)[2][2][4][2], const Unit& u, int wr, int wc, int fr, int fq) const {
        const int r0 = wr * 64 + fr, cb = 256 * u.pn + 64 * wc + 16 * fq, slot0 = (u.pm - __builtin_amdgcn_readfirstlane(tb[u.e])) * 256;
        const float* bp = bd + (size_t)u.e * 1024 + cb; const float* lwp = lw + (size_t)u.e * ECAP + slot0;
        f32x4 bv[2][2];
#pragma unroll
        for (int bj = 0; bj < 2; ++bj)
#pragma unroll
            for (int n = 0; n < 2; ++n) bv[bj][n] = *(const f32x4*)(bp + 8 * bj + 4 * n);
        float wv[2][4];
        EPI_LOOP_AI_M wv[ai][m] = lwp[r0 + 128 * ai + 16 * m];
        asm volatile("" : "+v"(wv[0][0]), "+v"(wv[0][1]), "+v"(wv[0][2]), "+v"(wv[0][3]), "+v"(wv[1][0]), "+v"(wv[1][1]), "+v"(wv[1][2]), "+v"(wv[1][3]));
        EPI_LOADS_DONE();
        EPI_LOOP_AI_M { const int r = r0 + 128 * ai + 16 * m; const float w = (r < u.cnt) ? wv[ai][m] * Y8_SCALE : 0.f; u32x4 o;
            { const f32x4 v0 = (acc[ai][0][m][0] * W8_INV + bv[0][0]) * w, v1 = (acc[ai][0][m][1] * W8_INV + bv[0][1]) * w; o.x = pk4_fp8(v0[0], v0[1], v0[2], v0[3]); o.y = pk4_fp8(v1[0], v1[1], v1[2], v1[3]); }
            { const f32x4 v0 = (acc[ai][1][m][0] * W8_INV + bv[1][0]) * w, v1 = (acc[ai][1][m][1] * W8_INV + bv[1][1]) * w; o.z = pk4_fp8(v0[0], v0[1], v0[2], v0[3]); o.w = pk4_fp8(v1[0], v1[1], v1[2], v1[3]); }
            *(u32x4*)(Y + ((size_t)u.pm * 256 + r) * 1024 + cb) = o; }
    }
};

struct Ctx {
    LAS unsigned char* lds; gu32* ctl; unsigned char* ws;
    int tid, lane, wave, vcu, G;
    const float *x, *meta, *attn_nw, *w_in, *dw_w, *dw_b, *ln_w, *ln_b, *pw2_w, *qa_nw, *w_qb, *kva_nw, *w_kvb, *q_nw, *k_nw, *w_o, *gate_b, *w_out, *ffn_nw, *router_w, *router_b, *w_gu, *b_gu, *w_d, *b_d;
    float* out;
};
#define WSP(T, off) ((T*)(F.ws + (off)))

__device__ __forceinline__ void tr_item(const float* src, int ld_src, int k0, int colA, int colB, const float* ks, bf16* dst, int ld_dst, LAS unsigned* scr, int lane) {
    const int nq = lane & 15, kq = lane >> 4; const int col = (nq >> 3) ? colB : colA; const int c4 = col + 4 * (nq & 7);
#pragma unroll
    for (int i = 0; i < 8; ++i) { const int kp = 4 * i + kq; f32x4 a = {0.f, 0.f, 0.f, 0.f}, b = {0.f, 0.f, 0.f, 0.f};
        if (col >= 0) { a = *(const f32x4*)(src + (size_t)(k0 + 2 * kp) * ld_src + c4); b = *(const f32x4*)(src + (size_t)(k0 + 2 * kp + 1) * ld_src + c4); }
        if (ks) { a *= ks[k0 + 2 * kp]; b *= ks[k0 + 2 * kp + 1]; }
        LAS unsigned* p = scr + kp * 65 + 4 * nq; p[0] = pk2(a[0], b[0]); p[1] = pk2(a[1], b[1]); p[2] = pk2(a[2], b[2]); p[3] = pk2(a[3], b[3]); }
    LDS_WAIT(); asm volatile("" ::: "memory");
    const int c = lane & 7;
#pragma unroll
    for (int j = 0; j < 8; ++j) { const int n = (lane >> 3) + 8 * j; const LAS unsigned* s = scr + (4 * c) * 65 + n;
        u32x4 o; o.x = s[0]; o.y = s[65]; o.z = s[130]; o.w = s[195];
        *(u32x4*)(dst + (size_t)n * ld_dst + 8 * c) = o; }
    LDS_WAIT(); asm volatile("" ::: "memory");
}
__device__ __forceinline__ void tr_item8(const float* src, int ld_src, int k0, int colA, int colB, const float* ks, unsigned char* dst, int ld_dst, LAS unsigned* scr, int lane) {
    const int nq = lane & 15, kq = lane >> 4; const int col = (nq >> 3) ? colB : colA; const int c4 = col + 4 * (nq & 7);
#pragma unroll
    for (int i = 0; i < 8; ++i) { const int kg = 4 * i + kq; const float* sp = src + (size_t)(k0 + 4 * kg) * ld_src + c4;
        f32x4 a = {0.f, 0.f, 0.f, 0.f}, b = a, c = a, d = a;
        if (col >= 0) { a = __builtin_nontemporal_load((const f32x4*)sp); b = __builtin_nontemporal_load((const f32x4*)(sp + ld_src)); c = __builtin_nontemporal_load((const f32x4*)(sp + 2 * (size_t)ld_src)); d = __builtin_nontemporal_load((const f32x4*)(sp + 3 * (size_t)ld_src)); }
        float s0 = W8_SCALE, s1 = W8_SCALE, s2 = W8_SCALE, s3 = W8_SCALE;
        if (ks) { const f32x4 kv = *(const f32x4*)(ks + k0 + 4 * kg); s0 *= kv[0]; s1 *= kv[1]; s2 *= kv[2]; s3 *= kv[3]; }
        a *= s0; b *= s1; c *= s2; d *= s3;
        LAS unsigned* p = scr + kg * 65 + 4 * nq;
        p[0] = pk4_fp8(a[0], b[0], c[0], d[0]); p[1] = pk4_fp8(a[1], b[1], c[1], d[1]); p[2] = pk4_fp8(a[2], b[2], c[2], d[2]); p[3] = pk4_fp8(a[3], b[3], c[3], d[3]); }
    LDS_WAIT(); asm volatile("" ::: "memory");
    const int c = lane & 7;
#pragma unroll
    for (int j = 0; j < 8; ++j) { const int n = (lane >> 3) + 8 * j; const LAS unsigned* s = scr + (4 * c) * 65 + n;
        u32x4 o; o.x = s[0]; o.y = s[65]; o.z = s[130]; o.w = s[195];
        *(u32x4*)(dst + (size_t)n * ld_dst + 16 * c) = o; }
    LDS_WAIT(); asm volatile("" ::: "memory");
}
__device__ __forceinline__ int colmap_in(int n32) { const int tile = n32 >> 3, j = n32 & 7;
    if (tile < 4) return (j < 4) ? 128 * tile + 32 * j : 512 + 128 * tile + 32 * (j - 4);
    if (tile == 4) return 1024 + 32 * j;
    if (tile == 5) return (j < 5) ? 1280 + 32 * j : -1;
    return (j < 4) ? 1440 + 128 * (tile - 6) + 32 * j : 1440 + 1024 + 128 * (tile - 6) + 32 * (j - 4); }
__device__ __forceinline__ int colmap_gu(int n32) { const int tile = n32 >> 3, j = n32 & 7; return (j < 4) ? 128 * tile + 32 * j : 1024 + 128 * tile + 32 * (j - 4); }
__device__ __forceinline__ int colmap_qb(int n32) { const int h = n32 >> 2, j = n32 & 3; return (j < 3) ? 96 * h + 32 * j : -1; }

__device__ __forceinline__ void p0_item(Ctx& F, int it, LAS unsigned* scr) {
    constexpr int I_GU = 256, I_D = 128, N_GU = NE * I_GU, N_D = NE * I_D, N_WIN = INPROJ_FP8 ? 56 * 8 : 56 * 16, N_WOUT = 256, N_PW2 = 128, N_WO = 128, N_QB = 64;
    int r = it;
    if (r < N_GU) { const int e = r / I_GU, q = r % I_GU, nb = q & 31, kb = q >> 5;
        tr_item8(F.w_gu + (size_t)e * 1024 * 2048, 2048, 128 * kb, colmap_gu(2 * nb), colmap_gu(2 * nb + 1), F.ffn_nw, WSP(unsigned char, WS_WGU) + ((size_t)e * 2048 + 64 * nb) * 1024 + 128 * kb, 1024, scr, F.lane); return; }
    r -= N_GU;
    if (r < N_D) { const int e = r / I_D, q = r % I_D, nb = q & 15, kb = q >> 4;
        tr_item8(F.w_d + (size_t)e * 1024 * 1024, 1024, 128 * kb, 64 * nb, 64 * nb + 32, nullptr, WSP(unsigned char, WS_WD) + ((size_t)e * 1024 + 64 * nb) * 1024 + 128 * kb, 1024, scr, F.lane); return; }
    r -= N_D;
#if INPROJ_FP8
    if (r < N_WIN) { const int nb = r >> 3, kb = r & 7;
        tr_item8(F.w_in, INC, 128 * kb, colmap_in(2 * nb), colmap_in(2 * nb + 1), F.attn_nw, WSP(unsigned char, WS_WIN) + (size_t)(64 * nb) * 1024 + 128 * kb, 1024, scr, F.lane); return; }
#else
    if (r < N_WIN) { const int nb = r >> 4, kb = r & 15;
        tr_item(F.w_in, INC, 64 * kb, colmap_in(2 * nb), colmap_in(2 * nb + 1), F.attn_nw, WSP(bf16, WS_WIN) + (size_t)(64 * nb) * 1024 + 64 * kb, 1024, scr, F.lane); return; }
#endif
    r -= N_WIN;
    if (r < N_WOUT) { const int nb = r >> 4, kb = r & 15;
        tr_item(F.w_out, 1024, 64 * kb, 64 * nb, 64 * nb + 32, nullptr, WSP(bf16, WS_WOUT) + (size_t)(64 * nb) * 1024 + 64 * kb, 1024, scr, F.lane); return; }
    r -= N_WOUT;
    if (r < N_PW2) { const int nb = r >> 3, kb = r & 7;
        tr_item(F.pw2_w, 1024, 64 * kb, 64 * nb, 64 * nb + 32, nullptr, WSP(bf16, WS_W2T) + (size_t)(64 * nb) * 1024 + 64 * kb, 1024, scr, F.lane); return; }
    r -= N_PW2;
    if (r < N_WO) { const int nb = r >> 3, kb = r & 7;
        tr_item(F.w_o, 1024, 64 * kb, 64 * nb, 64 * nb + 32, nullptr, WSP(bf16, WS_W2T) + (size_t)(64 * nb) * 1024 + 512 + 64 * kb, 1024, scr, F.lane); return; }
    r -= N_WO;
    if (r < N_QB) { const int nb = r >> 2, kb = r & 3;
        tr_item(F.w_qb, 768, 64 * kb, colmap_qb(2 * nb), colmap_qb(2 * nb + 1), F.qa_nw, WSP(bf16, WS_WQB) + (size_t)(64 * nb) * 256 + 64 * kb, 256, scr, F.lane); return; }
    r -= N_QB;
    { const int nb = r >> 2, kb = r & 3; const bool real = kb < 2;
        tr_item(F.w_kvb, 1024, real ? 64 * kb : 0, real ? 64 * nb : -1, real ? 64 * nb + 32 : -1, real ? F.kva_nw : nullptr, WSP(bf16, WS_WKVB) + (size_t)(64 * nb) * 256 + 64 * kb, 256, scr, F.lane); }
}
constexpr int P0_NITEMS = NE * 256 + NE * 128 + (INPROJ_FP8 ? 56 * 8 : 56 * 16) + 256 + 128 + 128 + 64 + 64;

__device__ __forceinline__ void p0_prologue(Ctx& F) {
    LAS unsigned* scr = (LAS unsigned*)F.lds + F.wave * 2080;
    const int gw = F.vcu * 8 + F.wave, NGW = F.G * 8, gth = gw * 64 + F.lane, NGT = NGW * 64;
    for (int it = gw; it < P0_NITEMS; it += NGW) p0_item(F, it, scr);
    bf16* XN = WSP(bf16, WS_XN);
    for (int m2 = gw; m2 < MT / 2; m2 += NGW) {
        f32x4 v[2][4]; float ss[2];
#pragma unroll
        for (int q = 0; q < 2; ++q) { const f32x4* xr = (const f32x4*)(F.x + (size_t)(2 * m2 + q) * DM) + F.lane;
#pragma unroll
            for (int j = 0; j < 4; ++j) v[q][j] = __builtin_nontemporal_load(xr + 64 * j); }
#pragma unroll
        for (int q = 0; q < 2; ++q) { float sq = 0.f;
#pragma unroll
            for (int j = 0; j < 4; ++j) sq += (v[q][j][0] * v[q][j][0] + v[q][j][1] * v[q][j][1]) + (v[q][j][2] * v[q][j][2] + v[q][j][3] * v[q][j][3]);
            ss[q] = sq; }
        ss[0] = wave_sum(ss[0]); ss[1] = wave_sum(ss[1]);
#pragma unroll
        for (int q = 0; q < 2; ++q) { if (F.lane == 0) WSP(float, WS_RSX)[2 * m2 + q] = (INPROJ_FP8 ? 1.f / (XQ_SCALE * W8_SCALE) : 1.f) / sqrtf(ss[q] * (1.f / DM) + NORM_EPS);
            u32x2* o8 = (u32x2*)(XN + (size_t)(2 * m2 + q) * DM) + F.lane;
#pragma unroll
            for (int j = 0; j < 4; ++j) { u32x2 o; o.x = pk2(v[q][j][0], v[q][j][1]); o.y = pk2(v[q][j][2], v[q][j][3]); o8[64 * j] = o; }
#if INPROJ_FP8
            unsigned* o4 = (unsigned*)(WSP(unsigned char, WS_XQ) + (size_t)(2 * m2 + q) * DM) + F.lane;
#pragma unroll
            for (int j = 0; j < 4; ++j) o4[64 * j] = pk4_fp8(v[q][j][0] * XQ_SCALE, v[q][j][1] * XQ_SCALE, v[q][j][2] * XQ_SCALE, v[q][j][3] * XQ_SCALE);
#endif
        }
    }
    float* PMP = WSP(float, WS_PMP);
    for (int task = gw; task < 19 * 8; task += NGW) { const int cg = task >> 3, kc = task & 7, cp = 64 * cg + F.lane; const bool valid = cp < PMC;
        const int sc = (cp < 1024) ? cp : 1280 + (cp - 1024);
        LAS float* ms = (LAS float*)scr;
#pragma unroll
        for (int r = 0; r < 16; ++r) { ms[r * 128 + F.lane] = F.meta[r * DM + kc * 128 + F.lane] * F.attn_nw[kc * 128 + F.lane]; ms[r * 128 + 64 + F.lane] = F.meta[r * DM + kc * 128 + 64 + F.lane] * F.attn_nw[kc * 128 + 64 + F.lane]; }
        LDS_WAIT(); asm volatile("" ::: "memory");
        float acc[16];
#pragma unroll
        for (int r = 0; r < 16; ++r) acc[r] = 0.f;
        const float* wp = F.w_in + (size_t)(kc * 128) * INC + (valid ? sc : 0);
        for (int k = 0; k < 128; k += 4) { const float w0 = wp[(size_t)k * INC], w1 = wp[(size_t)(k + 1) * INC], w2 = wp[(size_t)(k + 2) * INC], w3 = wp[(size_t)(k + 3) * INC];
#pragma unroll
            for (int r = 0; r < 16; ++r) { const f32x4 mv = *(const LAS f32x4*)(ms + r * 128 + k); acc[r] += (mv[0] * w0 + mv[1] * w1) + (mv[2] * w2 + mv[3] * w3); } }
        if (valid) {
#pragma unroll
            for (int r = 0; r < 16; ++r) PMP[(kc * 16 + r) * PMC + cp] = acc[r]; }
        LDS_WAIT(); asm volatile("" ::: "memory");
    }
    float* ROPE = WSP(float, WS_ROPE);
    for (int idx = gth; idx < (SEQ + NMETA) * 16; idx += NGT) { const int pos = idx >> 4, i = idx & 15;
        const double invf[16] = {1, 0.56234132519034907, 0.31622776601683794, 0.17782794100389229, 0.10000000000000001, 0.056234132519034911, 0.031622776601683791, 0.017782794100389229, 0.01, 0.005623413251903491, 0.0031622776601683794, 0.0017782794100389228, 0.001, 0.0005623413251903491, 0.00031622776601683794, 0.00017782794100389227};
        double fq = invf[0];
#pragma unroll
        for (int q = 1; q < 16; ++q) fq = (i == q) ? invf[q] : fq;
        const double ang = (double)pos * fq, red = ang - 6.283185307179586477 * __builtin_rint(ang * 0.15915494309189533577);
        float sn, cs; sincosf((float)red, &sn, &cs);
        ROPE[2 * idx] = cs; ROPE[2 * idx + 1] = sn; }
    for (int r = gw; r < NMETA; r += NGW) { float s = 0.f;
        for (int k = F.lane; k < DM; k += 64) { const float v = F.meta[r * DM + k]; s += v * v; }
        s = wave_sum(s); if (F.lane == 0) WSP(float, WS_METARS)[r] = 1.f / sqrtf(s * (1.f / DM) + NORM_EPS); }
    { unsigned short* RW3 = WSP(unsigned short, WS_RW3);
      for (int idx = gth; idx < DM * NE; idx += NGT) { const int k = idx >> 5, e = idx & 31; const float w = F.ffn_nw[k] * F.router_w[idx];
          const unsigned h = pk2(w, 0.f) & 0xffffu; const float r1 = w - __builtin_bit_cast(float, h << 16);
          const unsigned m = pk2(r1, 0.f) & 0xffffu; const float r2 = r1 - __builtin_bit_cast(float, m << 16);
          const unsigned l = pk2(r2, 0.f) & 0xffffu;
          const size_t o = ((size_t)((k >> 3) * NE + e)) * 8 + (k & 7);
          RW3[o] = (unsigned short)h; RW3[(size_t)NE * DM + o] = (unsigned short)m; RW3[(size_t)2 * NE * DM + o] = (unsigned short)l; } }
}

__device__ __forceinline__ float pm_sum(const float* PMP, int r, int c) { float s = 0.f;
#pragma unroll
    for (int kc = 0; kc < 8; ++kc) s += PMP[(kc * 16 + r) * PMC + c];
    return s; }
__device__ __forceinline__ void p1_meta(Ctx& F) {
    const float* PMP = WSP(float, WS_PMP); float* MRS = WSP(float, WS_METARS);
    const int bx = blockIdx.x;
    if (bx < 16) { const int rm = bx, c = F.tid; bf16* HG = WSP(bf16, WS_HG);
        const float rs = MRS[rm]; const float val = rs * pm_sum(PMP, rm, c) * sigmoid_f(rs * pm_sum(PMP, rm, 512 + c)); const bf16 hv = (bf16)f2bf(val);
#pragma unroll
        for (int b = 0; b < NB; ++b) { HG[((size_t)b * LPC + rm) * CDIM + c] = (bf16)0; HG[((size_t)b * LPC + 16 + rm) * CDIM + c] = hv; }
    } else if (bx == 16) {
#pragma unroll
        for (int q = 0; q < 2; ++q) { const int r = 2 * F.wave + q; const float rs = MRS[r];
            const float v0 = rs * pm_sum(PMP, r, 1024 + F.lane), v1 = rs * pm_sum(PMP, r, 1024 + 64 + F.lane);
            const float ss = wave_sum(v0 * v0 + v1 * v1); if (F.lane == 0) MRS[16 + r] = 1.f / sqrtf(ss * (1.f / KVLR) + NORM_EPS); }
    } else if (bx < 17 + 37) { float* PMF = WSP(float, WS_PMF);
        const int idx = (bx - 17) * 512 + F.tid; if (idx < 16 * PMC) PMF[idx] = pm_sum(PMP, idx / PMC, idx % PMC);
    } else if (bx < 54 + 8) {
        const int q = bx - 54, n = (q & 1) * 512 + F.tid, r0 = 4 * (q >> 1); LAS float* cs = (LAS float*)F.lds;
        { const int r = F.tid >> 7, k = F.tid & 127; cs[F.tid] = MRS[r0 + r] * pm_sum(PMP, r0 + r, 1024 + k); }
        __syncthreads();
        if (F.tid < 256) { const int r = F.tid >> 6, l = F.tid & 63; const float v0 = cs[r * 128 + l], v1 = cs[r * 128 + 64 + l]; const float ss = wave_sum(v0 * v0 + v1 * v1);
            if (l == 0) cs[512 + r] = 1.f / sqrtf(ss * (1.f / KVLR) + NORM_EPS); }
        __syncthreads();
        { const int r = F.tid >> 7, k = F.tid & 127; cs[F.tid] *= cs[512 + r] * F.kva_nw[k]; }
        __syncthreads();
        float acc[4] = {0.f, 0.f, 0.f, 0.f};
#pragma unroll 8
        for (int k = 0; k < KVLR; k += 4) { const float w0 = F.w_kvb[k * 1024 + n], w1 = F.w_kvb[(k + 1) * 1024 + n], w2 = F.w_kvb[(k + 2) * 1024 + n], w3 = F.w_kvb[(k + 3) * 1024 + n];
#pragma unroll
            for (int r = 0; r < 4; ++r) { const f32x4 c = *(const LAS f32x4*)(cs + r * 128 + k); acc[r] += (c[0] * w0 + c[1] * w1) + (c[2] * w2 + c[3] * w3); } }
#pragma unroll
        for (int r = 0; r < 4; ++r) WSP(float, WS_KVMETA)[(r0 + r) * 1024 + n] = acc[r];
        __syncthreads();
    }
}

__device__ __forceinline__ void p2_thin(Ctx& F) {
    {
        const bf16* HG = WSP(bf16, WS_HG); bf16* HC = WSP(bf16, WS_HCO);
        LAS unsigned char* lin = F.lds; LAS float* lout = (LAS float*)(F.lds + 63488);
        const int cp = F.tid & 255, th = F.tid >> 8;
        float wlo[CWID], whi[CWID];
#pragma unroll
        for (int j = 0; j < CWID; ++j) { const f32x2 w = *(const f32x2*)(F.dw_w + j * CDIM + 2 * cp); wlo[j] = w[0]; whi[j] = w[1]; }
        const f32x2 cb = *(const f32x2*)(F.dw_b + 2 * cp);
#define P2_LBAR() asm volatile("s_waitcnt lgkmcnt(0)\n\ts_barrier" ::: "memory")
        for (int rp = 0; rp < 1 + PROBE_P2A; ++rp) {
        u32x4 nx[8];
        if (F.vcu < NB * (SEQ / 32)) { const int b = F.vcu >> 7, t0 = (F.vcu & 127) * 32;
#pragma unroll
            for (int i = 0; i < 8; ++i) { const int p = F.tid + 512 * i; nx[i] = (u32x4){0u, 0u, 0u, 0u}; if (p < 62 * 64) nx[i] = *(const u32x4*)(HG + ((size_t)b * LPC + t0 + 2 + (p >> 6)) * CDIM + (p & 63) * 8); } }
        for (int un = F.vcu; un < NB * (SEQ / 32); un += F.G) { const int b = un >> 7, t0 = (un & 127) * 32;
#pragma unroll
            for (int i = 0; i < 8; ++i) { const int p = F.tid + 512 * i; if (p < 62 * 64) { const int row = p >> 6, ch = p & 63; *(LAS u32x4*)(lin + row * 1024 + ch * 16) = nx[i]; } }
            P2_LBAR();
            if (un + F.G < NB * (SEQ / 32)) { const int un1 = un + F.G, b1 = un1 >> 7, t1 = (un1 & 127) * 32;
#pragma unroll
                for (int i = 0; i < 8; ++i) { const int p = F.tid + 512 * i; if (p < 62 * 64) nx[i] = *(const u32x4*)(HG + ((size_t)b1 * LPC + t1 + 2 + (p >> 6)) * CDIM + (p & 63) * 8); } }
#pragma unroll
            for (int g = 0; g < 2; ++g) { const int tl0 = th * 16 + g * 8; float a0[8], a1[8];
#pragma unroll
                for (int o = 0; o < 8; ++o) { a0[o] = cb[0]; a1[o] = cb[1]; }
#pragma unroll
                for (int jj = 0; jj < 38; ++jj) { const unsigned v = *(const LAS unsigned*)(lin + (tl0 + jj) * 1024 + 4 * cp); const float lo = bflo(v), hi = bfhi(v);
#pragma unroll
                    for (int o = 0; o < 8; ++o) { const int j = jj - o; if (j >= 0 && j < CWID) { a0[o] += wlo[j] * lo; a1[o] += whi[j] * hi; } } }
#pragma unroll
                for (int o = 0; o < 8; ++o) *(LAS f32x2*)(lout + (tl0 + o) * CDIM + 2 * cp) = (f32x2){a0[o], a1[o]}; }
            P2_LBAR();
            { const int tok = 4 * F.wave + (F.lane >> 4), l16 = F.lane & 15;
                f32x4 v[4][2]; float sm = 0.f;
#pragma unroll
                for (int j = 0; j < 4; ++j) { const LAS float* lr = lout + tok * CDIM + 128 * j + 8 * l16; v[j][0] = *(const LAS f32x4*)lr; v[j][1] = *(const LAS f32x4*)(lr + 4);
                    sm += (v[j][0][0] + v[j][0][1]) + (v[j][0][2] + v[j][0][3]) + (v[j][1][0] + v[j][1][1]) + (v[j][1][2] + v[j][1][3]); }
                const float mean = sum16(sm) * (1.f / CDIM); float sv = 0.f;
#pragma unroll
                for (int j = 0; j < 4; ++j)
#pragma unroll
                    for (int q = 0; q < 2; ++q) { v[j][q] = v[j][q] - mean; sv += (v[j][q][0] * v[j][q][0] + v[j][q][1] * v[j][q][1]) + (v[j][q][2] * v[j][q][2] + v[j][q][3] * v[j][q][3]); }
                const float rstd = 1.f / sqrtf(sum16(sv) * (1.f / CDIM) + NORM_EPS);
#pragma unroll
                for (int j = 0; j < 4; ++j) { const int c0 = 128 * j + 8 * l16;
                    const f32x4 w0 = *(const f32x4*)(F.ln_w + c0), w1 = *(const f32x4*)(F.ln_w + c0 + 4), b0 = *(const f32x4*)(F.ln_b + c0), b1 = *(const f32x4*)(F.ln_b + c0 + 4);
                    f32x4 y0 = v[j][0] * rstd * w0 + b0, y1 = v[j][1] * rstd * w1 + b1;
#pragma unroll
                    for (int e = 0; e < 4; ++e) { y0[e] = y0[e] * sigmoid_f(y0[e]); y1[e] = y1[e] * sigmoid_f(y1[e]); }
                    *(u32x4*)(HC + ((size_t)b * SEQ + t0 + tok) * 1024 + c0) = pack8(y0, y1); } }
            P2_LBAR();
        }
        }
#undef P2_LBAR
    }
}

__device__ __forceinline__ void norm_rope_store(float (&v)[48], int part, const float* nw, const float* rp, float scale, bf16* dst) {
    float ss = 0.f;
#pragma unroll
    for (int d = 0; d < 48; ++d) ss += v[d] * v[d];
    ss += __shfl_xor(ss, 1);
    const float r = scale / sqrtf(ss * (1.f / DQK) + NORM_EPS);
    const float* nwp = nw + 48 * part;
#pragma unroll
    for (int d = 0; d < 48; ++d) v[d] *= r * nwp[d];
    if (part) {
#pragma unroll
        for (int i = 0; i < 16; ++i) { const float c = rp[2 * i], s = rp[2 * i + 1], x1 = v[16 + i], x2 = v[32 + i]; v[16 + i] = x1 * c - x2 * s; v[32 + i] = x2 * c + x1 * s; }
    }
#pragma unroll
    for (int q = 0; q < 6; ++q) { u32x4 w; w.x = pk2(v[8 * q], v[8 * q + 1]); w.y = pk2(v[8 * q + 2], v[8 * q + 3]); w.z = pk2(v[8 * q + 4], v[8 * q + 5]); w.w = pk2(v[8 * q + 6], v[8 * q + 7]); *(u32x4*)(dst + 8 * q) = w; }
}
__device__ __forceinline__ void ld8(const bf16* p, float* v) { const u32x4 w = *(const u32x4*)p; v[0] = bflo(w.x); v[1] = bfhi(w.x); v[2] = bflo(w.y); v[3] = bfhi(w.y); v[4] = bflo(w.z); v[5] = bfhi(w.z); v[6] = bflo(w.w); v[7] = bfhi(w.w); }

__device__ __forceinline__ void p4_headnorm(Ctx& F) {
    const int gw = F.vcu * 8 + F.wave, NGW = F.G * 8;
    const bf16* QRAW = WSP(bf16, WS_QRAW); bf16* KVRAW = WSP(bf16, WS_KVRAW); const bf16* KVLAT = WSP(bf16, WS_KVLAT);
    bf16* QF = WSP(bf16, WS_QF); bf16* KF = WSP(bf16, WS_KF); const float* ROPE = WSP(float, WS_ROPE);
    const float* PM = WSP(float, WS_PMF); const float* MRS = WSP(float, WS_METARS); const float* KVM = WSP(float, WS_KVMETA);
    constexpr int T_REAL = 0, T_META = NB * 4, T_DUMMY = NB * 48;
    const int part = F.lane & 1, h = (F.lane >> 1) & 7, tl = F.lane >> 4;
    for (int wt = gw; wt < T_REAL + T_META + T_DUMMY; wt += NGW) {
        if (false) {
        } else if (wt < T_REAL + T_META) {
            const int q = wt - T_REAL, b = q >> 2, r = tl + 4 * (q & 3); const float* rp = ROPE + (size_t)r * 32;
            float v[48]; const float* src = KVM + r * 1024 + h * 128; const float rs = MRS[r];
            if (part == 0) {
#pragma unroll
                for (int d = 0; d < 48; ++d) v[d] = src[d];
            } else {
#pragma unroll
                for (int d = 0; d < 16; ++d) v[d] = src[48 + d];
#pragma unroll
                for (int i = 0; i < 32; ++i) v[16 + i] = rs * PM[r * PMC + 1152 + i];
            }
            const size_t kr = (size_t)b * LPK + r;
            norm_rope_store(v, part, F.k_nw, rp, 1.f, KF + ((size_t)(b * NH + h) * LPK + r) * DQK + 48 * part);
            bf16* vd = KVRAW + kr * 1024 + h * 128 + 64 + 32 * part; const float* vs = src + 64 + 32 * part;
#pragma unroll
            for (int q8 = 0; q8 < 4; ++q8) { u32x4 w; w.x = pk2(vs[8 * q8], vs[8 * q8 + 1]); w.y = pk2(vs[8 * q8 + 2], vs[8 * q8 + 3]); w.z = pk2(vs[8 * q8 + 4], vs[8 * q8 + 5]); w.w = pk2(vs[8 * q8 + 6], vs[8 * q8 + 7]); *(u32x4*)(vd + 8 * q8) = w; }
        } else {
            const int q = wt - T_REAL - T_META, b = q / 48, r = 16 + q % 48; const size_t kr = (size_t)b * LPK + r; const u32x4 z = {0u, 0u, 0u, 0u};
            u32x4* vd = (u32x4*)(KVRAW + kr * 1024); vd[F.lane] = z; vd[64 + F.lane] = z;
            for (int q2 = F.lane; q2 < NH * 12; q2 += 64) { const int hh = q2 / 12, c = q2 % 12; *(u32x4*)(KF + ((size_t)(b * NH + hh) * LPK + r) * DQK + 8 * c) = z; }
        }
    }
}

namespace att {
constexpr int KSLOT = 16384, VSLOT = 8192, SLOT = KSLOT + VSLOT, NSLOT = 4, L_WS = NSLOT * SLOT, L_OST = 0, L_END = L_WS + 8 * 256;
static_assert(8 * 4096 <= 2 * SLOT && L_END <= RING_BYTES, "attention LDS map");
constexpr float THR = 8.f;
__device__ __forceinline__ int crow(int r, int hi) { return (r & 3) + 8 * (r >> 2) + 4 * hi; }
__device__ __forceinline__ float max3f(float a, float b, float c) { float r; asm("v_max3_f32 %0, %1, %2, %3" : "=v"(r) : "v"(a), "v"(b), "v"(c)); return r; }
__device__ __forceinline__ float max2f(float a, float b) { float r; asm("v_max_f32_e32 %0, %1, %2" : "=v"(r) : "v"(a), "v"(b)); return r; }
__device__ __forceinline__ void glds16(const void* gsrc, unsigned lds_dst) { unsigned keep;
    asm volatile("s_mov_b32 %0, m0\n\ts_mov_b32 m0, %2\n\ts_nop 0\n\tglobal_load_lds_dwordx4 %1, off\n\ts_mov_b32 m0, %0" : "=&s"(keep) : "v"(gsrc), "s"(lds_dst) : "memory"); }
typedef short v4i16_t __attribute__((ext_vector_type(4)));
__device__ __forceinline__ s16x4 vtr(const LAS unsigned char* p) { return __builtin_bit_cast(s16x4, __builtin_amdgcn_ds_read_tr16_b64_v4i16((LAS v4i16_t*)p)); }
__device__ __forceinline__ void pv(f32x16* o, const LAS unsigned char* vp, bf16x8 pa0, bf16x8 pa1, bf16x8 pa2, bf16x8 pa3) {
#pragma unroll
    for (int d0 = 0; d0 < 2; ++d0) { s16x4 lo[4], hi[4];
#pragma unroll
        for (int ks = 0; ks < 4; ++ks) { lo[ks] = vtr(vp + d0 * 4096 + ks * 1024); hi[ks] = vtr(vp + d0 * 4096 + ks * 1024 + 512); }
#define PK(k) (bf16x8){lo[k][0], lo[k][1], lo[k][2], lo[k][3], hi[k][0], hi[k][1], hi[k][2], hi[k][3]}
        o[d0] = __builtin_amdgcn_mfma_f32_32x32x16_bf16(pa0, PK(0), o[d0], 0, 0, 0);
        o[d0] = __builtin_amdgcn_mfma_f32_32x32x16_bf16(pa1, PK(1), o[d0], 0, 0, 0);
        o[d0] = __builtin_amdgcn_mfma_f32_32x32x16_bf16(pa2, PK(2), o[d0], 0, 0, 0);
        o[d0] = __builtin_amdgcn_mfma_f32_32x32x16_bf16(pa3, PK(3), o[d0], 0, 0, 0);
#undef PK
    }
}
__device__ __forceinline__ void attn_unit(Ctx& F, int b, int h, int qb) {
    const int lane = F.lane, r32 = lane & 31, hi = lane >> 5, wid = F.wave;
    const bf16* QF = WSP(bf16, WS_QF); const bf16* KF = WSP(bf16, WS_KF); const bf16* KVRAW = WSP(bf16, WS_KVRAW); bf16* O = WSP(bf16, WS_HCO) + 512;
    const size_t rowq0 = (size_t)b * SEQ + 256 * qb + 32 * wid;
    const bf16* Kh = KF + (size_t)(b * NH + h) * LPK * DQK; const bf16* Vh = KVRAW + (size_t)b * LPK * 1024 + h * 128 + 64;
    const unsigned lds0 = (unsigned)(uintptr_t)F.lds;
    const int NT = 4 * qb + 5;
    const bf16* ksrc0; const bf16* ksrc1;
    { const int row0 = 8 * wid + (lane >> 4), row1 = row0 + 4; int c0 = (lane & 15) ^ (row0 & 15), c1 = (lane & 15) ^ (row1 & 15); c0 -= (c0 >= 12) ? 4 : 0; c1 -= (c1 >= 12) ? 4 : 0;
      ksrc0 = Kh + (size_t)row0 * DQK + c0 * 8; ksrc1 = Kh + (size_t)row1 * DQK + c1 * 8; }
    const bf16* vsrc = Vh + (size_t)(16 * (wid & 3) + (lane >> 2)) * 1024 + (wid >> 2) * 32 + (lane & 3) * 8;
#define ATT_TIX(i) (((i) == 0) ? 0 : (((i) < 5) ? 4 * qb + (i) : (i) - 4))
#define ATT_DMA(i, slot) do { const int _t = ATT_TIX(i); const unsigned _s = lds0 + (slot); glds16(ksrc0 + (size_t)_t * 64 * DQK, (unsigned)__builtin_amdgcn_readfirstlane(_s + wid * 2048)); \
        glds16(ksrc1 + (size_t)_t * 64 * DQK, (unsigned)__builtin_amdgcn_readfirstlane(_s + wid * 2048 + 1024)); \
        glds16(vsrc + (size_t)_t * 64 * 1024, (unsigned)__builtin_amdgcn_readfirstlane(_s + KSLOT + wid * 1024)); } while (0)
#define ATT_BAR() asm volatile("s_waitcnt vmcnt(0) lgkmcnt(0)\n\ts_barrier" ::: "memory")
#define ATT_BARC(issued) do { if (issued) asm volatile("s_waitcnt vmcnt(3) lgkmcnt(0)\n\ts_barrier" ::: "memory"); else ATT_BAR(); } while (0)
#define ATT_KLD(slot, hh) do { const LAS unsigned char* kb_ = kp0 + (slot) + (hh) * 8192; int xk_ = xk; asm volatile("" : "+v"(xk_));     \
        _Pragma("unroll") for (int d0 = 0; d0 < 6; ++d0) kf[d0] = *(const LAS bf16x8*)(kb_ + (((2 * d0 + hi) ^ xk_) << 4)); } while (0)
#define ATT_QKM(S) do { S = __builtin_amdgcn_mfma_f32_32x32x16_bf16(kf[0], qr[0], negm, 0, 0, 0); _Pragma("unroll") for (int d0 = 1; d0 < 6; ++d0) S = __builtin_amdgcn_mfma_f32_32x32x16_bf16(kf[d0], qr[d0], S, 0, 0, 0); } while (0)
#define ATT_RMAX(S, RM) do { float a_ = max3f(S[0], S[1], S[2]), b_ = max3f(S[3], S[4], S[5]); a_ = max3f(a_, S[6], S[7]); b_ = max3f(b_, S[8], S[9]); a_ = max3f(a_, S[10], S[11]); b_ = max3f(b_, S[12], S[13]); a_ = max3f(a_, S[14], S[15]); a_ = max2f(a_, b_); \
        { const auto rr = __builtin_amdgcn_permlane32_swap(__float_as_uint(a_), __float_as_uint(a_), false, false); RM = max2f(__uint_as_float(rr[0]), __uint_as_float(rr[1])); } } while (0)
#define ATT_RESC(S, rm) do { \
        if (__any(rm > THR)) { const float dl = fmaxf(rm, 0.f), f = __builtin_amdgcn_exp2f(-dl); m_run += dl; l_run *= f; if (hi == 0) wsf[r32] = f; \
            _Pragma("unroll") for (int r = 0; r < 16; ++r) { const float fr_ = wsf[crow(r, hi)]; o[0][r] *= fr_; o[1][r] *= fr_; } \
            _Pragma("unroll") for (int r = 0; r < 16; ++r) { S[r] -= dl; negm[r] = -m_run; } } } while (0)
#define ATT_SMA(S) do { float rm_; ATT_RMAX(S, rm_); ATT_RESC(S, rm_); } while (0)
#define ATT_VLD(slot, hh) do { const LAS unsigned char* vp_ = vp0 + (slot) + (hh) * 2048; \
        _Pragma("unroll") for (int d0 = 0; d0 < 2; ++d0) _Pragma("unroll") for (int kk = 0; kk < 2; ++kk) { vl[d0 * 2 + kk] = vtr(vp_ + d0 * 4096 + kk * 1024); vh[d0 * 2 + kk] = vtr(vp_ + d0 * 4096 + kk * 1024 + 512); } } while (0)
#define ATT_VF(x) ((bf16x8){vl[x][0], vl[x][1], vl[x][2], vl[x][3], vh[x][0], vh[x][1], vh[x][2], vh[x][3]})
#define ATT_PVM(PA, PB) do { _Pragma("unroll") for (int d0 = 0; d0 < 2; ++d0) { \
            o[d0] = __builtin_amdgcn_mfma_f32_32x32x16_bf16(__builtin_bit_cast(bf16x8, PA), ATT_VF(d0 * 2), o[d0], 0, 0, 0); \
            o[d0] = __builtin_amdgcn_mfma_f32_32x32x16_bf16(__builtin_bit_cast(bf16x8, PB), ATT_VF(d0 * 2 + 1), o[d0], 0, 0, 0); } } while (0)
#define ATT_SMB(S, PA, PB) do { float sacc = 0.f; \
        _Pragma("unroll") for (int r = 0; r < 16; ++r) { S[r] = __builtin_amdgcn_exp2f(S[r]); sacc += S[r]; } \
        l_run += sacc; \
        PA = (u32x4){pk2(S[0], S[1]), pk2(S[2], S[3]), pk2(S[4], S[5]), pk2(S[6], S[7])}; PB = (u32x4){pk2(S[8], S[9]), pk2(S[10], S[11]), pk2(S[12], S[13]), pk2(S[14], S[15])}; } while (0)
#define ATT_PVH(slot, hh, PA, PB) do { const LAS unsigned char* vp_ = vp0 + (slot) + (hh) * 2048; \
        _Pragma("unroll") for (int d0 = 0; d0 < 2; ++d0) { const s16x4 l0_ = vtr(vp_ + d0 * 4096), h0_ = vtr(vp_ + d0 * 4096 + 512), l1_ = vtr(vp_ + d0 * 4096 + 1024), h1_ = vtr(vp_ + d0 * 4096 + 1536); \
            o[d0] = __builtin_amdgcn_mfma_f32_32x32x16_bf16(__builtin_bit_cast(bf16x8, PA), ((bf16x8){l0_[0], l0_[1], l0_[2], l0_[3], h0_[0], h0_[1], h0_[2], h0_[3]}), o[d0], 0, 0, 0); \
            o[d0] = __builtin_amdgcn_mfma_f32_32x32x16_bf16(__builtin_bit_cast(bf16x8, PB), ((bf16x8){l1_[0], l1_[1], l1_[2], l1_[3], h1_[0], h1_[1], h1_[2], h1_[3]}), o[d0], 0, 0, 0); } } while (0)
    ATT_DMA(0, 0); ATT_DMA(1, SLOT); if (2 < NT) ATT_DMA(2, 2 * SLOT);
    bf16x8 qr[6], kf[6];
    { const bf16* Qw = QF + (rowq0 + r32) * 768 + h * DQK + hi * 8;
#pragma unroll
        for (int d0 = 0; d0 < 6; ++d0) qr[d0] = *(const bf16x8*)(Qw + 16 * d0); }
    LAS float* wsf = (LAS float*)(F.lds + L_WS) + wid * 64;
    float m_run = 0.f, l_run = 0.f; f32x16 o[2]; o[0] = f32x16{}; o[1] = f32x16{}; f32x16 negm = f32x16{};
    const LAS unsigned char* kp0 = F.lds + r32 * 256;
    const int xk = r32 & 15;
    const LAS unsigned char* vp0 = F.lds + KSLOT + ((lane >> 4) & 1) * 32 + (lane & 3) * 8 + (4 * hi + ((lane & 15) >> 2)) * 64;
    u32x4 pw0, pw1; f32x16 sa, sb;
    ATT_BAR();
    int sl = 0, sl3 = 3 * SLOT;
#define ATT_ROT() do { sl = (sl == 3 * SLOT) ? 0 : sl + SLOT; sl3 = (sl3 == 3 * SLOT) ? 0 : sl3 + SLOT; } while (0)
#pragma unroll 1
    for (int i = 0; i < 5; ++i) {
        if (i + 3 < NT) ATT_DMA(i + 3, sl3);
        const int jb = i - 1;
#pragma unroll
        for (int hh = 0; hh < 2; ++hh) {
            const bool skip = (i == 0) ? (hh == 1) : (64 * jb + 32 * hh > 32 * wid + 31);
            if (!skip) {
                ATT_KLD(sl, hh); ATT_QKM(sa);
                if (i == 0) {
#pragma unroll
                    for (int r = 0; r < 16; ++r) if (crow(r, hi) >= NMETA) sa[r] = -INFINITY;
                } else if (64 * jb + 32 * hh + 31 > 32 * wid) {
                    const int qrel = 32 * wid + r32 - 64 * jb - 32 * hh;
#pragma unroll
                    for (int r = 0; r < 16; ++r) if (crow(r, hi) > qrel) sa[r] = -INFINITY;
                }
                ATT_SMA(sa); ATT_SMB(sa, pw0, pw1); ATT_PVH(sl, hh, pw0, pw1);
            }
        }
        ATT_BARC(i + 3 < NT); ATT_ROT();
    }
    if (NT > 5) {
        s16x4 vl[4], vh[4]; float rm;
        ATT_KLD(sl, 0); ATT_QKM(sa);
        ATT_KLD(sl, 1); __builtin_amdgcn_sched_barrier(0);
        ATT_RMAX(sa, rm); ATT_RESC(sa, rm);
        ATT_QKM(sb); ATT_SMB(sa, pw0, pw1);
        ATT_VLD(sl, 0);
#pragma unroll 1
        for (int i = 5; i < NT - 1; ++i) {
            if (i + 3 < NT) ATT_DMA(i + 3, sl3);
            const int sln = (sl == 3 * SLOT) ? 0 : sl + SLOT;
            ATT_KLD(sln, 0); __builtin_amdgcn_sched_barrier(0);
            ATT_PVM(pw0, pw1); ATT_RMAX(sb, rm);
            ATT_RESC(sb, rm);
            ATT_QKM(sa); ATT_SMB(sb, pw0, pw1);
            ATT_VLD(sl, 1);
            ATT_BARC(i + 3 < NT); ATT_ROT();
            ATT_KLD(sl, 1); __builtin_amdgcn_sched_barrier(0);
            ATT_PVM(pw0, pw1); ATT_RMAX(sa, rm);
            ATT_RESC(sa, rm);
            ATT_QKM(sb); ATT_SMB(sa, pw0, pw1);
            ATT_VLD(sl, 0);
        }
        ATT_PVM(pw0, pw1); ATT_RMAX(sb, rm);
        ATT_RESC(sb, rm);
        ATT_SMB(sb, pw0, pw1);
        ATT_VLD(sl, 1);
        ATT_PVM(pw0, pw1);
        ATT_BAR();
    }
    { const auto rr = __builtin_amdgcn_permlane32_swap(__float_as_uint(l_run), __float_as_uint(l_run), false, false); l_run = __uint_as_float(rr[0]) + __uint_as_float(rr[1]); }
    if (hi == 0) wsf[32 + r32] = l_run;
    float rli[16];
#pragma unroll
    for (int r = 0; r < 16; ++r) rli[r] = __builtin_amdgcn_rcpf(wsf[32 + crow(r, hi)]);
    { LAS bf16* stg = (LAS bf16*)(F.lds + L_OST) + wid * 2048;
#pragma unroll
        for (int r = 0; r < 16; ++r) { const int orow = crow(r, hi);
#pragma unroll
            for (int d0 = 0; d0 < 2; ++d0) stg[orow * 64 + d0 * 32 + r32] = (bf16)f2bf(o[d0][r] * rli[r]); }
        asm volatile("s_waitcnt lgkmcnt(0)" ::: "memory");
#pragma unroll
        for (int i = 0; i < 4; ++i) { const int row = i * 8 + (lane >> 3), ch = lane & 7; const u32x4 v = *(const LAS u32x4*)(stg + row * 64 + ch * 8);
            *(u32x4*)(O + (rowq0 + row) * 1024 + h * DV + ch * 8) = v; } }
    asm volatile("s_waitcnt lgkmcnt(0)\n\ts_barrier" ::: "memory");
#undef ATT_TIX
#undef ATT_DMA
#undef ATT_BAR
#undef ATT_BARC
#undef ATT_KLD
#undef ATT_QKM
#undef ATT_SMA
#undef ATT_RMAX
#undef ATT_RESC
#undef ATT_VLD
#undef ATT_VF
#undef ATT_PVM
#undef ATT_SMB
#undef ATT_PVH
#undef ATT_ROT
}
__device__ __forceinline__ void attn_phase(Ctx& F) {
    for (int v = F.vcu; v < 256; v += F.G) { const int bh = v >> 2, s = v & 3;
#pragma unroll 1
        for (int i = 0; i < 4; ++i) { const int qb = (i == 0) ? s : (i == 1) ? 7 - s : (i == 2) ? 8 + s : 15 - s; attn_unit(F, bh >> 3, bh & 7, qb); } }
}
}

__device__ __forceinline__ void p8_router(Ctx& F) {
    LAS float* xch = (LAS float*)F.lds;
    volatile LAS int* cnt_l = (volatile LAS int*)(F.lds + LDSCTL_OFF + 1024); volatile LAS int* base_l = cnt_l + 32;
    const bf16* H1 = WSP(bf16, WS_H1B);
    int* gcount = (int*)(F.ctl + CW_CNT); int* LTOK = WSP(int, WS_LTOK); float* LW = WSP(float, WS_LW); float* LRS = WSP(float, WS_LRS); int* TOKPOS = WSP(int, WS_TOKPOS);
    for (int un = F.vcu; un < MT / 128; un += F.G) {
        if (F.tid < 32) cnt_l[F.tid] = 0;
        const int j = F.lane & 31, kh = F.lane >> 5, grp = F.wave & 3, kq = F.wave >> 2; const int token = un * 128 + 32 * grp + j;
        int te[4] = {0, 0, 0, 0}, sl[4] = {0, 0, 0, 0}; float tg[4] = {0.f, 0.f, 0.f, 0.f}; float rstd = 0.f;
        f32x16 acc = f32x16{}; float ss = 0.f;
        { const bf16* row = H1 + (size_t)token * DM + 512 * kq + 8 * kh;
          const bf16* a0 = WSP(bf16, WS_RW3) + ((size_t)(64 * kq + kh) * NE + j) * 8;
#pragma unroll 4
            for (int st = 0; st < 32; ++st) { const u32x4 hw = *(const u32x4*)(row + 16 * st); f32x4 h0, h1; unpack8(hw, h0, h1);
                ss += ((h0[0] * h0[0] + h0[1] * h0[1]) + (h0[2] * h0[2] + h0[3] * h0[3])) + ((h1[0] * h1[0] + h1[1] * h1[1]) + (h1[2] * h1[2] + h1[3] * h1[3]));
                const bf16x8 hb = __builtin_bit_cast(bf16x8, hw);
                const bf16x8 ah = *(const bf16x8*)(a0 + 512 * st), am = *(const bf16x8*)(a0 + (size_t)NE * DM + 512 * st), al = *(const bf16x8*)(a0 + (size_t)2 * NE * DM + 512 * st);
                acc = __builtin_amdgcn_mfma_f32_32x32x16_bf16(al, hb, acc, 0, 0, 0); acc = __builtin_amdgcn_mfma_f32_32x32x16_bf16(am, hb, acc, 0, 0, 0); acc = __builtin_amdgcn_mfma_f32_32x32x16_bf16(ah, hb, acc, 0, 0, 0); } }
        if (kq == 1) { LAS float* xp = xch + grp * 17 * 64 + F.lane;
#pragma unroll
            for (int r = 0; r < 16; ++r) xp[r * 64] = acc[r];
            xp[16 * 64] = ss; }
        __syncthreads();
        if (kq == 0) {
            { const LAS float* xp = xch + grp * 17 * 64 + F.lane;
#pragma unroll
                for (int r = 0; r < 16; ++r) acc[r] += xp[r * 64];
                ss += xp[16 * 64]; }
            ss += __shfl_xor(ss, 32);
            rstd = 1.f / sqrtf(ss * (1.f / DM) + NORM_EPS);
            float cv[8]; int ci[8];
            float lv[16];
#pragma unroll
            for (int r = 0; r < 16; ++r) lv[r] = acc[r] * rstd + F.router_b[att::crow(r, kh)];
#pragma unroll
            for (int k = 0; k < 4; ++k) { float bv = -INFINITY; int bi = 0;
#pragma unroll
                for (int r = 0; r < 16; ++r) { const bool better = lv[r] > bv; bv = better ? lv[r] : bv; bi = better ? r : bi; }
#pragma unroll
                for (int r = 0; r < 16; ++r) if (r == bi) lv[r] = -INFINITY;
                cv[k] = bv; ci[k] = att::crow(bi, kh); }
#pragma unroll
            for (int k = 0; k < 4; ++k) { cv[4 + k] = __shfl_xor(cv[k], 32); ci[4 + k] = __shfl_xor(ci[k], 32); }
#pragma unroll
            for (int k = 0; k < 4; ++k) { float bv = -INFINITY; int bi = 1 << 20, bp = 0;
#pragma unroll
                for (int c = 0; c < 8; ++c) { const bool better = (cv[c] > bv) || (cv[c] == bv && ci[c] < bi); bv = better ? cv[c] : bv; bi = better ? ci[c] : bi; bp = better ? c : bp; }
#pragma unroll
                for (int c = 0; c < 8; ++c) if (c == bp) cv[c] = -INFINITY;
                tg[k] = bv; te[k] = bi; }
            { const float e1 = __expf(tg[1] - tg[0]), e2 = __expf(tg[2] - tg[0]), e3 = __expf(tg[3] - tg[0]); const float inv = 1.f / (1.f + e1 + e2 + e3); tg[0] = inv; tg[1] = e1 * inv; tg[2] = e2 * inv; tg[3] = e3 * inv; }
            if (kh == 0) {
#pragma unroll
                for (int k = 0; k < 4; ++k) sl[k] = __hip_atomic_fetch_add((LAS int*)&cnt_l[te[k]], 1, __ATOMIC_RELAXED, __HIP_MEMORY_SCOPE_WORKGROUP); }
        }
        __syncthreads();
        if (F.tid < 32) base_l[F.tid] = atomicAdd(gcount + F.tid, cnt_l[F.tid]);
        __syncthreads();
        if (kq == 0 && kh == 0) {
#pragma unroll
            for (int k = 0; k < 4; ++k) { const int slot = base_l[te[k]] + sl[k]; const size_t li = (size_t)te[k] * ECAP + slot;
                LTOK[li] = token; LW[li] = tg[k]; LRS[li] = rstd; TOKPOS[token * 4 + k] = te[k] * ECAP + slot; } }
        __syncthreads();
    }
}

__device__ __forceinline__ void moe_table(Ctx& F) {
    volatile LAS int* tb = (volatile LAS int*)(F.lds + LDSCTL_OFF); volatile LAS int* cnt = (volatile LAS int*)(F.lds + LDSCTL_OFF + 256);
    if (F.tid < 64) { const int* gcount = (const int*)(F.ctl + CW_CNT); const int c = (F.lane < NE) ? gcount[F.lane] : 0; const int nt = (c + 255) >> 8;
        int incl = nt;
#pragma unroll
        for (int o = 1; o < 32; o <<= 1) { const int v = __shfl_up(incl, o); if ((F.lane & 31) >= o) incl += v; }
        if (F.lane < NE) { cnt[F.lane] = c; tb[F.lane] = incl - nt; if (F.lane == NE - 1) tb[NE] = incl; } }
    __syncthreads();
    { const int TT = tb[NE];
      for (int mt = F.tid; mt < TT; mt += 512) { int e = 0;
#pragma unroll
          for (int st = 16; st >= 1; st >>= 1) if (e + st < NE && tb[e + st] <= mt) e += st;
          tb[512 + mt] = e; } }
    __syncthreads();
}

__device__ __forceinline__ void p11_combine(Ctx& F) {
    const volatile LAS int* tb = (const volatile LAS int*)(F.lds + LDSCTL_OFF);
    const int gw = F.vcu * 8 + F.wave, NGW = F.G * 8;
    const bf16* H1 = WSP(bf16, WS_H1B); const unsigned char* Y = WSP(unsigned char, WS_Y); const int* TOKPOS = WSP(int, WS_TOKPOS);
    typedef int i32x4v __attribute__((ext_vector_type(4)));
    const i32x4v* TP4 = (const i32x4v*)TOKPOS;
    i32x4v tp[2]; { const int m0 = gw, m1 = gw + NGW; tp[0] = TP4[m0 < MT ? m0 : 0]; tp[1] = TP4[m1 < MT ? m1 : 0]; }
    for (int mb = gw; mb < MT; mb += 2 * NGW) {
        i32x4v tn[2]; { const int n0 = mb + 2 * NGW, n1 = mb + 3 * NGW; tn[0] = TP4[n0 < MT ? n0 : 0]; tn[1] = TP4[n1 < MT ? n1 : 0]; }
        u32x4 hw[2][2], yw[2][4];
#pragma unroll
        for (int q = 0; q < 2; ++q) { const int m = mb + q * NGW; const int mm = m < MT ? m : mb;
            const u32x4* hp = (const u32x4*)(H1 + (size_t)mm * DM + 16 * F.lane); hw[q][0] = __builtin_nontemporal_load(hp); hw[q][1] = __builtin_nontemporal_load(hp + 1);
#pragma unroll
            for (int k = 0; k < 4; ++k) { const int p = tp[q][k], e = p >> 15, slot = p & (ECAP - 1); const size_t yr = (size_t)tb[e] * 256 + slot;
                yw[q][k] = __builtin_nontemporal_load((const u32x4*)(Y + yr * DM + 16 * F.lane)); } }
#pragma unroll
        for (int q = 0; q < 2; ++q) { const int m = mb + q * NGW; if (m < MT) {
            f32x4 a0, a1, a2, a3; unpack8(hw[q][0], a0, a1); unpack8(hw[q][1], a2, a3);
            f32x4 s0 = {0.f, 0.f, 0.f, 0.f}, s1 = s0, s2 = s0, s3 = s0;
#pragma unroll
            for (int k = 0; k < 4; ++k) { const u32x4 y = yw[q][k];
                { const f32x2 p0 = __builtin_amdgcn_cvt_pk_f32_fp8((int)y.x, false), p1 = __builtin_amdgcn_cvt_pk_f32_fp8((int)y.x, true); s0[0] += p0[0]; s0[1] += p0[1]; s0[2] += p1[0]; s0[3] += p1[1]; }
                { const f32x2 p0 = __builtin_amdgcn_cvt_pk_f32_fp8((int)y.y, false), p1 = __builtin_amdgcn_cvt_pk_f32_fp8((int)y.y, true); s1[0] += p0[0]; s1[1] += p0[1]; s1[2] += p1[0]; s1[3] += p1[1]; }
                { const f32x2 p0 = __builtin_amdgcn_cvt_pk_f32_fp8((int)y.z, false), p1 = __builtin_amdgcn_cvt_pk_f32_fp8((int)y.z, true); s2[0] += p0[0]; s2[1] += p0[1]; s2[2] += p1[0]; s2[3] += p1[1]; }
                { const f32x2 p0 = __builtin_amdgcn_cvt_pk_f32_fp8((int)y.w, false), p1 = __builtin_amdgcn_cvt_pk_f32_fp8((int)y.w, true); s3[0] += p0[0]; s3[1] += p0[1]; s3[2] += p1[0]; s3[3] += p1[1]; } }
            a0 += s0 * Y8_INV; a1 += s1 * Y8_INV; a2 += s2 * Y8_INV; a3 += s3 * Y8_INV;
            f32x4* op = (f32x4*)(F.out + (size_t)m * DM + 16 * F.lane); op[0] = a0; op[1] = a1; op[2] = a2; op[3] = a3; } }
        tp[0] = tn[0]; tp[1] = tn[1];
    }
}

#define LDS_TB ((const volatile LAS int*)(F.lds + LDSCTL_OFF))
#define LDS_CNT ((const volatile LAS int*)(F.lds + LDSCTL_OFF + 256))
__device__ __forceinline__ void ph1_inproj(Ctx& F) { p1_meta(F);
    pg8::Dense P; P.init(WSP(bf16, INPROJ_FP8 ? WS_XQ : WS_XN), WSP(bf16, WS_WIN), MT, NINP, INPROJ_FP8 ? DM / 2 : DM, F.G, (int)blockIdx.x);
    EpiInProj E{WSP(bf16, WS_HG), WSP(bf16, WS_QLAT), WSP(bf16, WS_KVLAT), WSP(bf16, WS_G), WSP(bf16, WS_G) + (size_t)MT * 1024, F.gate_b, WSP(float, WS_KPESS), WSP(float, WS_RSX), WSP(float, WS_RSQ), WSP(float, WS_RSC)};
    pg8::gemm_phase<pg8::Dense, EpiInProj, INPROJ_FP8 != 0>(F.lds, P, E); }
#ifndef PROBE_P3
#define PROBE_P3 0
#endif
__device__ __forceinline__ void ph3_smallgemms(Ctx& F) { p2_thin(F); p4_headnorm(F);
#if PROBE_P3 == 1
    __syncthreads(); p2_thin(F); p4_headnorm(F);
#endif
    { pg8::Dense P; P.init(WSP(bf16, WS_QLAT), WSP(bf16, WS_WQB), MT, 1024, 256, F.G, (int)blockIdx.x); EpiQHead E{WSP(bf16, WS_QF), WSP(float, WS_RSQ), F.q_nw, WSP(float, WS_ROPE), F.lds}; pg8::gemm_phase(F.lds, P, E); }
    { pg8::Dense P; P.init(WSP(bf16, WS_KVLAT), WSP(bf16, WS_WKVB), MT, 1024, 256, F.G, (int)blockIdx.x); EpiKVHead E{WSP(bf16, WS_KF), WSP(bf16, WS_KVRAW), WSP(bf16, WS_KVLAT), WSP(float, WS_RSC), WSP(float, WS_KPESS), F.k_nw, WSP(float, WS_ROPE), F.lds}; pg8::gemm_phase(F.lds, P, E); }
 }
__device__ __forceinline__ void ph6_wo(Ctx& F) { pg8::Dense P; P.init(WSP(bf16, WS_HCO), WSP(bf16, WS_W2T), MT, 1024, 1024, F.G, (int)blockIdx.x); EpiMix E{WSP(bf16, WS_MIX), WSP(bf16, WS_G), WSP(bf16, WS_G) + (size_t)MT * 1024}; pg8::gemm_phase<pg8::Dense, EpiMix, false, true>(F.lds, P, E); }
__device__ __forceinline__ void ph7_wout(Ctx& F) { pg8::Dense P; P.init(WSP(bf16, WS_MIX), WSP(bf16, WS_WOUT), MT, 1024, 1024, F.G, (int)blockIdx.x); EpiResid E{WSP(bf16, WS_XN), WSP(bf16, WS_H1B), WSP(unsigned char, WS_H1Q)}; pg8::gemm_phase<pg8::Dense, EpiResid, false, true>(F.lds, P, E); }
__device__ __forceinline__ void ph9_moe1(Ctx& F) { moe_table(F);
    pg8::Moe<true> P{WSP(bf16, WS_H1Q), WSP(bf16, WS_WGU), DM / 2, 8, F.G, F.vcu, WSP(int, WS_LTOK), LDS_TB, LDS_CNT};
    EpiSwiGLU E{WSP(unsigned char, WS_ACT), F.b_gu, WSP(float, WS_LRS), LDS_TB}; pg8::gemm_phase<pg8::Moe<true>, EpiSwiGLU, true>(F.lds, P, E); }
__device__ __forceinline__ void ph10_moe2(Ctx& F) {
#if !MK_ONE_LAUNCH
    moe_table(F);
#endif
    pg8::Moe<false> P{WSP(bf16, WS_ACT), WSP(bf16, WS_WD), DFF / 2, 4, F.G, F.vcu, nullptr, LDS_TB, LDS_CNT};
    EpiDown E{WSP(unsigned char, WS_Y), F.b_d, WSP(float, WS_LW), LDS_TB}; pg8::gemm_phase<pg8::Moe<false>, EpiDown, true, true>(F.lds, P, E); }
__device__ __forceinline__ void ph11_combine(Ctx& F) {
#if !MK_ONE_LAUNCH
    moe_table(F);
#endif
    p11_combine(F); }

struct Args { const float* in[25]; float* out; unsigned char* ws; int ph_lo, ph_hi; };
__global__ void __launch_bounds__(512, 2) mk_fwd(Args args) {
    extern __shared__ __attribute__((aligned(16))) unsigned char lds_raw[];
    Ctx F;
    F.lds = (LAS unsigned char*)lds_raw; F.ws = args.ws; F.ctl = (gu32*)(args.ws + WS_CTL);
    F.tid = threadIdx.x; F.lane = F.tid & 63; F.wave = __builtin_amdgcn_readfirstlane(F.tid >> 6);
    F.G = gridDim.x; { const int bx = blockIdx.x; F.vcu = (F.G % 8 == 0) ? (bx % 8) * (F.G / 8) + bx / 8 : bx; }
    F.x = args.in[0]; F.meta = args.in[1]; F.attn_nw = args.in[2]; F.w_in = args.in[3]; F.dw_w = args.in[4]; F.dw_b = args.in[5]; F.ln_w = args.in[6]; F.ln_b = args.in[7]; F.pw2_w = args.in[8];
    F.qa_nw = args.in[9]; F.w_qb = args.in[10]; F.kva_nw = args.in[11]; F.w_kvb = args.in[12]; F.q_nw = args.in[13]; F.k_nw = args.in[14]; F.w_o = args.in[15]; F.gate_b = args.in[16]; F.w_out = args.in[17];
    F.ffn_nw = args.in[18]; F.router_w = args.in[19]; F.router_b = args.in[20]; F.w_gu = args.in[21]; F.b_gu = args.in[22]; F.w_d = args.in[23]; F.b_d = args.in[24]; F.out = args.out;
    for (int u = F.tid; u < (LDS_BYTES - LDSCTL_OFF) / 4; u += 512) ((LAS unsigned*)(F.lds + LDSCTL_OFF))[u] = 0u;
    __syncthreads();
    const int lo = args.ph_lo, hi = args.ph_hi;
    XcdBarrier bar; bar.bar = (unsigned*)(F.ctl + CW_BAR); bar.x = 0; bar.st = nullptr;
    if (hi - lo > 1) bar = xcd_barrier_post((unsigned*)(F.ctl + CW_BAR), (volatile LAS unsigned*)(F.lds + LDSCTL_OFF + 512));
#ifdef ONLY_PHASE
#define IN(k) ((k) == ONLY_PHASE && lo <= (k) && (k) < hi)
#else
#define IN(k) (lo <= (k) && (k) < hi)
#endif
#define SEAM(k) do { if (IN(k) && IN((k) + 1)) xcd_barrier(bar); } while (0)
#if USE_REFRESH
#define REFRESH() do { int _t = threadIdx.x; asm volatile("" : "+v"(_t)); F.tid = _t; F.lane = _t & 63; F.wave = __builtin_amdgcn_readfirstlane(_t >> 6); } while (0)
#else
#define REFRESH() do { } while (0)
#endif
#define PHASE(k, call) do { if (IN(k)) { REFRESH(); call; if (PROBE_REPEAT == (k)) { xcd_barrier(bar); call; } } SEAM(k); } while (0)

    PHASE(0, p0_prologue(F));
    PHASE(1, ph1_inproj(F));
    PHASE(3, ph3_smallgemms(F));
    PHASE(5, att::attn_phase(F));
    PHASE(6, ph6_wo(F));
    PHASE(7, ph7_wout(F));
#if PROBE_REPEAT == 8
    if (IN(8)) { REFRESH(); p8_router(F); xcd_barrier(bar); if (blockIdx.x == 0 && F.tid < NE) ((int*)(F.ctl + CW_CNT))[F.tid] = 0; xcd_barrier(bar); p8_router(F); } SEAM(8);
#else
    PHASE(8, p8_router(F));
#endif
    PHASE(9, ph9_moe1(F));
    PHASE(10, ph10_moe2(F));
    PHASE(11, ph11_combine(F));
#undef IN
#undef SEAM
#undef PHASE
}

extern "C" void kernel_launch(void* const* d_in, const int* in_sizes, int n_in, void* d_out, int out_size, void* d_ws, size_t ws_size, hipStream_t stream) {
    static int grid = 0;
    if (grid == 0) {
        if (n_in != 25 || in_sizes[0] != MT * DM || out_size != MT * DM || ws_size < WS_END) { fprintf(stderr, "kernel_launch: unexpected shapes (n_in %d, in0 %d, out %d, ws %zu < %zu); nothing launched\n", n_in, n_in > 0 ? in_sizes[0] : -1, out_size, ws_size, (size_t)WS_END); grid = -1; return; }
        int dev = 0, cus = 0, per_cu = 0;
        if (hipGetDevice(&dev) != hipSuccess || hipDeviceGetAttribute(&cus, hipDeviceAttributeMultiprocessorCount, dev) != hipSuccess) { grid = -1; return; }
        if (hipFuncSetAttribute((const void*)mk_fwd, hipFuncAttributeMaxDynamicSharedMemorySize, LDS_BYTES) != hipSuccess) { fprintf(stderr, "kernel_launch: hipFuncSetAttribute failed\n"); grid = -1; return; }
        if (hipOccupancyMaxActiveBlocksPerMultiprocessor(&per_cu, (const void*)mk_fwd, 512, LDS_BYTES) != hipSuccess || per_cu < 1) fprintf(stderr, "kernel_launch: note: occupancy query reports %d\n", per_cu);
        (void)hipGetLastError();
        grid = cus;
    }
    if (grid < 0) return;
    if (hipMemsetAsync((char*)d_ws + WS_CTL, 0, CTL_ZERO_BYTES, stream) != hipSuccess) return;
    Args a{};
    for (int i = 0; i < 25; ++i) a.in[i] = (const float*)d_in[i];
    a.out = (float*)d_out; a.ws = (unsigned char*)d_ws;
#if MK_ONE_LAUNCH
    a.ph_lo = 0; a.ph_hi = NPH;
    hipLaunchKernelGGL(mk_fwd, dim3(grid), dim3(512), LDS_BYTES, stream, a);
#else
    for (int p = 0; p < NPH; ++p) { a.ph_lo = p; a.ph_hi = p + 1; hipLaunchKernelGGL(mk_fwd, dim3(grid), dim3(512), LDS_BYTES, stream, a); }
#endif
}
```

```cpp
#include <hip/hip_runtime.h>
#include <cstdio>
#include <cstdint>

#define GAS __attribute__((address_space(1)))
#define LAS __attribute__((address_space(3)))
typedef unsigned short bf16;
typedef unsigned u32x4 __attribute__((ext_vector_type(4)));
typedef unsigned u32x2 __attribute__((ext_vector_type(2)));
typedef float f32x2 __attribute__((ext_vector_type(2)));
typedef float f32x4 __attribute__((ext_vector_type(4)));
typedef float f32x16 __attribute__((ext_vector_type(16)));
typedef short bf16x8 __attribute__((ext_vector_type(8)));
typedef short s16x4 __attribute__((ext_vector_type(4)));
typedef int i32x4 __attribute__((ext_vector_type(4)));
typedef int i32x8 __attribute__((ext_vector_type(8)));
typedef GAS unsigned gu32;

#ifndef PROBE_REPEAT
#define PROBE_REPEAT (-1)
#endif
#ifndef INPROJ_FP8
#define INPROJ_FP8 1
#endif
#ifndef PROBE_KLOOP2
#define PROBE_KLOOP2 0
#endif
#ifndef USE_REFRESH
#define USE_REFRESH 0
#endif
#ifndef RELAX_WAITS
#define RELAX_WAITS 0
#endif
#ifndef PROBE_EPI2
#define PROBE_EPI2 0
#endif
#ifndef PROBE_P2A
#define PROBE_P2A 0
#endif
#ifndef PROBE_P2B
#define PROBE_P2B 0
#endif
#ifndef MK_ONE_LAUNCH
#define MK_ONE_LAUNCH 1
#endif

constexpr int NB = 8, SEQ = 4096, DM = 1024, MT = NB * SEQ;
constexpr int NMETA = 16;
constexpr int CDIM = 512, CWID = 31;
constexpr int NH = 8, DNOPE = 64, DROPE = 32, DQK = 96, DV = 64, QLR = 256, KVLR = 128;
constexpr int INC = 3488, NINP = 3584;
constexpr int NE = 32, DFF = 1024, ECAP = 32768;
constexpr int LPC = 4128, HGOFF = 32;
constexpr int LPK = 4160, KOFF = 64;
constexpr int PMC = 1184;
constexpr float NORM_EPS = 1e-6f;
constexpr float SW_LIMIT = 7.0f, SW_ALPHA = 1.702f;
constexpr float QSCALE = 0.10206207261596577f * 1.4426950408889634f;
constexpr int NPH = 12;

constexpr size_t MiB = 1u << 20;
constexpr size_t WS_CTL = 0, CTL_ZERO_BYTES = 1 * MiB;
constexpr int CW_TMO = 0, CW_CODE = 1, CW_BAR = 4096, CW_CNT = 8192, CW_PM = 16384;
constexpr size_t WS_METARS = 1 * MiB;
constexpr size_t WS_KVMETA = 1 * MiB + 4096;
constexpr size_t WS_ROPE = 1 * MiB + 512 * 1024;
constexpr size_t WS_RSQ = 156 * MiB, WS_RSC = 157 * MiB;
constexpr size_t WS_KPESS = 2 * MiB + 384 * 1024;
constexpr size_t WS_RWP = 2 * MiB + 512 * 1024;
constexpr size_t WS_RW3 = 2 * MiB + 768 * 1024;
constexpr size_t WS_TOKPOS = 3 * MiB;
constexpr size_t WS_LTOK = 4 * MiB, WS_LW = 8 * MiB, WS_LRS = 12 * MiB;
constexpr size_t WS_WIN = 16 * MiB, WS_WPW2 = 23 * MiB, WS_WQB = 24 * MiB, WS_WKVB = 24 * MiB + 512 * 1024, WS_WO = 25 * MiB, WS_WOUT = 26 * MiB;
constexpr size_t WS_WGU = 28 * MiB, WS_WD = 92 * MiB;
constexpr size_t WS_XQ = 124 * MiB;
constexpr float XQ_SCALE = 16.f;
constexpr size_t WS_H1Q = 124 * MiB;
constexpr size_t WS_W2T = 220 * MiB, WS_H1B = 348 * MiB;
constexpr size_t WS_BIG = 412 * MiB;
constexpr size_t WS_ACT = WS_BIG, WS_Y = WS_BIG + 273 * MiB;
constexpr size_t WS_XN = WS_BIG + 289 * MiB, WS_QF = WS_BIG;
constexpr size_t WS_RSX = 2 * MiB + 640 * 1024;
constexpr size_t WS_G = WS_BIG + 64 * MiB, WS_HG = WS_BIG + 192 * MiB, WS_MIX = WS_BIG + 192 * MiB;
constexpr size_t WS_QLAT = WS_BIG + 225 * MiB, WS_KVLAT = WS_BIG + 241 * MiB, WS_HC = WS_BIG + 257 * MiB;
constexpr size_t WS_QRAW = WS_BIG + 289 * MiB, WS_KVRAW = WS_BIG + 353 * MiB, WS_HCO = WS_BIG + 418 * MiB, WS_KF = WS_BIG + 482 * MiB;
constexpr size_t WS_PMP = WS_BIG + 564 * MiB, WS_PMF = WS_BIG + 565 * MiB;
constexpr size_t WS_END = WS_BIG + 566 * MiB;
static_assert(WS_Y + (size_t)139520 * 2048 <= WS_END && WS_HG + (size_t)NB * LPC * CDIM * 2 <= WS_QLAT && WS_KVRAW + (size_t)NB * LPK * 2048 <= WS_HCO && WS_KF + (size_t)NB * LPK * 1536 <= WS_BIG + 531 * MiB, "ws map");

constexpr int RING_BYTES = 131072;
constexpr int LDSCTL_OFF = RING_BYTES;
constexpr int LDS_BYTES = 147456;

#define RLX_AGENT __ATOMIC_RELAXED, __HIP_MEMORY_SCOPE_AGENT
#define LDS_WAIT() asm volatile("s_waitcnt lgkmcnt(0)" ::: "memory")
#define VM_WAIT() asm volatile("s_waitcnt vmcnt(0)" ::: "memory")
__device__ __forceinline__ unsigned f2bf(float f) { unsigned u = __builtin_bit_cast(unsigned, f); return (u + 0x7fffu + ((u >> 16) & 1u)) >> 16; }
typedef __bf16 hwbf16x2 __attribute__((ext_vector_type(2)));
__device__ __forceinline__ unsigned pk2(float lo, float hi) { const f32x2 v = {lo, hi}; return __builtin_bit_cast(unsigned, __builtin_convertvector(v, hwbf16x2)); }
__device__ __forceinline__ float bflo(unsigned w) { return __builtin_bit_cast(float, w << 16); }
__device__ __forceinline__ float bfhi(unsigned w) { return __builtin_bit_cast(float, w & 0xffff0000u); }
constexpr float Y8_SCALE = 8.f, Y8_INV = 1.f / 8.f;
constexpr float W8_SCALE = 64.f, W8_INV = 1.f / 64.f;
__device__ __forceinline__ unsigned pk4_fp8(float a, float b, float c, float d) { int v = __builtin_amdgcn_cvt_pk_fp8_f32(a, b, 0, false); v = __builtin_amdgcn_cvt_pk_fp8_f32(c, d, v, true); return (unsigned)v; }
__device__ __forceinline__ float sigmoid_f(float x) { return __builtin_amdgcn_rcpf(1.f + __expf(-x)); }
__device__ __forceinline__ float sum16(float v) {
#pragma unroll
    for (int o = 1; o < 16; o <<= 1) v += __shfl_xor(v, o);
    return v;
}
__device__ __forceinline__ float wave_sum(float v) {
#pragma unroll
    for (int o = 1; o < 64; o <<= 1) v += __shfl_xor(v, o);
    return v;
}

#define XB_TMO      128
#define XB_XCNT(j)  (256  + 64 * (j))
#define XB_XSUB(j)  (1280 + 64 * (j))
#define XB_XGEN(j)  (2304 + 64 * (j))
#define XB_TOP      3328
#define XB_TOPGEN   3392
#define XCD_BAR_WORDS 3456
#define XB_SPIN_CAP (1u << 18)
__device__ __forceinline__ unsigned xb_ld(unsigned* p)              { return __hip_atomic_load(p, __ATOMIC_RELAXED, __HIP_MEMORY_SCOPE_AGENT); }
__device__ __forceinline__ unsigned xb_add(unsigned* p, unsigned v) { return __hip_atomic_fetch_add(p, v, __ATOMIC_RELAXED, __HIP_MEMORY_SCOPE_AGENT); }
__device__ __forceinline__ unsigned xb_xcc_id() { return (unsigned)__builtin_amdgcn_s_getreg((3 << 11) | 20) & 0xFu; }
#define XB_SPIN(cond, bar) do { unsigned _sp = 0; while (cond) { __builtin_amdgcn_s_sleep(1); \
    if ((++_sp & 255u) == 0u) { if (xb_ld(&(bar)[XB_TMO])) break; if (_sp > XB_SPIN_CAP) { atomicAdd(&(bar)[XB_TMO], 1u); break; } } } } while (0)
struct XcdBarrier { unsigned* bar; unsigned x; volatile LAS unsigned* st; };
__device__ __forceinline__ XcdBarrier xcd_barrier_post(unsigned* bar, volatile LAS unsigned* st) {
    XcdBarrier b; b.bar = bar; b.x = xb_xcc_id(); b.st = st;
    if (threadIdx.x == 0) (void)xb_add(&bar[XB_XCNT(b.x)], 1u);
    return b;
}
__device__ __forceinline__ void xcd_barrier_complete(unsigned* bar, unsigned x, unsigned& nloc, unsigned& nx) {
    const unsigned G = gridDim.x * gridDim.y * gridDim.z;
    unsigned sum, cnt, mine, sp = 0u;
    for (;;) {
        sum = 0u; cnt = 0u; mine = 0u;
#pragma unroll
        for (unsigned j = 0; j < 16; ++j) { const unsigned c = xb_ld(&bar[XB_XCNT(j)]); sum += c; cnt += (c > 0u) ? 1u : 0u; mine = (j == x) ? c : mine; }
        if (sum == G) break;
        __builtin_amdgcn_s_sleep(1);
        if ((++sp & 255u) == 0u) { if (xb_ld(&bar[XB_TMO])) break; if (sp > XB_SPIN_CAP) { atomicAdd(&bar[XB_TMO], 1u); break; } }
    }
    nloc = mine > 0u ? mine : 1u; nx = cnt > 0u ? cnt : 1u;
}
__device__ __forceinline__ void xcd_barrier(const XcdBarrier& b) {
    asm volatile("s_waitcnt vmcnt(0)" ::: "memory");
    __syncthreads();
    if (threadIdx.x == 0) {
        unsigned* bar = b.bar;
        __builtin_amdgcn_s_waitcnt(0);
        unsigned nloc = b.st[0], nx = b.st[1];
        if (nloc == 0u) { xcd_barrier_complete(bar, b.x, nloc, nx); b.st[0] = nloc; b.st[1] = nx; }
        const unsigned old = xb_add(&bar[XB_XSUB(b.x)], 1u);
        const unsigned gen = old / nloc;
        if (old + 1u == (gen + 1u) * nloc) {
            __builtin_amdgcn_fence(__ATOMIC_RELEASE, "agent");
            asm volatile("s_waitcnt vmcnt(0)" ::: "memory");
            const unsigned og = xb_add(&bar[XB_TOP], 1u);
            const unsigned tg = og / nx;
            if (og + 1u == (tg + 1u) * nx) xb_add(&bar[XB_TOPGEN], 1u);
            else XB_SPIN(xb_ld(&bar[XB_TOPGEN]) == tg, bar);
            xb_add(&bar[XB_XGEN(b.x)], 1u);
            __builtin_amdgcn_fence(__ATOMIC_ACQUIRE, "agent");
            asm volatile("s_waitcnt vmcnt(0)" ::: "memory");
        } else {
            XB_SPIN(xb_ld(&bar[XB_XGEN(b.x)]) == gen, bar);
            __builtin_amdgcn_fence(__ATOMIC_ACQUIRE, "agent");
            asm volatile("s_waitcnt vmcnt(0)" ::: "memory");
        }
    }
    __syncthreads();
}

namespace pg8 {
constexpr int BM = 256, BK = 64, HALF = 128, HTB = HALF * BK * 2, NXCD = 8, WGM = 8;
__host__ __device__ __forceinline__ int lds_byte(int r, int c) { const int st = (r >> 4) * 2 + (c >> 5), rr = r & 15, cc = c & 31, ob = rr * 64 + cc * 2; return st * 1024 + (ob ^ (((ob >> 9) & 1) << 5)); }
__host__ __device__ __forceinline__ void stage_rc(int b, int& R, int& C) { const int st = b / 1024, sb = b % 1024, swz = sb ^ (((sb >> 9) & 1) << 5); R = (st >> 1) * 16 + swz / 64; C = (st & 1) * 32 + (swz % 64) / 2; }
__host__ __device__ __forceinline__ int perm32(int rho) { const int n = rho >> 4, i = rho & 15; return 8 * (i >> 2) + 4 * n + (i & 3); }

struct Unit { int pm, pn, e, cnt; };

struct Dense {
    static constexpr bool GATHER = false;
    const bf16* A; const bf16* Bt; int K; int nM, nN, nwg, G, c;
    __device__ __forceinline__ void init(const bf16* A_, const bf16* Bt_, int M, int N, int K_, int G_, int c_) { A = A_; Bt = Bt_; K = K_; nM = M / BM; nN = N / BM; nwg = nM * nN; G = G_; c = c_; }
    __device__ __forceinline__ bool next(int i, Unit& u) const {
        const long L = (long)i * G + c; if (L >= nwg) return false;
        int wgid = (int)L; { const int q = nwg / NXCD, r = nwg % NXCD, xcd = wgid % NXCD, off = wgid / NXCD; wgid = (xcd < r ? xcd * (q + 1) : r * (q + 1) + (xcd - r) * q) + off; }
        const int nig = WGM * nN, gid = wgid / nig, fm = gid * WGM, gsz = (nM - fm) < WGM ? (nM - fm) : WGM;
        u.pm = fm + ((wgid % nig) % gsz); u.pn = (wgid % nig) / gsz; u.e = 0; u.cnt = 256; return true;
    }
    __device__ __forceinline__ const char* a_base(const Unit& u) const { return (const char*)A + (size_t)u.pm * BM * K * 2; }
    __device__ __forceinline__ const char* b_base(const Unit& u) const { return (const char*)Bt + (size_t)u.pn * BM * K * 2; }
    __device__ __forceinline__ void a_off(const Unit&, const int (&R)[2], const int (&C)[2], unsigned (&vo)[2][2]) const {
#pragma unroll
        for (int h = 0; h < 2; ++h)
#pragma unroll
            for (int i = 0; i < 2; ++i) vo[h][i] = (unsigned)((R[i] + HALF * h) * K + C[i]) * 2u;
    }
};

template <bool GATHER_> struct Moe {
    static constexpr bool GATHER = GATHER_;
    const bf16* A; const bf16* Bt; int K, nN, G, vcu; const int* ltok; const volatile LAS int* tb; const volatile LAS int* cnt;
    __device__ __forceinline__ bool next(int i, Unit& u) const {
        const int L = i * G + vcu; const int TT = __builtin_amdgcn_readfirstlane(tb[NE]); if (L >= TT * nN) return false;
        const int mt = L / nN; u.pn = L - mt * nN;
        const int e = __builtin_amdgcn_readfirstlane(tb[512 + mt]);
        u.e = e; u.pm = mt; const int rem = __builtin_amdgcn_readfirstlane(cnt[e]) - (mt - __builtin_amdgcn_readfirstlane(tb[e])) * BM; u.cnt = rem < BM ? rem : BM; return true;
    }
    __device__ __forceinline__ const char* a_base(const Unit& u) const { return GATHER ? (const char*)A : (const char*)A + (size_t)u.pm * BM * K * 2; }
    __device__ __forceinline__ const char* b_base(const Unit& u) const { return (const char*)Bt + ((size_t)u.e * nN + u.pn) * BM * K * 2; }
    __device__ __forceinline__ const int* idx_src(const Unit& u) const { return ltok + (size_t)u.e * ECAP + (u.pm - __builtin_amdgcn_readfirstlane(tb[u.e])) * BM; }
    __device__ __forceinline__ void a_idx(const Unit& u, const int (&R)[2], int (&tk)[2][2]) const {
        const int slot0 = (u.pm - __builtin_amdgcn_readfirstlane(tb[u.e])) * BM; const int* lt = ltok + (size_t)u.e * ECAP + slot0;
        const unsigned o0 = (unsigned)R[0] * 4u, o1 = (unsigned)R[1] * 4u;
        asm volatile("global_load_dword %0, %4, %6\n\tglobal_load_dword %1, %5, %6\n\tglobal_load_dword %2, %4, %6 offset:512\n\tglobal_load_dword %3, %5, %6 offset:512"
                     : "=&v"(tk[0][0]), "=&v"(tk[0][1]), "=&v"(tk[1][0]), "=&v"(tk[1][1]) : "v"(o0), "v"(o1), "s"(lt) : "memory");
    }
    __device__ __forceinline__ void a_fin(const Unit& u, const int (&R)[2], const int (&C)[2], int (&tk)[2][2], unsigned (&vo)[2][2]) const {
        asm volatile("" : "+v"(tk[0][0]), "+v"(tk[0][1]), "+v"(tk[1][0]), "+v"(tk[1][1]));
#pragma unroll
        for (int h = 0; h < 2; ++h)
#pragma unroll
            for (int i = 0; i < 2; ++i) { const int r = R[i] + HALF * h; const int tok = (r < u.cnt) ? tk[h][i] : 0; vo[h][i] = (unsigned)(tok * K + C[i]) * 2u; }
    }
    __device__ __forceinline__ void a_off(const Unit& u, const int (&R)[2], const int (&C)[2], unsigned (&vo)[2][2]) const {
        if constexpr (GATHER) {
            const int slot0 = (u.pm - __builtin_amdgcn_readfirstlane(tb[u.e])) * BM; const int* lt = ltok + (size_t)u.e * ECAP + slot0; int tk[2][2];
#pragma unroll
            for (int h = 0; h < 2; ++h)
#pragma unroll
                for (int i = 0; i < 2; ++i) tk[h][i] = lt[R[i] + HALF * h];
            asm volatile("" : "+v"(tk[0][0]), "+v"(tk[0][1]), "+v"(tk[1][0]), "+v"(tk[1][1]));
#pragma unroll
            for (int h = 0; h < 2; ++h)
#pragma unroll
                for (int i = 0; i < 2; ++i) { const int r = R[i] + HALF * h; const int tok = (r < u.cnt) ? tk[h][i] : 0; vo[h][i] = (unsigned)(tok * K + C[i]) * 2u; }
        } else {
#pragma unroll
            for (int h = 0; h < 2; ++h)
#pragma unroll
                for (int i = 0; i < 2; ++i) vo[h][i] = (unsigned)((R[i] + HALF * h) * K + C[i]) * 2u;
        }
    }
};

template <class Prob, class Epi, bool FP8 = false, bool ADJ = false>
__device__ __forceinline__ void gemm_phase(LAS unsigned char* lds, const Prob& P, const Epi& E) {
    const int tid = threadIdx.x, wid = __builtin_amdgcn_readfirstlane(tid >> 6), lane = tid & 63, wr = wid >> 2, wc = wid & 3, fr = lane & 15, fq = lane >> 4;
    const int K = P.K, nt = K / BK;
    constexpr bool PRE11 = RELAX_WAITS && !Epi::LDSX;
    int Rr[2], Cc[2]; unsigned voffB[2];
#pragma unroll
    for (int i = 0; i < 2; ++i) { int R, C; stage_rc(tid * 16 + i * 8192, R, C); const int rho = R & 31;
        const int Rb = ADJ ? (64 * (R >> 5) + 16 * ((rho >> 2) & 3) + 4 * (rho >> 4) + (rho & 3)) : ((R & ~31) + perm32(rho)); Rr[i] = R; Cc[i] = C; voffB[i] = (unsigned)(Rb * K + C) * 2u; }
    const size_t kstep = (size_t)(BK * 2);
    const size_t hstep = (size_t)(ADJ ? 8 : HALF) * K * 2;
    const unsigned ldsw = (unsigned)wid * 1024u;
    const int aoff = lds_byte(wr * 64 + fr, fq * 8), boff = lds_byte(wc * 32 + fr, fq * 8);
#define PG8_SA(b, h) (((b) * 2 + (h)) * HTB)
#define PG8_SB(b, h) ((4 + (b) * 2 + (h)) * HTB)
#define PG8_STAGE(bufoff, gbase, voff) do { const char* _g = (const char*)(gbase); asm volatile("" : "+s"(_g));     \
        _Pragma("unroll") for (int _i = 0; _i < 2; ++_i) \
        __builtin_amdgcn_global_load_lds((const unsigned*)(_g + (voff)[_i]), (LAS unsigned*)(lds + (bufoff) + ldsw + _i * 8192), 16, 0, 0); } while (0)
#define PG8_LD8(addr) __builtin_shufflevector(*(const LAS i32x4*)(addr), *(const LAS i32x4*)((addr) + 1024), 0, 1, 2, 3, 4, 5, 6, 7)
#define PG8_LDA(dst, b, h) do { _Pragma("unroll") for (int m = 0; m < 4; ++m) dst[m] = PG8_LD8(lds + PG8_SA(b, h) + aoff + m * 2048); } while (0)
#define PG8_LDB(dst, b, h) do { _Pragma("unroll") for (int n = 0; n < 2; ++n) dst[n] = PG8_LD8(lds + PG8_SB(b, h) + boff + n * 2048); } while (0)
#define PG8_LO(x) __builtin_bit_cast(bf16x8, __builtin_shufflevector(x, x, 0, 1, 2, 3))
#define PG8_HI(x) __builtin_bit_cast(bf16x8, __builtin_shufflevector(x, x, 4, 5, 6, 7))
#define PG8_MMA(ai, bj, At, Bt) do { __builtin_amdgcn_s_setprio(1); _Pragma("unroll") for (int m = 0; m < 4; ++m) _Pragma("unroll") for (int n = 0; n < 2; ++n) { \
        if constexpr (FP8) asm volatile("v_mfma_scale_f32_16x16x128_f8f6f4 %0, %1, %2, %0, %3, %3 op_sel_hi:[0,0,0]" : "+v"(acc[ai][bj][m][n]) : "v"(Bt[n]), "v"(At[m]), "v"(one_scale)); \
        else { acc[ai][bj][m][n] = __builtin_amdgcn_mfma_f32_16x16x32_bf16(PG8_LO(Bt[n]), PG8_LO(At[m]), acc[ai][bj][m][n], 0, 0, 0); \
               acc[ai][bj][m][n] = __builtin_amdgcn_mfma_f32_16x16x32_bf16(PG8_HI(Bt[n]), PG8_HI(At[m]), acc[ai][bj][m][n], 0, 0, 0); } } \
        __builtin_amdgcn_s_setprio(0); } while (0)
#define PG8_MMA_Z(ai, bj, At, Bt) do { __builtin_amdgcn_s_setprio(1); _Pragma("unroll") for (int m = 0; m < 4; ++m) _Pragma("unroll") for (int n = 0; n < 2; ++n) \
        asm volatile("v_mfma_scale_f32_16x16x128_f8f6f4 %0, %1, %2, 0, %3, %3 op_sel_hi:[0,0,0]" : "=&v"(acc[ai][bj][m][n]) : "v"(Bt[n]), "v"(At[m]), "v"(one_scale)); \
        __builtin_amdgcn_s_setprio(0); } while (0)
#define PG8_MMA2(ai, At, B0, B1) do { if constexpr (FP8) { if (zfirst) { PG8_MMA_Z(ai, 0, At, B0); PG8_MMA_Z(ai, 1, At, B1); } else { PG8_MMA(ai, 0, At, B0); PG8_MMA(ai, 1, At, B1); } } else { PG8_MMA(ai, 0, At, B0); PG8_MMA(ai, 1, At, B1); } } while (0)
#define PG8_WAIT_V(n) asm volatile("s_waitcnt vmcnt(" #n ")" ::: "memory")
#define PG8_WAIT_L(n) asm volatile("s_waitcnt lgkmcnt(" #n ")" ::: "memory")
#define PG8_BAR __builtin_amdgcn_s_barrier()
#define PG8_SCHED __builtin_amdgcn_sched_barrier(0)
    Unit cur, nxt; int ui = 0;
    if (!P.next(0, cur)) return;
    f32x4 acc[2][2][4][2];
    if constexpr (!FP8) {
#pragma unroll
    for (int a = 0; a < 2; ++a)
#pragma unroll
        for (int b = 0; b < 2; ++b)
#pragma unroll
            for (int m = 0; m < 4; ++m)
#pragma unroll
                for (int n = 0; n < 2; ++n) acc[a][b][m][n] = (f32x4){0.f, 0.f, 0.f, 0.f}; }
    int one_scale = 0x7f7f7f7f; asm volatile("" : "+v"(one_scale));
    i32x8 At[4], B0[2], B1[2];
    unsigned vc[2][2], vn[2][2];
    P.a_off(cur, Rr, Cc, vc);
    const char* cA = P.a_base(cur); const char* cB = P.b_base(cur);
    PG8_STAGE(PG8_SB(0, 0), cB, voffB); PG8_STAGE(PG8_SB(0, 1), cB + hstep, voffB); PG8_STAGE(PG8_SA(0, 0), cA, vc[0]); PG8_STAGE(PG8_SA(0, 1), cA, vc[1]);
    if (wr == 1) PG8_BAR;
    PG8_WAIT_V(2); PG8_BAR;
    PG8_STAGE(PG8_SB(1, 0), cB + kstep, voffB); PG8_STAGE(PG8_SA(1, 0), cA + kstep, vc[0]); PG8_STAGE(PG8_SB(1, 1), cB + hstep + kstep, voffB);
    PG8_WAIT_V(6); PG8_BAR;
    for (;;) {
        const bool has_next = P.next(ui + 1, nxt);
        const char* nA = has_next ? P.a_base(nxt) : cA; const char* nB = has_next ? P.b_base(nxt) : cB;
        int tkr[2][2] = {{0, 0}, {0, 0}};
        if constexpr (Prob::GATHER) { if (has_next) P.a_idx(nxt, Rr, tkr); }
#pragma unroll
        for (int h = 0; h < 2; ++h)
#pragma unroll
            for (int i = 0; i < 2; ++i) vn[h][i] = vc[h][i];
        if constexpr (Prob::GATHER) { if (nt < 6 && has_next) { PG8_WAIT_V(0); P.a_fin(nxt, Rr, Cc, tkr, vn); } }
        const bool post = ui > 0;
#if PROBE_KLOOP2
        const int ntt = ((PROBE_KLOOP2 == 1 && FP8) || (PROBE_KLOOP2 == 2 && !FP8 && nt == 16)) ? 2 * nt : nt;
#else
        const int ntt = nt;
#endif
        for (int t = 0; t < ntt; t += 2) {
#if PROBE_KLOOP2
            if (t == nt) {
#pragma unroll
                for (int a = 0; a < 2; ++a)
#pragma unroll
                    for (int b = 0; b < 2; ++b)
#pragma unroll
                        for (int m = 0; m < 4; ++m)
#pragma unroll
                            for (int n = 0; n < 2; ++n) acc[a][b][m][n] = (f32x4){0.f, 0.f, 0.f, 0.f};
            }
            const int tq = t >= nt ? t - nt : t;
#else
            const int tq = t;
#endif
            if constexpr (Epi::MID) { if (tq == nt / 2) { int l2 = 0; asm volatile("" : "+v"(l2)); l2 = (int)__builtin_amdgcn_mbcnt_hi(~0u, __builtin_amdgcn_mbcnt_lo(~0u, (unsigned)l2)); E.mid(acc, cur, wr, wc, l2 & 15, l2 >> 4); } }
            const bool last = (t == ntt - 2);
            const int tq2 = (tq + 2 == nt) ? 0 : tq + 2;
            const char* a1 = cA + (size_t)(tq + 1) * kstep;
            const char* a2 = last ? nA : cA + (size_t)tq2 * kstep; const char* b2 = last ? nB : cB + (size_t)tq2 * kstep;
            const char* a3 = a2 + kstep; const char* b3 = b2 + kstep;
            unsigned w0[2], w1[2];
            if constexpr (Prob::GATHER) { w0[0] = last ? vn[0][0] : vc[0][0]; w0[1] = last ? vn[0][1] : vc[0][1]; w1[0] = last ? vn[1][0] : vc[1][0]; w1[1] = last ? vn[1][1] : vc[1][1]; }
            else { w0[0] = vc[0][0]; w0[1] = vc[0][1]; w1[0] = vc[1][0]; w1[1] = vc[1][1]; }
            int tz = t; asm volatile("" : "+s"(tz));
            const bool relax = PRE11 && post && tz == 0;
            int tzq = tq; asm volatile("" : "+s"(tzq)); const bool zfirst = (tzq == 0);
            PG8_LDB(B0, 0, 0); PG8_LDB(B1, 0, 1); PG8_SCHED; PG8_LDA(At, 0, 0); if (!relax) PG8_STAGE(PG8_SA(1, 1), a1, vc[1]);
            if (!relax) PG8_WAIT_V(8); PG8_WAIT_L(0); PG8_BAR; PG8_MMA2(0, At, B0, B1); PG8_BAR; PG8_SCHED;
            PG8_LDA(At, 0, 1); PG8_STAGE(PG8_SB(0, 0), b2, voffB); PG8_STAGE(PG8_SB(0, 1), b2 + hstep, voffB); PG8_STAGE(PG8_SA(0, 0), a2, w0);
            if (!relax) PG8_WAIT_V(8); PG8_WAIT_L(0); PG8_BAR; PG8_MMA2(1, At, B0, B1); PG8_BAR; PG8_SCHED;
            PG8_LDB(B0, 1, 0); PG8_LDB(B1, 1, 1); PG8_SCHED; PG8_LDA(At, 1, 0); PG8_STAGE(PG8_SA(0, 1), a2, w1);
            if (!relax) PG8_WAIT_V(8); PG8_WAIT_L(0); PG8_BAR; PG8_MMA(0, 0, At, B0); PG8_MMA(0, 1, At, B1); PG8_BAR; PG8_SCHED;
            PG8_LDA(At, 1, 1); PG8_STAGE(PG8_SB(1, 0), b3, voffB); PG8_STAGE(PG8_SB(1, 1), b3 + hstep, voffB); PG8_STAGE(PG8_SA(1, 0), a3, w0);
            PG8_WAIT_V(8); PG8_WAIT_L(0); PG8_BAR; PG8_MMA(1, 0, At, B0); PG8_MMA(1, 1, At, B1); PG8_BAR; PG8_SCHED;
            if constexpr (Prob::GATHER) { if (nt >= 6 && t + 4 == ntt && has_next) P.a_fin(nxt, Rr, Cc, tkr, vn); }
        }
        if (wr == 0) PG8_BAR;
        if constexpr (PRE11) PG8_STAGE(PG8_SA(1, 1), nA + kstep, vn[1]);
        if constexpr (FP8) asm volatile("s_nop 15\n\ts_nop 3" ::: "memory");
        { int l2 = 0; asm volatile("" : "+v"(l2)); l2 = (int)__builtin_amdgcn_mbcnt_hi(~0u, __builtin_amdgcn_mbcnt_lo(~0u, (unsigned)l2));
          E(acc, cur, wr, wc, l2 & 15, l2 >> 4);
#if PROBE_EPI2
          if ((PROBE_EPI2 == 1 && FP8) || (PROBE_EPI2 == 2 && !FP8 && P.nN == 14)) { int l3 = threadIdx.x & 63; asm volatile("" : "+v"(l3)); E(acc, cur, wr, wc, l3 & 15, l3 >> 4); }
#endif
        }
        if (!has_next) break;
        if constexpr (!FP8) {
#pragma unroll
        for (int a = 0; a < 2; ++a)
#pragma unroll
            for (int b = 0; b < 2; ++b)
#pragma unroll
                for (int m = 0; m < 4; ++m)
#pragma unroll
                    for (int n = 0; n < 2; ++n) acc[a][b][m][n] = (f32x4){0.f, 0.f, 0.f, 0.f}; }
        cur = nxt; cA = nA; cB = nB; ++ui;
#pragma unroll
        for (int h = 0; h < 2; ++h)
#pragma unroll
            for (int i = 0; i < 2; ++i) vc[h][i] = vn[h][i];
        if (wr == 1) PG8_BAR;
    }
    PG8_WAIT_V(0);
    PG8_BAR;
#undef PG8_SA
#undef PG8_SB
#undef PG8_STAGE
#undef PG8_LDA
#undef PG8_LDB
#undef PG8_MMA
#undef PG8_MMA_Z
#undef PG8_MMA2
#undef PG8_LO
#undef PG8_HI
#undef PG8_LD8
#undef PG8_WAIT_V
#undef PG8_WAIT_L
#undef PG8_BAR
#undef PG8_SCHED
}
}

using pg8::Unit;
__device__ __forceinline__ u32x4 pack8(const f32x4& a, const f32x4& b) { u32x4 w; w.x = pk2(a[0], a[1]); w.y = pk2(a[2], a[3]); w.z = pk2(b[0], b[1]); w.w = pk2(b[2], b[3]); return w; }
#define EPI_LOOP_AI_M _Pragma("unroll") for (int ai = 0; ai < 2; ++ai) _Pragma("unroll") for (int m = 0; m < 4; ++m)
#define EPI_LOADS_DONE() asm volatile("s_waitcnt vmcnt(0)" ::: "memory")

struct EpiInProj {
    static constexpr bool MID = false, LDSX = false;
    bf16* HG; bf16* QLAT; bf16* KVLAT; bf16* G; bf16* GR; const float* gate_b; float* KPESS; const float* RSX; float* SSQ; float* SSC;
    __device__ __forceinline__ void operator()(const f32x4 (&acc)[2][2][4][2], const Unit& u, int wr, int wc, int fr, int fq) const {
        const int rowu = u.pm * 256 + wr * 64, cwu = wc * 32, cw = cwu + 8 * fq;
        float rx[2][4];
        { const float* rxp = RSX + rowu; EPI_LOOP_AI_M rx[ai][m] = rxp[fr + 128 * ai + 16 * m]; }
        f32x4 bv[2][2];
        { const int cbg = 128 * (u.pn < 6 ? 0 : u.pn - 6) + cw;
#pragma unroll
          for (int bj = 0; bj < 2; ++bj)
#pragma unroll
              for (int n = 0; n < 2; ++n) bv[bj][n] = *(const f32x4*)(gate_b + 1024 * bj + cbg + 4 * n); }
        __builtin_amdgcn_sched_barrier(0);
        EPI_LOADS_DONE();
        asm volatile("" : "+v"(bv[0][0]), "+v"(bv[0][1]), "+v"(bv[1][0]), "+v"(bv[1][1]));
        if (u.pn < 4) {
            const int bb = rowu >> 12, tu = rowu & 4095;
            char* hb = (char*)HG + (((size_t)bb * LPC + HGOFF + tu) * CDIM + 128 * u.pn + cwu) * 2; const unsigned lo = (unsigned)(fr * CDIM + 8 * fq) * 2u;
            EPI_LOOP_AI_M {
                const f32x2 r2 = {rx[ai][m], rx[ai][m]}, nr2 = r2 * -1.4426950408889634f; f32x4 v[2];
#pragma unroll
                for (int n = 0; n < 2; ++n)
#pragma unroll
                    for (int h = 0; h < 2; ++h) { const f32x2 a2 = {acc[ai][0][m][n][2 * h], acc[ai][0][m][n][2 * h + 1]}, g2 = {acc[ai][1][m][n][2 * h], acc[ai][1][m][n][2 * h + 1]};
                        const f32x2 t = g2 * nr2; f32x2 d = {__builtin_amdgcn_exp2f(t[0]), __builtin_amdgcn_exp2f(t[1])}; d = d + 1.f;
                        const f32x2 rc = {__builtin_amdgcn_rcpf(d[0]), __builtin_amdgcn_rcpf(d[1])}, o = (a2 * r2) * rc; v[n][2 * h] = o[0]; v[n][2 * h + 1] = o[1]; }
                *(u32x4*)(hb + (size_t)(128 * ai + 16 * m) * (CDIM * 2) + lo) = pack8(v[0], v[1]); }
        } else if (u.pn < 6) {
            char* db = (char*)((u.pn == 4) ? QLAT : KVLAT) + ((size_t)rowu * 256 + cwu) * 2; const unsigned lo = (unsigned)(fr * 256 + 8 * fq) * 2u;
            EPI_LOOP_AI_M {
#pragma unroll
                for (int bj = 0; bj < 2; ++bj) *(u32x4*)(db + (size_t)(128 * ai + 16 * m) * 512 + 256 * bj + lo) = pack8(acc[ai][bj][m][0] * rx[ai][m], acc[ai][bj][m][1] * rx[ai][m]); }
            { float* ssd = ((u.pn == 4) ? SSQ : SSC) + (size_t)rowu * 4 + wc; const int nbj = (u.pn == 4) ? 2 : 1;
                EPI_LOOP_AI_M { float ss = 0.f;
#pragma unroll
                    for (int bj = 0; bj < 2; ++bj) if (bj < nbj) { const f32x4 a = acc[ai][bj][m][0], b = acc[ai][bj][m][1]; ss += ((a[0] * a[0] + a[1] * a[1]) + (a[2] * a[2] + a[3] * a[3])) + ((b[0] * b[0] + b[1] * b[1]) + (b[2] * b[2] + b[3] * b[3])); }
                    ss += __shfl_xor(ss, 16); ss += __shfl_xor(ss, 32);
                    if (fq == 0) ssd[(fr + 128 * ai + 16 * m) * 4] = ss * rx[ai][m] * rx[ai][m]; } }
            if (u.pn == 5 && wc == 0) {
                float* kp = KPESS + rowu;
                EPI_LOOP_AI_M { const f32x4 a = acc[ai][1][m][0], b = acc[ai][1][m][1];
                    float ss = ((a[0] * a[0] + a[1] * a[1]) + (a[2] * a[2] + a[3] * a[3])) + ((b[0] * b[0] + b[1] * b[1]) + (b[2] * b[2] + b[3] * b[3]));
                    ss += __shfl_xor(ss, 16); ss += __shfl_xor(ss, 32);
                    if (fq == 0) kp[fr + 128 * ai + 16 * m] = ss * rx[ai][m] * rx[ai][m]; } }
        } else {
            const size_t ub = ((size_t)rowu * 1024 + 128 * (u.pn - 6) + cwu) * 2; char* rb = (char*)GR + ub; char* gb = (char*)G + ub; const unsigned lo = (unsigned)(fr * 1024 + 8 * fq) * 2u;
#pragma unroll
            for (int bj = 0; bj < 2; ++bj)
#pragma unroll
                for (int n = 0; n < 2; ++n) bv[bj][n] = bv[bj][n] * -1.4426950408889634f;
            EPI_LOOP_AI_M { f32x4 rr[2], gg[2]; const float nr = rx[ai][m] * -1.4426950408889634f; const f32x2 nr2 = {nr, nr};
#pragma unroll
                for (int n = 0; n < 2; ++n)
#pragma unroll
                    for (int h = 0; h < 2; ++h) { const f32x2 z0 = {acc[ai][0][m][n][2 * h], acc[ai][0][m][n][2 * h + 1]}, z1 = {acc[ai][1][m][n][2 * h], acc[ai][1][m][n][2 * h + 1]};
                        const f32x2 b0 = {bv[0][n][2 * h], bv[0][n][2 * h + 1]}, b1 = {bv[1][n][2 * h], bv[1][n][2 * h + 1]};
                        const f32x2 t0 = z0 * nr2 + b0, t1 = z1 * nr2 + b1;
                        f32x2 d0 = {__builtin_amdgcn_exp2f(t0[0]), __builtin_amdgcn_exp2f(t0[1])}, d1 = {__builtin_amdgcn_exp2f(t1[0]), __builtin_amdgcn_exp2f(t1[1])}; d0 = d0 + 1.f; d1 = d1 + 1.f;
                        const f32x2 q0 = {__builtin_amdgcn_rcpf(d0[0]), __builtin_amdgcn_rcpf(d0[1])}, g1 = {__builtin_amdgcn_rcpf(d1[0]), __builtin_amdgcn_rcpf(d1[1])}, r = d1 * q0;
                        gg[n][2 * h] = g1[0]; gg[n][2 * h + 1] = g1[1]; rr[n][2 * h] = r[0]; rr[n][2 * h + 1] = r[1]; }
                *(u32x4*)(rb + (size_t)(128 * ai + 16 * m) * 2048 + lo) = pack8(rr[0], rr[1]); *(u32x4*)(gb + (size_t)(128 * ai + 16 * m) * 2048 + lo) = pack8(gg[0], gg[1]); }
        }
    }
};
template <bool REMAP> struct EpiRowScale {
    static constexpr bool MID = false, LDSX = false;
    bf16* O; const float* rs;
    __device__ __forceinline__ void operator()(const f32x4 (&acc)[2][2][4][2], const Unit& u, int wr, int wc, int fr, int fq) const {
        const int rowt = u.pm * 256 + wr * 64 + fr, cb = 256 * u.pn + 64 * wc + 16 * fq;
        float sv[2][4];
        EPI_LOOP_AI_M sv[ai][m] = rs[rowt + 128 * ai + 16 * m];
        __builtin_amdgcn_sched_barrier(0);
        EPI_LOADS_DONE();
        EPI_LOOP_AI_M { const int row = rowt + 128 * ai + 16 * m; const float s = sv[ai][m];
            const size_t orow = REMAP ? ((size_t)(row >> 12) * LPK + KOFF + (row & 4095)) : (size_t)row;
#pragma unroll
            for (int bj = 0; bj < 2; ++bj) *(u32x4*)(O + orow * 1024 + cb + 8 * bj) = pack8(acc[ai][bj][m][0] * s, acc[ai][bj][m][1] * s); }
    }
};
__device__ __forceinline__ void unpack8(const u32x4& w, f32x4& a, f32x4& b) { a[0] = bflo(w.x); a[1] = bfhi(w.x); a[2] = bflo(w.y); a[3] = bfhi(w.y); b[0] = bflo(w.z); b[1] = bfhi(w.z); b[2] = bflo(w.w); b[3] = bfhi(w.w); }
struct EpiQHead {
    static constexpr bool MID = false, LDSX = true;
    bf16* QF; const float* rs; const float* q_nw; const float* ROPE; LAS unsigned char* lds;
    __device__ __forceinline__ void operator()(const f32x4 (&acc)[2][2][4][2], const Unit& u, int wr, int wc, int fr, int fq) const {
        LAS float* S = (LAS float*)(lds + 3 * 16384);
        const int rl0 = wr * 64 + fr, rowt = u.pm * 256 + rl0;
        float sv[2][4];
        { f32x4 pp[2][4];
          EPI_LOOP_AI_M pp[ai][m] = *(const f32x4*)(rs + (size_t)(rowt + 128 * ai + 16 * m) * 4);
          __builtin_amdgcn_sched_barrier(0);
          EPI_LOADS_DONE();
          EPI_LOOP_AI_M sv[ai][m] = 1.f / sqrtf(((pp[ai][m][0] + pp[ai][m][1]) + (pp[ai][m][2] + pp[ai][m][3])) * (1.f / QLR) + NORM_EPS); }
        EPI_LOOP_AI_M {
#pragma unroll
            for (int bj = 0; bj < 2; ++bj) { const f32x4 a = acc[ai][bj][m][0], b = acc[ai][bj][m][1];
                float ss = ((a[0] * a[0] + a[1] * a[1]) + (a[2] * a[2] + a[3] * a[3])) + ((b[0] * b[0] + b[1] * b[1]) + (b[2] * b[2] + b[3] * b[3]));
                ss += __shfl_xor(ss, 16); ss += __shfl_xor(ss, 32);
                if (fq == 0) S[((rl0 + 128 * ai + 16 * m) * 2 + bj) * 4 + wc] = ss; } }
        asm volatile("s_waitcnt lgkmcnt(0)\n\ts_barrier" ::: "memory");
        if (wc < 3) {
            const int d0 = 32 * wc + 8 * fq; const f32x4 w0 = *(const f32x4*)(q_nw + d0), w1 = *(const f32x4*)(q_nw + d0 + 4);
            EPI_LOOP_AI_M { const int rl = rl0 + 128 * ai + 16 * m, row = rowt + 128 * ai + 16 * m; const float rsq = sv[ai][m];
#pragma unroll
                for (int bj = 0; bj < 2; ++bj) { const f32x4 pt = *(const LAS f32x4*)(S + (rl * 2 + bj) * 4);
                    const float tot = ((pt[0] + pt[1]) + (pt[2] + pt[3])) * rsq * rsq, sc = rsq * QSCALE / sqrtf(tot * (1.f / DQK) + NORM_EPS);
                    f32x4 o0 = acc[ai][bj][m][0] * sc * w0, o1 = acc[ai][bj][m][1] * sc * w1;
                    if (wc == 2) {
                        const float* rp = ROPE + (size_t)(NMETA + (row & 4095)) * 32 + 16 * (fq & 1);
                        const f32x4 c0 = *(const f32x4*)rp, c1 = *(const f32x4*)(rp + 4), c2 = *(const f32x4*)(rp + 8), c3 = *(const f32x4*)(rp + 12);
                        const float sg = (fq < 2) ? -1.f : 1.f; f32x4 p0, p1;
#pragma unroll
                        for (int e = 0; e < 4; ++e) { p0[e] = __shfl_xor(o0[e], 32); p1[e] = __shfl_xor(o1[e], 32); }
                        o0 = (f32x4){o0[0] * c0[0] + sg * p0[0] * c0[1], o0[1] * c0[2] + sg * p0[1] * c0[3], o0[2] * c1[0] + sg * p0[2] * c1[1], o0[3] * c1[2] + sg * p0[3] * c1[3]};
                        o1 = (f32x4){o1[0] * c2[0] + sg * p1[0] * c2[1], o1[1] * c2[2] + sg * p1[1] * c2[3], o1[2] * c3[0] + sg * p1[2] * c3[1], o1[3] * c3[2] + sg * p1[3] * c3[3]}; }
                    *(u32x4*)(QF + (size_t)row * 768 + (2 * u.pn + bj) * DQK + d0) = pack8(o0, o1); } }
        }
        asm volatile("s_waitcnt lgkmcnt(0)\n\ts_barrier" ::: "memory");
    }
};
struct EpiKVHead {
    static constexpr bool MID = false, LDSX = true;
    bf16* KF; bf16* VO; const bf16* KVLAT; const float* rs; const float* kpess; const float* k_nw; const float* ROPE; LAS unsigned char* lds;
    __device__ __forceinline__ void operator()(const f32x4 (&acc)[2][2][4][2], const Unit& u, int wr, int wc, int fr, int fq) const {
        LAS float* S = (LAS float*)(lds + 3 * 16384);
        const int rl0 = wr * 64 + fr, rowt = u.pm * 256 + rl0;
        float sv[2][4];
        { f32x4 pp[2][4];
          EPI_LOOP_AI_M pp[ai][m] = *(const f32x4*)(rs + (size_t)(rowt + 128 * ai + 16 * m) * 4);
          __builtin_amdgcn_sched_barrier(0);
          EPI_LOADS_DONE();
          EPI_LOOP_AI_M sv[ai][m] = 1.f / sqrtf(((pp[ai][m][0] + pp[ai][m][1]) + (pp[ai][m][2] + pp[ai][m][3])) * (1.f / KVLR) + NORM_EPS); }
        if (wc < 2) {
            EPI_LOOP_AI_M {
#pragma unroll
                for (int bj = 0; bj < 2; ++bj) { const f32x4 a = acc[ai][bj][m][0], b = acc[ai][bj][m][1];
                    float ss = ((a[0] * a[0] + a[1] * a[1]) + (a[2] * a[2] + a[3] * a[3])) + ((b[0] * b[0] + b[1] * b[1]) + (b[2] * b[2] + b[3] * b[3]));
                    ss += __shfl_xor(ss, 16); ss += __shfl_xor(ss, 32);
                    if (fq == 0) S[((rl0 + 128 * ai + 16 * m) * 2 + bj) * 4 + wc] = ss; } }
        } else if (fq == 0) {
            EPI_LOOP_AI_M { const float val = (wc == 2) ? sv[ai][m] : kpess[rowt + 128 * ai + 16 * m];
                S[((rl0 + 128 * ai + 16 * m) * 2 + 0) * 4 + wc] = val; S[((rl0 + 128 * ai + 16 * m) * 2 + 1) * 4 + wc] = val; }
        }
        asm volatile("s_waitcnt lgkmcnt(0)\n\ts_barrier" ::: "memory");
        if (wc < 2) {
            const int d0 = 32 * wc + 8 * fq; const f32x4 w0 = *(const f32x4*)(k_nw + d0), w1 = *(const f32x4*)(k_nw + d0 + 4);
            EPI_LOOP_AI_M { const int rl = rl0 + 128 * ai + 16 * m, row = rowt + 128 * ai + 16 * m, b = row >> 12, t = row & 4095;
#pragma unroll
                for (int bj = 0; bj < 2; ++bj) { const f32x4 pt = *(const LAS f32x4*)(S + (rl * 2 + bj) * 4);
                    const float tot = (pt[0] + pt[1]) * pt[2] * pt[2] + pt[3], sc = pt[2] / sqrtf(tot * (1.f / DQK) + NORM_EPS);
                    *(u32x4*)(KF + ((size_t)(b * NH + 2 * u.pn + bj) * LPK + KOFF + t) * DQK + d0) = pack8(acc[ai][bj][m][0] * sc * w0, acc[ai][bj][m][1] * sc * w1); } }
        } else {
            const int d0 = 32 * (wc - 2) + 8 * fq;
            EPI_LOOP_AI_M { const int row = rowt + 128 * ai + 16 * m, b = row >> 12, t = row & 4095; const float rsc = sv[ai][m];
#pragma unroll
                for (int bj = 0; bj < 2; ++bj) *(u32x4*)(VO + ((size_t)b * LPK + KOFF + t) * 1024 + (2 * u.pn + bj) * 128 + 64 + d0) = pack8(acc[ai][bj][m][0] * rsc, acc[ai][bj][m][1] * rsc); }
        }
        __builtin_amdgcn_sched_barrier(0);
        if (wc == 2) {
            const f32x4 wo0 = *(const f32x4*)(k_nw + 64 + 8 * fq), wo1 = *(const f32x4*)(k_nw + 68 + 8 * fq), wp0 = *(const f32x4*)(k_nw + 64 + 8 * (fq ^ 2)), wp1 = *(const f32x4*)(k_nw + 68 + 8 * (fq ^ 2));
            const float sg = (fq < 2) ? -1.f : 1.f;
#pragma unroll 2
            for (int q = 0; q < 8; ++q) { const int rl = rl0 + 128 * (q >> 2) + 16 * (q & 3), row = u.pm * 256 + rl, b = row >> 12, t = row & 4095;
                f32x4 xo0, xo1, xp0, xp1; const bf16* pe = KVLAT + (size_t)row * 256 + KVLR; unpack8(*(const u32x4*)(pe + 8 * fq), xo0, xo1); unpack8(*(const u32x4*)(pe + 8 * (fq ^ 2)), xp0, xp1);
                const float* rp = ROPE + (size_t)(NMETA + t) * 32 + 16 * (fq & 1); const f32x4 c0 = *(const f32x4*)rp, c1 = *(const f32x4*)(rp + 4), c2 = *(const f32x4*)(rp + 8), c3 = *(const f32x4*)(rp + 12);
#pragma unroll
                for (int bj = 0; bj < 2; ++bj) { const f32x4 pt = *(const LAS f32x4*)(S + (rl * 2 + bj) * 4);
                    const float tot = (pt[0] + pt[1]) * pt[2] * pt[2] + pt[3], rh = 1.f / sqrtf(tot * (1.f / DQK) + NORM_EPS);
                    const f32x4 a0 = xo0 * rh * wo0, a1 = xo1 * rh * wo1, p0 = xp0 * rh * wp0, p1 = xp1 * rh * wp1;
                    const f32x4 o0 = {a0[0] * c0[0] + sg * p0[0] * c0[1], a0[1] * c0[2] + sg * p0[1] * c0[3], a0[2] * c1[0] + sg * p0[2] * c1[1], a0[3] * c1[2] + sg * p0[3] * c1[3]};
                    const f32x4 o1 = {a1[0] * c2[0] + sg * p1[0] * c2[1], a1[1] * c2[2] + sg * p1[1] * c2[3], a1[2] * c3[0] + sg * p1[2] * c3[1], a1[3] * c3[2] + sg * p1[3] * c3[3]};
                    *(u32x4*)(KF + ((size_t)(b * NH + 2 * u.pn + bj) * LPK + KOFF + t) * DQK + 64 + 8 * fq) = pack8(o0, o1); } }
        }
        asm volatile("s_waitcnt lgkmcnt(0)\n\ts_barrier" ::: "memory");
    }
};
struct EpiMix {
    static constexpr bool MID = true, LDSX = false;
    bf16* O; const bf16* G1; const bf16* GR;
    __device__ __forceinline__ void mid(f32x4 (&acc)[2][2][4][2], const Unit& u, int wr, int wc, int fr, int fq) const {
        const char* gb = (const char*)GR + ((size_t)(u.pm * 256 + wr * 64) * 1024 + 256 * u.pn + 64 * wc) * 2; const unsigned lo = (unsigned)(fr * 1024 + 16 * fq) * 2u;
#pragma unroll
        for (int ai = 0; ai < 2; ++ai) { u32x4 gw[4][2];
#pragma unroll
            for (int m = 0; m < 4; ++m)
#pragma unroll
                for (int bj = 0; bj < 2; ++bj) gw[m][bj] = *(const u32x4*)(gb + (size_t)(128 * ai + 16 * m) * 2048 + lo + 16 * bj);
            __builtin_amdgcn_sched_barrier(0);
#pragma unroll
            for (int m = 0; m < 4; ++m)
#pragma unroll
                for (int bj = 0; bj < 2; ++bj) { f32x4 g0, g1; unpack8(gw[m][bj], g0, g1); acc[ai][bj][m][0] *= g0; acc[ai][bj][m][1] *= g1; }
            __builtin_amdgcn_sched_barrier(0); }
    }
    __device__ __forceinline__ void operator()(const f32x4 (&acc)[2][2][4][2], const Unit& u, int wr, int wc, int fr, int fq) const {
        const size_t ub = ((size_t)(u.pm * 256 + wr * 64) * 1024 + 256 * u.pn + 64 * wc) * 2; const unsigned lo = (unsigned)(fr * 1024 + 16 * fq) * 2u;
        const char* gb = (const char*)G1 + ub; char* ob = (char*)O + ub;
        u32x4 gw[2][4][2];
        EPI_LOOP_AI_M {
#pragma unroll
            for (int bj = 0; bj < 2; ++bj) gw[ai][m][bj] = *(const u32x4*)(gb + (size_t)(128 * ai + 16 * m) * 2048 + lo + 16 * bj); }
        __builtin_amdgcn_sched_barrier(0);
        EPI_LOADS_DONE();
        EPI_LOOP_AI_M {
#pragma unroll
            for (int bj = 0; bj < 2; ++bj) { f32x4 g0, g1; unpack8(gw[ai][m][bj], g0, g1);
                *(u32x4*)(ob + (size_t)(128 * ai + 16 * m) * 2048 + lo + 16 * bj) = pack8(g0 * acc[ai][bj][m][0], g1 * acc[ai][bj][m][1]); } }
    }
};
struct EpiResid {
    static constexpr bool MID = false, LDSX = false;
    const bf16* X; bf16* H1B; unsigned char* H1Q;
    __device__ __forceinline__ void operator()(const f32x4 (&acc)[2][2][4][2], const Unit& u, int wr, int wc, int fr, int fq) const {
        const size_t ue = (size_t)(u.pm * 256 + wr * 64) * 1024 + 256 * u.pn + 64 * wc; const unsigned le = (unsigned)(fr * 1024 + 16 * fq);
        const char* xb = (const char*)X + ue * 2; char* hb = (char*)H1B + ue * 2; unsigned char* qb = H1Q + ue;
        u32x4 xv[2][4][2];
        EPI_LOOP_AI_M {
#pragma unroll
            for (int bj = 0; bj < 2; ++bj) xv[ai][m][bj] = *(const u32x4*)(xb + (size_t)(128 * ai + 16 * m) * 2048 + le * 2u + 16 * bj); }
        __builtin_amdgcn_sched_barrier(0);
        EPI_LOADS_DONE();
        EPI_LOOP_AI_M {
#pragma unroll
            for (int bj = 0; bj < 2; ++bj) {
                f32x4 x0, x1; unpack8(xv[ai][m][bj], x0, x1); const f32x4 v0 = x0 + acc[ai][bj][m][0], v1 = x1 + acc[ai][bj][m][1];
                *(u32x4*)(hb + (size_t)(128 * ai + 16 * m) * 2048 + le * 2u + 16 * bj) = pack8(v0, v1);
                *(u32x2*)(qb + (size_t)(128 * ai + 16 * m) * 1024 + le + 8 * bj) = (u32x2){pk4_fp8(v0[0], v0[1], v0[2], v0[3]), pk4_fp8(v1[0], v1[1], v1[2], v1[3])}; } }
    }
};
struct EpiSwiGLU {
    static constexpr bool MID = false, LDSX = false;
    unsigned char* ACT; const float* bgu; const float* lrs; const volatile LAS int* tb;
    __device__ __forceinline__ void operator()(const f32x4 (&acc)[2][2][4][2], const Unit& u, int wr, int wc, int fr, int fq) const {
        const int r0 = wr * 64 + fr, cw = wc * 32 + 8 * fq, slot0 = (u.pm - __builtin_amdgcn_readfirstlane(tb[u.e])) * 256;
        const float* bg = bgu + (size_t)u.e * 2048 + 128 * u.pn + cw; const float* lr = lrs + (size_t)u.e * ECAP + slot0;
        const f32x4 bg0 = *(const f32x4*)(bg), bg1 = *(const f32x4*)(bg + 4), bu0 = *(const f32x4*)(bg + 1024), bu1 = *(const f32x4*)(bg + 1028);
        float sv[2][4];
        EPI_LOOP_AI_M sv[ai][m] = lr[r0 + 128 * ai + 16 * m];
        asm volatile("" : "+v"(sv[0][0]), "+v"(sv[0][1]), "+v"(sv[0][2]), "+v"(sv[0][3]), "+v"(sv[1][0]), "+v"(sv[1][1]), "+v"(sv[1][2]), "+v"(sv[1][3]));
        EPI_LOADS_DONE();
        constexpr float NC = -SW_ALPHA * 1.4426950408889634f;
        f32x4 bgv[2] = {bg0, bg1}, buv[2] = {bu0 + 1.f, bu1 + 1.f};
        EPI_LOOP_AI_M { const int r = r0 + 128 * ai + 16 * m; const float s = (r < u.cnt) ? sv[ai][m] * W8_INV : 0.f; const f32x2 s2 = {s, s};
            f32x4 v[2];
#pragma unroll
            for (int n = 0; n < 2; ++n)
#pragma unroll
                for (int h = 0; h < 2; ++h) {
                    const f32x2 ag = {acc[ai][0][m][n][2 * h], acc[ai][0][m][n][2 * h + 1]}, au = {acc[ai][1][m][n][2 * h], acc[ai][1][m][n][2 * h + 1]};
                    const f32x2 bg2 = {bgv[n][2 * h], bgv[n][2 * h + 1]}, bu2 = {buv[n][2 * h], buv[n][2 * h + 1]};
                    f32x2 g = ag * s2 + bg2; g[0] = fminf(g[0], SW_LIMIT); g[1] = fminf(g[1], SW_LIMIT);
                    f32x2 uu = au * s2 + bu2; uu[0] = __builtin_amdgcn_fmed3f(uu[0], 1.f - SW_LIMIT, 1.f + SW_LIMIT); uu[1] = __builtin_amdgcn_fmed3f(uu[1], 1.f - SW_LIMIT, 1.f + SW_LIMIT);
                    const f32x2 x = g * NC; f32x2 d = {__builtin_amdgcn_exp2f(x[0]), __builtin_amdgcn_exp2f(x[1])}; d = d + 1.f;
                    const f32x2 rc = {__builtin_amdgcn_rcpf(d[0]), __builtin_amdgcn_rcpf(d[1])};
                    const f32x2 o = (uu * g) * rc; v[n][2 * h] = o[0]; v[n][2 * h + 1] = o[1]; }
            *(u32x2*)(ACT + ((size_t)u.pm * 256 + r) * 1024 + 128 * u.pn + cw) = (u32x2){pk4_fp8(v[0][0], v[0][1], v[0][2], v[0][3]), pk4_fp8(v[1][0], v[1][1], v[1][2], v[1][3])}; }
    }
};
struct EpiDown {
    static constexpr bool MID = false, LDSX = false;
    unsigned char* Y; const float* bd; const float* lw; const volatile LAS int* tb;
    __device__ __forceinline__ void operator()(const f32x4 (&acc)[2][2][4][2], const Unit& u, int wr, int wc, int fr, int fq) const {
        const int r0 = wr * 64 + fr, cb = 256 * u.pn + 64 * wc + 16 * fq, slot0 = (u.pm - __builtin_amdgcn_readfirstlane(tb[u.e])) * 256;
        const float* bp = bd + (size_t)u.e * 1024 + cb; const float* lwp = lw + (size_t)u.e * ECAP + slot0;
        f32x4 bv[2][2];
#pragma unroll
        for (int bj = 0; bj < 2; ++bj)
#pragma unroll
            for (int n = 0; n < 2; ++n) bv[bj][n] = *(const f32x4*)(bp + 8 * bj + 4 * n);
        float wv[2][4];
        EPI_LOOP_AI_M wv[ai][m] = lwp[r0 + 128 * ai + 16 * m];
        asm volatile("" : "+v"(wv[0][0]), "+v"(wv[0][1]), "+v"(wv[0][2]), "+v"(wv[0][3]), "+v"(wv[1][0]), "+v"(wv[1][1]), "+v"(wv[1][2]), "+v"(wv[1][3]));
        EPI_LOADS_DONE();
        EPI_LOOP_AI_M { const int r = r0 + 128 * ai + 16 * m; const float w = (r < u.cnt) ? wv[ai][m] * Y8_SCALE : 0.f; u32x4 o;
            { const f32x4 v0 = (acc[ai][0][m][0] * W8_INV + bv[0][0]) * w, v1 = (acc[ai][0][m][1] * W8_INV + bv[0][1]) * w; o.x = pk4_fp8(v0[0], v0[1], v0[2], v0[3]); o.y = pk4_fp8(v1[0], v1[1], v1[2], v1[3]); }
            { const f32x4 v0 = (acc[ai][1][m][0] * W8_INV + bv[1][0]) * w, v1 = (acc[ai][1][m][1] * W8_INV + bv[1][1]) * w; o.z = pk4_fp8(v0[0], v0[1], v0[2], v0[3]); o.w = pk4_fp8(v1[0], v1[1], v1[2], v1[3]); }
            *(u32x4*)(Y + ((size_t)u.pm * 256 + r) * 1024 + cb) = o; }
    }
};

struct Ctx {
    LAS unsigned char* lds; gu32* ctl; unsigned char* ws;
    int tid, lane, wave, vcu, G;
    const float *x, *meta, *attn_nw, *w_in, *dw_w, *dw_b, *ln_w, *ln_b, *pw2_w, *qa_nw, *w_qb, *kva_nw, *w_kvb, *q_nw, *k_nw, *w_o, *gate_b, *w_out, *ffn_nw, *router_w, *router_b, *w_gu, *b_gu, *w_d, *b_d;
    float* out;
};
#define WSP(T, off) ((T*)(F.ws + (off)))

__device__ __forceinline__ void tr_item(const float* src, int ld_src, int k0, int colA, int colB, const float* ks, bf16* dst, int ld_dst, LAS unsigned* scr, int lane) {
    const int nq = lane & 15, kq = lane >> 4; const int col = (nq >> 3) ? colB : colA; const int c4 = col + 4 * (nq & 7);
#pragma unroll
    for (int i = 0; i < 8; ++i) { const int kp = 4 * i + kq; f32x4 a = {0.f, 0.f, 0.f, 0.f}, b = {0.f, 0.f, 0.f, 0.f};
        if (col >= 0) { a = *(const f32x4*)(src + (size_t)(k0 + 2 * kp) * ld_src + c4); b = *(const f32x4*)(src + (size_t)(k0 + 2 * kp + 1) * ld_src + c4); }
        if (ks) { a *= ks[k0 + 2 * kp]; b *= ks[k0 + 2 * kp + 1]; }
        LAS unsigned* p = scr + kp * 65 + 4 * nq; p[0] = pk2(a[0], b[0]); p[1] = pk2(a[1], b[1]); p[2] = pk2(a[2], b[2]); p[3] = pk2(a[3], b[3]); }
    LDS_WAIT(); asm volatile("" ::: "memory");
    const int c = lane & 7;
#pragma unroll
    for (int j = 0; j < 8; ++j) { const int n = (lane >> 3) + 8 * j; const LAS unsigned* s = scr + (4 * c) * 65 + n;
        u32x4 o; o.x = s[0]; o.y = s[65]; o.z = s[130]; o.w = s[195];
        *(u32x4*)(dst + (size_t)n * ld_dst + 8 * c) = o; }
    LDS_WAIT(); asm volatile("" ::: "memory");
}
__device__ __forceinline__ void tr_item8(const float* src, int ld_src, int k0, int colA, int colB, const float* ks, unsigned char* dst, int ld_dst, LAS unsigned* scr, int lane) {
    const int nq = lane & 15, kq = lane >> 4; const int col = (nq >> 3) ? colB : colA; const int c4 = col + 4 * (nq & 7);
#pragma unroll
    for (int i = 0; i < 8; ++i) { const int kg = 4 * i + kq; const float* sp = src + (size_t)(k0 + 4 * kg) * ld_src + c4;
        f32x4 a = {0.f, 0.f, 0.f, 0.f}, b = a, c = a, d = a;
        if (col >= 0) { a = __builtin_nontemporal_load((const f32x4*)sp); b = __builtin_nontemporal_load((const f32x4*)(sp + ld_src)); c = __builtin_nontemporal_load((const f32x4*)(sp + 2 * (size_t)ld_src)); d = __builtin_nontemporal_load((const f32x4*)(sp + 3 * (size_t)ld_src)); }
        float s0 = W8_SCALE, s1 = W8_SCALE, s2 = W8_SCALE, s3 = W8_SCALE;
        if (ks) { const f32x4 kv = *(const f32x4*)(ks + k0 + 4 * kg); s0 *= kv[0]; s1 *= kv[1]; s2 *= kv[2]; s3 *= kv[3]; }
        a *= s0; b *= s1; c *= s2; d *= s3;
        LAS unsigned* p = scr + kg * 65 + 4 * nq;
        p[0] = pk4_fp8(a[0], b[0], c[0], d[0]); p[1] = pk4_fp8(a[1], b[1], c[1], d[1]); p[2] = pk4_fp8(a[2], b[2], c[2], d[2]); p[3] = pk4_fp8(a[3], b[3], c[3], d[3]); }
    LDS_WAIT(); asm volatile("" ::: "memory");
    const int c = lane & 7;
#pragma unroll
    for (int j = 0; j < 8; ++j) { const int n = (lane >> 3) + 8 * j; const LAS unsigned* s = scr + (4 * c) * 65 + n;
        u32x4 o; o.x = s[0]; o.y = s[65]; o.z = s[130]; o.w = s[195];
        *(u32x4*)(dst + (size_t)n * ld_dst + 16 * c) = o; }
    LDS_WAIT(); asm volatile("" ::: "memory");
}
__device__ __forceinline__ int colmap_in(int n32) { const int tile = n32 >> 3, j = n32 & 7;
    if (tile < 4) return (j < 4) ? 128 * tile + 32 * j : 512 + 128 * tile + 32 * (j - 4);
    if (tile == 4) return 1024 + 32 * j;
    if (tile == 5) return (j < 5) ? 1280 + 32 * j : -1;
    return (j < 4) ? 1440 + 128 * (tile - 6) + 32 * j : 1440 + 1024 + 128 * (tile - 6) + 32 * (j - 4); }
__device__ __forceinline__ int colmap_gu(int n32) { const int tile = n32 >> 3, j = n32 & 7; return (j < 4) ? 128 * tile + 32 * j : 1024 + 128 * tile + 32 * (j - 4); }
__device__ __forceinline__ int colmap_qb(int n32) { const int h = n32 >> 2, j = n32 & 3; return (j < 3) ? 96 * h + 32 * j : -1; }

__device__ __forceinline__ void p0_item(Ctx& F, int it, LAS unsigned* scr) {
    constexpr int I_GU = 256, I_D = 128, N_GU = NE * I_GU, N_D = NE * I_D, N_WIN = INPROJ_FP8 ? 56 * 8 : 56 * 16, N_WOUT = 256, N_PW2 = 128, N_WO = 128, N_QB = 64;
    int r = it;
    if (r < N_GU) { const int e = r / I_GU, q = r % I_GU, nb = q & 31, kb = q >> 5;
        tr_item8(F.w_gu + (size_t)e * 1024 * 2048, 2048, 128 * kb, colmap_gu(2 * nb), colmap_gu(2 * nb + 1), F.ffn_nw, WSP(unsigned char, WS_WGU) + ((size_t)e * 2048 + 64 * nb) * 1024 + 128 * kb, 1024, scr, F.lane); return; }
    r -= N_GU;
    if (r < N_D) { const int e = r / I_D, q = r % I_D, nb = q & 15, kb = q >> 4;
        tr_item8(F.w_d + (size_t)e * 1024 * 1024, 1024, 128 * kb, 64 * nb, 64 * nb + 32, nullptr, WSP(unsigned char, WS_WD) + ((size_t)e * 1024 + 64 * nb) * 1024 + 128 * kb, 1024, scr, F.lane); return; }
    r -= N_D;
#if INPROJ_FP8
    if (r < N_WIN) { const int nb = r >> 3, kb = r & 7;
        tr_item8(F.w_in, INC, 128 * kb, colmap_in(2 * nb), colmap_in(2 * nb + 1), F.attn_nw, WSP(unsigned char, WS_WIN) + (size_t)(64 * nb) * 1024 + 128 * kb, 1024, scr, F.lane); return; }
#else
    if (r < N_WIN) { const int nb = r >> 4, kb = r & 15;
        tr_item(F.w_in, INC, 64 * kb, colmap_in(2 * nb), colmap_in(2 * nb + 1), F.attn_nw, WSP(bf16, WS_WIN) + (size_t)(64 * nb) * 1024 + 64 * kb, 1024, scr, F.lane); return; }
#endif
    r -= N_WIN;
    if (r < N_WOUT) { const int nb = r >> 4, kb = r & 15;
        tr_item(F.w_out, 1024, 64 * kb, 64 * nb, 64 * nb + 32, nullptr, WSP(bf16, WS_WOUT) + (size_t)(64 * nb) * 1024 + 64 * kb, 1024, scr, F.lane); return; }
    r -= N_WOUT;
    if (r < N_PW2) { const int nb = r >> 3, kb = r & 7;
        tr_item(F.pw2_w, 1024, 64 * kb, 64 * nb, 64 * nb + 32, nullptr, WSP(bf16, WS_W2T) + (size_t)(64 * nb) * 1024 + 64 * kb, 1024, scr, F.lane); return; }
    r -= N_PW2;
    if (r < N_WO) { const int nb = r >> 3, kb = r & 7;
        tr_item(F.w_o, 1024, 64 * kb, 64 * nb, 64 * nb + 32, nullptr, WSP(bf16, WS_W2T) + (size_t)(64 * nb) * 1024 + 512 + 64 * kb, 1024, scr, F.lane); return; }
    r -= N_WO;
    if (r < N_QB) { const int nb = r >> 2, kb = r & 3;
        tr_item(F.w_qb, 768, 64 * kb, colmap_qb(2 * nb), colmap_qb(2 * nb + 1), F.qa_nw, WSP(bf16, WS_WQB) + (size_t)(64 * nb) * 256 + 64 * kb, 256, scr, F.lane); return; }
    r -= N_QB;
    { const int nb = r >> 2, kb = r & 3; const bool real = kb < 2;
        tr_item(F.w_kvb, 1024, real ? 64 * kb : 0, real ? 64 * nb : -1, real ? 64 * nb + 32 : -1, real ? F.kva_nw : nullptr, WSP(bf16, WS_WKVB) + (size_t)(64 * nb) * 256 + 64 * kb, 256, scr, F.lane); }
}
constexpr int P0_NITEMS = NE * 256 + NE * 128 + (INPROJ_FP8 ? 56 * 8 : 56 * 16) + 256 + 128 + 128 + 64 + 64;

__device__ __forceinline__ void p0_prologue(Ctx& F) {
    LAS unsigned* scr = (LAS unsigned*)F.lds + F.wave * 2080;
    const int gw = F.vcu * 8 + F.wave, NGW = F.G * 8, gth = gw * 64 + F.lane, NGT = NGW * 64;
    for (int it = gw; it < P0_NITEMS; it += NGW) p0_item(F, it, scr);
    bf16* XN = WSP(bf16, WS_XN);
    for (int m2 = gw; m2 < MT / 2; m2 += NGW) {
        f32x4 v[2][4]; float ss[2];
#pragma unroll
        for (int q = 0; q < 2; ++q) { const f32x4* xr = (const f32x4*)(F.x + (size_t)(2 * m2 + q) * DM) + F.lane;
#pragma unroll
            for (int j = 0; j < 4; ++j) v[q][j] = __builtin_nontemporal_load(xr + 64 * j); }
#pragma unroll
        for (int q = 0; q < 2; ++q) { float sq = 0.f;
#pragma unroll
            for (int j = 0; j < 4; ++j) sq += (v[q][j][0] * v[q][j][0] + v[q][j][1] * v[q][j][1]) + (v[q][j][2] * v[q][j][2] + v[q][j][3] * v[q][j][3]);
            ss[q] = sq; }
        ss[0] = wave_sum(ss[0]); ss[1] = wave_sum(ss[1]);
#pragma unroll
        for (int q = 0; q < 2; ++q) { if (F.lane == 0) WSP(float, WS_RSX)[2 * m2 + q] = (INPROJ_FP8 ? 1.f / (XQ_SCALE * W8_SCALE) : 1.f) / sqrtf(ss[q] * (1.f / DM) + NORM_EPS);
            u32x2* o8 = (u32x2*)(XN + (size_t)(2 * m2 + q) * DM) + F.lane;
#pragma unroll
            for (int j = 0; j < 4; ++j) { u32x2 o; o.x = pk2(v[q][j][0], v[q][j][1]); o.y = pk2(v[q][j][2], v[q][j][3]); o8[64 * j] = o; }
#if INPROJ_FP8
            unsigned* o4 = (unsigned*)(WSP(unsigned char, WS_XQ) + (size_t)(2 * m2 + q) * DM) + F.lane;
#pragma unroll
            for (int j = 0; j < 4; ++j) o4[64 * j] = pk4_fp8(v[q][j][0] * XQ_SCALE, v[q][j][1] * XQ_SCALE, v[q][j][2] * XQ_SCALE, v[q][j][3] * XQ_SCALE);
#endif
        }
    }
    float* PMP = WSP(float, WS_PMP);
    for (int task = gw; task < 19 * 8; task += NGW) { const int cg = task >> 3, kc = task & 7, cp = 64 * cg + F.lane; const bool valid = cp < PMC;
        const int sc = (cp < 1024) ? cp : 1280 + (cp - 1024);
        LAS float* ms = (LAS float*)scr;
#pragma unroll
        for (int r = 0; r < 16; ++r) { ms[r * 128 + F.lane] = F.meta[r * DM + kc * 128 + F.lane] * F.attn_nw[kc * 128 + F.lane]; ms[r * 128 + 64 + F.lane] = F.meta[r * DM + kc * 128 + 64 + F.lane] * F.attn_nw[kc * 128 + 64 + F.lane]; }
        LDS_WAIT(); asm volatile("" ::: "memory");
        float acc[16];
#pragma unroll
        for (int r = 0; r < 16; ++r) acc[r] = 0.f;
        const float* wp = F.w_in + (size_t)(kc * 128) * INC + (valid ? sc : 0);
        for (int k = 0; k < 128; k += 4) { const float w0 = wp[(size_t)k * INC], w1 = wp[(size_t)(k + 1) * INC], w2 = wp[(size_t)(k + 2) * INC], w3 = wp[(size_t)(k + 3) * INC];
#pragma unroll
            for (int r = 0; r < 16; ++r) { const f32x4 mv = *(const LAS f32x4*)(ms + r * 128 + k); acc[r] += (mv[0] * w0 + mv[1] * w1) + (mv[2] * w2 + mv[3] * w3); } }
        if (valid) {
#pragma unroll
            for (int r = 0; r < 16; ++r) PMP[(kc * 16 + r) * PMC + cp] = acc[r]; }
        LDS_WAIT(); asm volatile("" ::: "memory");
    }
    float* ROPE = WSP(float, WS_ROPE);
    for (int idx = gth; idx < (SEQ + NMETA) * 16; idx += NGT) { const int pos = idx >> 4, i = idx & 15;
        const double invf[16] = {1, 0.56234132519034907, 0.31622776601683794, 0.17782794100389229, 0.10000000000000001, 0.056234132519034911, 0.031622776601683791, 0.017782794100389229, 0.01, 0.005623413251903491, 0.0031622776601683794, 0.0017782794100389228, 0.001, 0.0005623413251903491, 0.00031622776601683794, 0.00017782794100389227};
        double fq = invf[0];
#pragma unroll
        for (int q = 1; q < 16; ++q) fq = (i == q) ? invf[q] : fq;
        const double ang = (double)pos * fq, red = ang - 6.283185307179586477 * __builtin_rint(ang * 0.15915494309189533577);
        float sn, cs; sincosf((float)red, &sn, &cs);
        ROPE[2 * idx] = cs; ROPE[2 * idx + 1] = sn; }
    for (int r = gw; r < NMETA; r += NGW) { float s = 0.f;
        for (int k = F.lane; k < DM; k += 64) { const float v = F.meta[r * DM + k]; s += v * v; }
        s = wave_sum(s); if (F.lane == 0) WSP(float, WS_METARS)[r] = 1.f / sqrtf(s * (1.f / DM) + NORM_EPS); }
    { unsigned short* RW3 = WSP(unsigned short, WS_RW3);
      for (int idx = gth; idx < DM * NE; idx += NGT) { const int k = idx >> 5, e = idx & 31; const float w = F.ffn_nw[k] * F.router_w[idx];
          const unsigned h = pk2(w, 0.f) & 0xffffu; const float r1 = w - __builtin_bit_cast(float, h << 16);
          const unsigned m = pk2(r1, 0.f) & 0xffffu; const float r2 = r1 - __builtin_bit_cast(float, m << 16);
          const unsigned l = pk2(r2, 0.f) & 0xffffu;
          const size_t o = ((size_t)((k >> 3) * NE + e)) * 8 + (k & 7);
          RW3[o] = (unsigned short)h; RW3[(size_t)NE * DM + o] = (unsigned short)m; RW3[(size_t)2 * NE * DM + o] = (unsigned short)l; } }
}

__device__ __forceinline__ float pm_sum(const float* PMP, int r, int c) { float s = 0.f;
#pragma unroll
    for (int kc = 0; kc < 8; ++kc) s += PMP[(kc * 16 + r) * PMC + c];
    return s; }
__device__ __forceinline__ void p1_meta(Ctx& F) {
    const float* PMP = WSP(float, WS_PMP); float* MRS = WSP(float, WS_METARS);
    const int bx = blockIdx.x;
    if (bx < 16) { const int rm = bx, c = F.tid; bf16* HG = WSP(bf16, WS_HG);
        const float rs = MRS[rm]; const float val = rs * pm_sum(PMP, rm, c) * sigmoid_f(rs * pm_sum(PMP, rm, 512 + c)); const bf16 hv = (bf16)f2bf(val);
#pragma unroll
        for (int b = 0; b < NB; ++b) { HG[((size_t)b * LPC + rm) * CDIM + c] = (bf16)0; HG[((size_t)b * LPC + 16 + rm) * CDIM + c] = hv; }
    } else if (bx == 16) {
#pragma unroll
        for (int q = 0; q < 2; ++q) { const int r = 2 * F.wave + q; const float rs = MRS[r];
            const float v0 = rs * pm_sum(PMP, r, 1024 + F.lane), v1 = rs * pm_sum(PMP, r, 1024 + 64 + F.lane);
            const float ss = wave_sum(v0 * v0 + v1 * v1); if (F.lane == 0) MRS[16 + r] = 1.f / sqrtf(ss * (1.f / KVLR) + NORM_EPS); }
    } else if (bx < 17 + 37) { float* PMF = WSP(float, WS_PMF);
        const int idx = (bx - 17) * 512 + F.tid; if (idx < 16 * PMC) PMF[idx] = pm_sum(PMP, idx / PMC, idx % PMC);
    } else if (bx < 54 + 8) {
        const int q = bx - 54, n = (q & 1) * 512 + F.tid, r0 = 4 * (q >> 1); LAS float* cs = (LAS float*)F.lds;
        { const int r = F.tid >> 7, k = F.tid & 127; cs[F.tid] = MRS[r0 + r] * pm_sum(PMP, r0 + r, 1024 + k); }
        __syncthreads();
        if (F.tid < 256) { const int r = F.tid >> 6, l = F.tid & 63; const float v0 = cs[r * 128 + l], v1 = cs[r * 128 + 64 + l]; const float ss = wave_sum(v0 * v0 + v1 * v1);
            if (l == 0) cs[512 + r] = 1.f / sqrtf(ss * (1.f / KVLR) + NORM_EPS); }
        __syncthreads();
        { const int r = F.tid >> 7, k = F.tid & 127; cs[F.tid] *= cs[512 + r] * F.kva_nw[k]; }
        __syncthreads();
        float acc[4] = {0.f, 0.f, 0.f, 0.f};
#pragma unroll 8
        for (int k = 0; k < KVLR; k += 4) { const float w0 = F.w_kvb[k * 1024 + n], w1 = F.w_kvb[(k + 1) * 1024 + n], w2 = F.w_kvb[(k + 2) * 1024 + n], w3 = F.w_kvb[(k + 3) * 1024 + n];
#pragma unroll
            for (int r = 0; r < 4; ++r) { const f32x4 c = *(const LAS f32x4*)(cs + r * 128 + k); acc[r] += (c[0] * w0 + c[1] * w1) + (c[2] * w2 + c[3] * w3); } }
#pragma unroll
        for (int r = 0; r < 4; ++r) WSP(float, WS_KVMETA)[(r0 + r) * 1024 + n] = acc[r];
        __syncthreads();
    }
}

__device__ __forceinline__ void p2_thin(Ctx& F) {
    {
        const bf16* HG = WSP(bf16, WS_HG); bf16* HC = WSP(bf16, WS_HCO);
        LAS unsigned char* lin = F.lds; LAS float* lout = (LAS float*)(F.lds + 63488);
        const int cp = F.tid & 255, th = F.tid >> 8;
        float wlo[CWID], whi[CWID];
#pragma unroll
        for (int j = 0; j < CWID; ++j) { const f32x2 w = *(const f32x2*)(F.dw_w + j * CDIM + 2 * cp); wlo[j] = w[0]; whi[j] = w[1]; }
        const f32x2 cb = *(const f32x2*)(F.dw_b + 2 * cp);
#define P2_LBAR() asm volatile("s_waitcnt lgkmcnt(0)\n\ts_barrier" ::: "memory")
        for (int rp = 0; rp < 1 + PROBE_P2A; ++rp) {
        u32x4 nx[8];
        if (F.vcu < NB * (SEQ / 32)) { const int b = F.vcu >> 7, t0 = (F.vcu & 127) * 32;
#pragma unroll
            for (int i = 0; i < 8; ++i) { const int p = F.tid + 512 * i; nx[i] = (u32x4){0u, 0u, 0u, 0u}; if (p < 62 * 64) nx[i] = *(const u32x4*)(HG + ((size_t)b * LPC + t0 + 2 + (p >> 6)) * CDIM + (p & 63) * 8); } }
        for (int un = F.vcu; un < NB * (SEQ / 32); un += F.G) { const int b = un >> 7, t0 = (un & 127) * 32;
#pragma unroll
            for (int i = 0; i < 8; ++i) { const int p = F.tid + 512 * i; if (p < 62 * 64) { const int row = p >> 6, ch = p & 63; *(LAS u32x4*)(lin + row * 1024 + ch * 16) = nx[i]; } }
            P2_LBAR();
            if (un + F.G < NB * (SEQ / 32)) { const int un1 = un + F.G, b1 = un1 >> 7, t1 = (un1 & 127) * 32;
#pragma unroll
                for (int i = 0; i < 8; ++i) { const int p = F.tid + 512 * i; if (p < 62 * 64) nx[i] = *(const u32x4*)(HG + ((size_t)b1 * LPC + t1 + 2 + (p >> 6)) * CDIM + (p & 63) * 8); } }
#pragma unroll
            for (int g = 0; g < 2; ++g) { const int tl0 = th * 16 + g * 8; float a0[8], a1[8];
#pragma unroll
                for (int o = 0; o < 8; ++o) { a0[o] = cb[0]; a1[o] = cb[1]; }
#pragma unroll
                for (int jj = 0; jj < 38; ++jj) { const unsigned v = *(const LAS unsigned*)(lin + (tl0 + jj) * 1024 + 4 * cp); const float lo = bflo(v), hi = bfhi(v);
#pragma unroll
                    for (int o = 0; o < 8; ++o) { const int j = jj - o; if (j >= 0 && j < CWID) { a0[o] += wlo[j] * lo; a1[o] += whi[j] * hi; } } }
#pragma unroll
                for (int o = 0; o < 8; ++o) *(LAS f32x2*)(lout + (tl0 + o) * CDIM + 2 * cp) = (f32x2){a0[o], a1[o]}; }
            P2_LBAR();
            { const int tok = 4 * F.wave + (F.lane >> 4), l16 = F.lane & 15;
                f32x4 v[4][2]; float sm = 0.f;
#pragma unroll
                for (int j = 0; j < 4; ++j) { const LAS float* lr = lout + tok * CDIM + 128 * j + 8 * l16; v[j][0] = *(const LAS f32x4*)lr; v[j][1] = *(const LAS f32x4*)(lr + 4);
                    sm += (v[j][0][0] + v[j][0][1]) + (v[j][0][2] + v[j][0][3]) + (v[j][1][0] + v[j][1][1]) + (v[j][1][2] + v[j][1][3]); }
                const float mean = sum16(sm) * (1.f / CDIM); float sv = 0.f;
#pragma unroll
                for (int j = 0; j < 4; ++j)
#pragma unroll
                    for (int q = 0; q < 2; ++q) { v[j][q] = v[j][q] - mean; sv += (v[j][q][0] * v[j][q][0] + v[j][q][1] * v[j][q][1]) + (v[j][q][2] * v[j][q][2] + v[j][q][3] * v[j][q][3]); }
                const float rstd = 1.f / sqrtf(sum16(sv) * (1.f / CDIM) + NORM_EPS);
#pragma unroll
                for (int j = 0; j < 4; ++j) { const int c0 = 128 * j + 8 * l16;
                    const f32x4 w0 = *(const f32x4*)(F.ln_w + c0), w1 = *(const f32x4*)(F.ln_w + c0 + 4), b0 = *(const f32x4*)(F.ln_b + c0), b1 = *(const f32x4*)(F.ln_b + c0 + 4);
                    f32x4 y0 = v[j][0] * rstd * w0 + b0, y1 = v[j][1] * rstd * w1 + b1;
#pragma unroll
                    for (int e = 0; e < 4; ++e) { y0[e] = y0[e] * sigmoid_f(y0[e]); y1[e] = y1[e] * sigmoid_f(y1[e]); }
                    *(u32x4*)(HC + ((size_t)b * SEQ + t0 + tok) * 1024 + c0) = pack8(y0, y1); } }
            P2_LBAR();
        }
        }
#undef P2_LBAR
    }
}

__device__ __forceinline__ void norm_rope_store(float (&v)[48], int part, const float* nw, const float* rp, float scale, bf16* dst) {
    float ss = 0.f;
#pragma unroll
    for (int d = 0; d < 48; ++d) ss += v[d] * v[d];
    ss += __shfl_xor(ss, 1);
    const float r = scale / sqrtf(ss * (1.f / DQK) + NORM_EPS);
    const float* nwp = nw + 48 * part;
#pragma unroll
    for (int d = 0; d < 48; ++d) v[d] *= r * nwp[d];
    if (part) {
#pragma unroll
        for (int i = 0; i < 16; ++i) { const float c = rp[2 * i], s = rp[2 * i + 1], x1 = v[16 + i], x2 = v[32 + i]; v[16 + i] = x1 * c - x2 * s; v[32 + i] = x2 * c + x1 * s; }
    }
#pragma unroll
    for (int q = 0; q < 6; ++q) { u32x4 w; w.x = pk2(v[8 * q], v[8 * q + 1]); w.y = pk2(v[8 * q + 2], v[8 * q + 3]); w.z = pk2(v[8 * q + 4], v[8 * q + 5]); w.w = pk2(v[8 * q + 6], v[8 * q + 7]); *(u32x4*)(dst + 8 * q) = w; }
}
__device__ __forceinline__ void ld8(const bf16* p, float* v) { const u32x4 w = *(const u32x4*)p; v[0] = bflo(w.x); v[1] = bfhi(w.x); v[2] = bflo(w.y); v[3] = bfhi(w.y); v[4] = bflo(w.z); v[5] = bfhi(w.z); v[6] = bflo(w.w); v[7] = bfhi(w.w); }

__device__ __forceinline__ void p4_headnorm(Ctx& F) {
    const int gw = F.vcu * 8 + F.wave, NGW = F.G * 8;
    const bf16* QRAW = WSP(bf16, WS_QRAW); bf16* KVRAW = WSP(bf16, WS_KVRAW); const bf16* KVLAT = WSP(bf16, WS_KVLAT);
    bf16* QF = WSP(bf16, WS_QF); bf16* KF = WSP(bf16, WS_KF); const float* ROPE = WSP(float, WS_ROPE);
    const float* PM = WSP(float, WS_PMF); const float* MRS = WSP(float, WS_METARS); const float* KVM = WSP(float, WS_KVMETA);
    constexpr int T_REAL = 0, T_META = NB * 4, T_DUMMY = NB * 48;
    const int part = F.lane & 1, h = (F.lane >> 1) & 7, tl = F.lane >> 4;
    for (int wt = gw; wt < T_REAL + T_META + T_DUMMY; wt += NGW) {
        if (false) {
        } else if (wt < T_REAL + T_META) {
            const int q = wt - T_REAL, b = q >> 2, r = tl + 4 * (q & 3); const float* rp = ROPE + (size_t)r * 32;
            float v[48]; const float* src = KVM + r * 1024 + h * 128; const float rs = MRS[r];
            if (part == 0) {
#pragma unroll
                for (int d = 0; d < 48; ++d) v[d] = src[d];
            } else {
#pragma unroll
                for (int d = 0; d < 16; ++d) v[d] = src[48 + d];
#pragma unroll
                for (int i = 0; i < 32; ++i) v[16 + i] = rs * PM[r * PMC + 1152 + i];
            }
            const size_t kr = (size_t)b * LPK + r;
            norm_rope_store(v, part, F.k_nw, rp, 1.f, KF + ((size_t)(b * NH + h) * LPK + r) * DQK + 48 * part);
            bf16* vd = KVRAW + kr * 1024 + h * 128 + 64 + 32 * part; const float* vs = src + 64 + 32 * part;
#pragma unroll
            for (int q8 = 0; q8 < 4; ++q8) { u32x4 w; w.x = pk2(vs[8 * q8], vs[8 * q8 + 1]); w.y = pk2(vs[8 * q8 + 2], vs[8 * q8 + 3]); w.z = pk2(vs[8 * q8 + 4], vs[8 * q8 + 5]); w.w = pk2(vs[8 * q8 + 6], vs[8 * q8 + 7]); *(u32x4*)(vd + 8 * q8) = w; }
        } else {
            const int q = wt - T_REAL - T_META, b = q / 48, r = 16 + q % 48; const size_t kr = (size_t)b * LPK + r; const u32x4 z = {0u, 0u, 0u, 0u};
            u32x4* vd = (u32x4*)(KVRAW + kr * 1024); vd[F.lane] = z; vd[64 + F.lane] = z;
            for (int q2 = F.lane; q2 < NH * 12; q2 += 64) { const int hh = q2 / 12, c = q2 % 12; *(u32x4*)(KF + ((size_t)(b * NH + hh) * LPK + r) * DQK + 8 * c) = z; }
        }
    }
}

namespace att {
constexpr int KSLOT = 16384, VSLOT = 8192, SLOT = KSLOT + VSLOT, NSLOT = 4, L_WS = NSLOT * SLOT, L_OST = 0, L_END = L_WS + 8 * 256;
static_assert(8 * 4096 <= 2 * SLOT && L_END <= RING_BYTES, "attention LDS map");
constexpr float THR = 8.f;
__device__ __forceinline__ int crow(int r, int hi) { return (r & 3) + 8 * (r >> 2) + 4 * hi; }
__device__ __forceinline__ float max3f(float a, float b, float c) { float r; asm("v_max3_f32 %0, %1, %2, %3" : "=v"(r) : "v"(a), "v"(b), "v"(c)); return r; }
__device__ __forceinline__ float max2f(float a, float b) { float r; asm("v_max_f32_e32 %0, %1, %2" : "=v"(r) : "v"(a), "v"(b)); return r; }
__device__ __forceinline__ void glds16(const void* gsrc, unsigned lds_dst) { unsigned keep;
    asm volatile("s_mov_b32 %0, m0\n\ts_mov_b32 m0, %2\n\ts_nop 0\n\tglobal_load_lds_dwordx4 %1, off\n\ts_mov_b32 m0, %0" : "=&s"(keep) : "v"(gsrc), "s"(lds_dst) : "memory"); }
typedef short v4i16_t __attribute__((ext_vector_type(4)));
__device__ __forceinline__ s16x4 vtr(const LAS unsigned char* p) { return __builtin_bit_cast(s16x4, __builtin_amdgcn_ds_read_tr16_b64_v4i16((LAS v4i16_t*)p)); }
__device__ __forceinline__ void pv(f32x16* o, const LAS unsigned char* vp, bf16x8 pa0, bf16x8 pa1, bf16x8 pa2, bf16x8 pa3) {
#pragma unroll
    for (int d0 = 0; d0 < 2; ++d0) { s16x4 lo[4], hi[4];
#pragma unroll
        for (int ks = 0; ks < 4; ++ks) { lo[ks] = vtr(vp + d0 * 4096 + ks * 1024); hi[ks] = vtr(vp + d0 * 4096 + ks * 1024 + 512); }
#define PK(k) (bf16x8){lo[k][0], lo[k][1], lo[k][2], lo[k][3], hi[k][0], hi[k][1], hi[k][2], hi[k][3]}
        o[d0] = __builtin_amdgcn_mfma_f32_32x32x16_bf16(pa0, PK(0), o[d0], 0, 0, 0);
        o[d0] = __builtin_amdgcn_mfma_f32_32x32x16_bf16(pa1, PK(1), o[d0], 0, 0, 0);
        o[d0] = __builtin_amdgcn_mfma_f32_32x32x16_bf16(pa2, PK(2), o[d0], 0, 0, 0);
        o[d0] = __builtin_amdgcn_mfma_f32_32x32x16_bf16(pa3, PK(3), o[d0], 0, 0, 0);
#undef PK
    }
}
__device__ __forceinline__ void attn_unit(Ctx& F, int b, int h, int qb) {
    const int lane = F.lane, r32 = lane & 31, hi = lane >> 5, wid = F.wave;
    const bf16* QF = WSP(bf16, WS_QF); const bf16* KF = WSP(bf16, WS_KF); const bf16* KVRAW = WSP(bf16, WS_KVRAW); bf16* O = WSP(bf16, WS_HCO) + 512;
    const size_t rowq0 = (size_t)b * SEQ + 256 * qb + 32 * wid;
    const bf16* Kh = KF + (size_t)(b * NH + h) * LPK * DQK; const bf16* Vh = KVRAW + (size_t)b * LPK * 1024 + h * 128 + 64;
    const unsigned lds0 = (unsigned)(uintptr_t)F.lds;
    const int NT = 4 * qb + 5;
    const bf16* ksrc0; const bf16* ksrc1;
    { const int row0 = 8 * wid + (lane >> 4), row1 = row0 + 4; int c0 = (lane & 15) ^ (row0 & 15), c1 = (lane & 15) ^ (row1 & 15); c0 -= (c0 >= 12) ? 4 : 0; c1 -= (c1 >= 12) ? 4 : 0;
      ksrc0 = Kh + (size_t)row0 * DQK + c0 * 8; ksrc1 = Kh + (size_t)row1 * DQK + c1 * 8; }
    const bf16* vsrc = Vh + (size_t)(16 * (wid & 3) + (lane >> 2)) * 1024 + (wid >> 2) * 32 + (lane & 3) * 8;
#define ATT_TIX(i) (((i) == 0) ? 0 : (((i) < 5) ? 4 * qb + (i) : (i) - 4))
#define ATT_DMA(i, slot) do { const int _t = ATT_TIX(i); const unsigned _s = lds0 + (slot); glds16(ksrc0 + (size_t)_t * 64 * DQK, (unsigned)__builtin_amdgcn_readfirstlane(_s + wid * 2048)); \
        glds16(ksrc1 + (size_t)_t * 64 * DQK, (unsigned)__builtin_amdgcn_readfirstlane(_s + wid * 2048 + 1024)); \
        glds16(vsrc + (size_t)_t * 64 * 1024, (unsigned)__builtin_amdgcn_readfirstlane(_s + KSLOT + wid * 1024)); } while (0)
#define ATT_BAR() asm volatile("s_waitcnt vmcnt(0) lgkmcnt(0)\n\ts_barrier" ::: "memory")
#define ATT_BARC(issued) do { if (issued) asm volatile("s_waitcnt vmcnt(3) lgkmcnt(0)\n\ts_barrier" ::: "memory"); else ATT_BAR(); } while (0)
#define ATT_KLD(slot, hh) do { const LAS unsigned char* kb_ = kp0 + (slot) + (hh) * 8192; int xk_ = xk; asm volatile("" : "+v"(xk_));     \
        _Pragma("unroll") for (int d0 = 0; d0 < 6; ++d0) kf[d0] = *(const LAS bf16x8*)(kb_ + (((2 * d0 + hi) ^ xk_) << 4)); } while (0)
#define ATT_QKM(S) do { S = __builtin_amdgcn_mfma_f32_32x32x16_bf16(kf[0], qr[0], negm, 0, 0, 0); _Pragma("unroll") for (int d0 = 1; d0 < 6; ++d0) S = __builtin_amdgcn_mfma_f32_32x32x16_bf16(kf[d0], qr[d0], S, 0, 0, 0); } while (0)
#define ATT_RMAX(S, RM) do { float a_ = max3f(S[0], S[1], S[2]), b_ = max3f(S[3], S[4], S[5]); a_ = max3f(a_, S[6], S[7]); b_ = max3f(b_, S[8], S[9]); a_ = max3f(a_, S[10], S[11]); b_ = max3f(b_, S[12], S[13]); a_ = max3f(a_, S[14], S[15]); a_ = max2f(a_, b_); \
        { const auto rr = __builtin_amdgcn_permlane32_swap(__float_as_uint(a_), __float_as_uint(a_), false, false); RM = max2f(__uint_as_float(rr[0]), __uint_as_float(rr[1])); } } while (0)
#define ATT_RESC(S, rm) do { \
        if (__any(rm > THR)) { const float dl = fmaxf(rm, 0.f), f = __builtin_amdgcn_exp2f(-dl); m_run += dl; l_run *= f; if (hi == 0) wsf[r32] = f; \
            _Pragma("unroll") for (int r = 0; r < 16; ++r) { const float fr_ = wsf[crow(r, hi)]; o[0][r] *= fr_; o[1][r] *= fr_; } \
            _Pragma("unroll") for (int r = 0; r < 16; ++r) { S[r] -= dl; negm[r] = -m_run; } } } while (0)
#define ATT_SMA(S) do { float rm_; ATT_RMAX(S, rm_); ATT_RESC(S, rm_); } while (0)
#define ATT_VLD(slot, hh) do { const LAS unsigned char* vp_ = vp0 + (slot) + (hh) * 2048; \
        _Pragma("unroll") for (int d0 = 0; d0 < 2; ++d0) _Pragma("unroll") for (int kk = 0; kk < 2; ++kk) { vl[d0 * 2 + kk] = vtr(vp_ + d0 * 4096 + kk * 1024); vh[d0 * 2 + kk] = vtr(vp_ + d0 * 4096 + kk * 1024 + 512); } } while (0)
#define ATT_VF(x) ((bf16x8){vl[x][0], vl[x][1], vl[x][2], vl[x][3], vh[x][0], vh[x][1], vh[x][2], vh[x][3]})
#define ATT_PVM(PA, PB) do { _Pragma("unroll") for (int d0 = 0; d0 < 2; ++d0) { \
            o[d0] = __builtin_amdgcn_mfma_f32_32x32x16_bf16(__builtin_bit_cast(bf16x8, PA), ATT_VF(d0 * 2), o[d0], 0, 0, 0); \
            o[d0] = __builtin_amdgcn_mfma_f32_32x32x16_bf16(__builtin_bit_cast(bf16x8, PB), ATT_VF(d0 * 2 + 1), o[d0], 0, 0, 0); } } while (0)
#define ATT_SMB(S, PA, PB) do { float sacc = 0.f; \
        _Pragma("unroll") for (int r = 0; r < 16; ++r) { S[r] = __builtin_amdgcn_exp2f(S[r]); sacc += S[r]; } \
        l_run += sacc; \
        PA = (u32x4){pk2(S[0], S[1]), pk2(S[2], S[3]), pk2(S[4], S[5]), pk2(S[6], S[7])}; PB = (u32x4){pk2(S[8], S[9]), pk2(S[10], S[11]), pk2(S[12], S[13]), pk2(S[14], S[15])}; } while (0)
#define ATT_PVH(slot, hh, PA, PB) do { const LAS unsigned char* vp_ = vp0 + (slot) + (hh) * 2048; \
        _Pragma("unroll") for (int d0 = 0; d0 < 2; ++d0) { const s16x4 l0_ = vtr(vp_ + d0 * 4096), h0_ = vtr(vp_ + d0 * 4096 + 512), l1_ = vtr(vp_ + d0 * 4096 + 1024), h1_ = vtr(vp_ + d0 * 4096 + 1536); \
            o[d0] = __builtin_amdgcn_mfma_f32_32x32x16_bf16(__builtin_bit_cast(bf16x8, PA), ((bf16x8){l0_[0], l0_[1], l0_[2], l0_[3], h0_[0], h0_[1], h0_[2], h0_[3]}), o[d0], 0, 0, 0); \
            o[d0] = __builtin_amdgcn_mfma_f32_32x32x16_bf16(__builtin_bit_cast(bf16x8, PB), ((bf16x8){l1_[0], l1_[1], l1_[2], l1_[3], h1_[0], h1_[1], h1_[2], h1_[3]}), o[d0], 0, 0, 0); } } while (0)
    ATT_DMA(0, 0); ATT_DMA(1, SLOT); if (2 < NT) ATT_DMA(2, 2 * SLOT);
    bf16x8 qr[6], kf[6];
    { const bf16* Qw = QF + (rowq0 + r32) * 768 + h * DQK + hi * 8;
#pragma unroll
        for (int d0 = 0; d0 < 6; ++d0) qr[d0] = *(const bf16x8*)(Qw + 16 * d0); }
    LAS float* wsf = (LAS float*)(F.lds + L_WS) + wid * 64;
    float m_run = 0.f, l_run = 0.f; f32x16 o[2]; o[0] = f32x16{}; o[1] = f32x16{}; f32x16 negm = f32x16{};
    const LAS unsigned char* kp0 = F.lds + r32 * 256;
    const int xk = r32 & 15;
    const LAS unsigned char* vp0 = F.lds + KSLOT + ((lane >> 4) & 1) * 32 + (lane & 3) * 8 + (4 * hi + ((lane & 15) >> 2)) * 64;
    u32x4 pw0, pw1; f32x16 sa, sb;
    ATT_BAR();
    int sl = 0, sl3 = 3 * SLOT;
#define ATT_ROT() do { sl = (sl == 3 * SLOT) ? 0 : sl + SLOT; sl3 = (sl3 == 3 * SLOT) ? 0 : sl3 + SLOT; } while (0)
#pragma unroll 1
    for (int i = 0; i < 5; ++i) {
        if (i + 3 < NT) ATT_DMA(i + 3, sl3);
        const int jb = i - 1;
#pragma unroll
        for (int hh = 0; hh < 2; ++hh) {
            const bool skip = (i == 0) ? (hh == 1) : (64 * jb + 32 * hh > 32 * wid + 31);
            if (!skip) {
                ATT_KLD(sl, hh); ATT_QKM(sa);
                if (i == 0) {
#pragma unroll
                    for (int r = 0; r < 16; ++r) if (crow(r, hi) >= NMETA) sa[r] = -INFINITY;
                } else if (64 * jb + 32 * hh + 31 > 32 * wid) {
                    const int qrel = 32 * wid + r32 - 64 * jb - 32 * hh;
#pragma unroll
                    for (int r = 0; r < 16; ++r) if (crow(r, hi) > qrel) sa[r] = -INFINITY;
                }
                ATT_SMA(sa); ATT_SMB(sa, pw0, pw1); ATT_PVH(sl, hh, pw0, pw1);
            }
        }
        ATT_BARC(i + 3 < NT); ATT_ROT();
    }
    if (NT > 5) {
        s16x4 vl[4], vh[4]; float rm;
        ATT_KLD(sl, 0); ATT_QKM(sa);
        ATT_KLD(sl, 1); __builtin_amdgcn_sched_barrier(0);
        ATT_RMAX(sa, rm); ATT_RESC(sa, rm);
        ATT_QKM(sb); ATT_SMB(sa, pw0, pw1);
        ATT_VLD(sl, 0);
#pragma unroll 1
        for (int i = 5; i < NT - 1; ++i) {
            if (i + 3 < NT) ATT_DMA(i + 3, sl3);
            const int sln = (sl == 3 * SLOT) ? 0 : sl + SLOT;
            ATT_KLD(sln, 0); __builtin_amdgcn_sched_barrier(0);
            ATT_PVM(pw0, pw1); ATT_RMAX(sb, rm);
            ATT_RESC(sb, rm);
            ATT_QKM(sa); ATT_SMB(sb, pw0, pw1);
            ATT_VLD(sl, 1);
            ATT_BARC(i + 3 < NT); ATT_ROT();
            ATT_KLD(sl, 1); __builtin_amdgcn_sched_barrier(0);
            ATT_PVM(pw0, pw1); ATT_RMAX(sa, rm);
            ATT_RESC(sa, rm);
            ATT_QKM(sb); ATT_SMB(sa, pw0, pw1);
            ATT_VLD(sl, 0);
        }
        ATT_PVM(pw0, pw1); ATT_RMAX(sb, rm);
        ATT_RESC(sb, rm);
        ATT_SMB(sb, pw0, pw1);
        ATT_VLD(sl, 1);
        ATT_PVM(pw0, pw1);
        ATT_BAR();
    }
    { const auto rr = __builtin_amdgcn_permlane32_swap(__float_as_uint(l_run), __float_as_uint(l_run), false, false); l_run = __uint_as_float(rr[0]) + __uint_as_float(rr[1]); }
    if (hi == 0) wsf[32 + r32] = l_run;
    float rli[16];
#pragma unroll
    for (int r = 0; r < 16; ++r) rli[r] = __builtin_amdgcn_rcpf(wsf[32 + crow(r, hi)]);
    { LAS bf16* stg = (LAS bf16*)(F.lds + L_OST) + wid * 2048;
#pragma unroll
        for (int r = 0; r < 16; ++r) { const int orow = crow(r, hi);
#pragma unroll
            for (int d0 = 0; d0 < 2; ++d0) stg[orow * 64 + d0 * 32 + r32] = (bf16)f2bf(o[d0][r] * rli[r]); }
        asm volatile("s_waitcnt lgkmcnt(0)" ::: "memory");
#pragma unroll
        for (int i = 0; i < 4; ++i) { const int row = i * 8 + (lane >> 3), ch = lane & 7; const u32x4 v = *(const LAS u32x4*)(stg + row * 64 + ch * 8);
            *(u32x4*)(O + (rowq0 + row) * 1024 + h * DV + ch * 8) = v; } }
    asm volatile("s_waitcnt lgkmcnt(0)\n\ts_barrier" ::: "memory");
#undef ATT_TIX
#undef ATT_DMA
#undef ATT_BAR
#undef ATT_BARC
#undef ATT_KLD
#undef ATT_QKM
#undef ATT_SMA
#undef ATT_RMAX
#undef ATT_RESC
#undef ATT_VLD
#undef ATT_VF
#undef ATT_PVM
#undef ATT_SMB
#undef ATT_PVH
#undef ATT_ROT
}
__device__ __forceinline__ void attn_phase(Ctx& F) {
    for (int v = F.vcu; v < 256; v += F.G) { const int bh = v >> 2, s = v & 3;
#pragma unroll 1
        for (int i = 0; i < 4; ++i) { const int qb = (i == 0) ? s : (i == 1) ? 7 - s : (i == 2) ? 8 + s : 15 - s; attn_unit(F, bh >> 3, bh & 7, qb); } }
}
}

__device__ __forceinline__ void p8_router(Ctx& F) {
    LAS float* xch = (LAS float*)F.lds;
    volatile LAS int* cnt_l = (volatile LAS int*)(F.lds + LDSCTL_OFF + 1024); volatile LAS int* base_l = cnt_l + 32;
    const bf16* H1 = WSP(bf16, WS_H1B);
    int* gcount = (int*)(F.ctl + CW_CNT); int* LTOK = WSP(int, WS_LTOK); float* LW = WSP(float, WS_LW); float* LRS = WSP(float, WS_LRS); int* TOKPOS = WSP(int, WS_TOKPOS);
    for (int un = F.vcu; un < MT / 128; un += F.G) {
        if (F.tid < 32) cnt_l[F.tid] = 0;
        const int j = F.lane & 31, kh = F.lane >> 5, grp = F.wave & 3, kq = F.wave >> 2; const int token = un * 128 + 32 * grp + j;
        int te[4] = {0, 0, 0, 0}, sl[4] = {0, 0, 0, 0}; float tg[4] = {0.f, 0.f, 0.f, 0.f}; float rstd = 0.f;
        f32x16 acc = f32x16{}; float ss = 0.f;
        { const bf16* row = H1 + (size_t)token * DM + 512 * kq + 32 * kh;
          const bf16* a0 = WSP(bf16, WS_RW3) + ((size_t)(64 * kq + 4 * kh) * NE + j) * 8;
#pragma unroll 4
            for (int st = 0; st < 32; ++st) { const u32x4 hw = *(const u32x4*)(row + 64 * (st >> 2) + 8 * (st & 3)); f32x4 h0, h1; unpack8(hw, h0, h1);
                ss += ((h0[0] * h0[0] + h0[1] * h0[1]) + (h0[2] * h0[2] + h0[3] * h0[3])) + ((h1[0] * h1[0] + h1[1] * h1[1]) + (h1[2] * h1[2] + h1[3] * h1[3]));
                const bf16x8 hb = __builtin_bit_cast(bf16x8, hw);
                const int ao = (8 * (st >> 2) + (st & 3)) * (NE * 8);
                const bf16x8 ah = *(const bf16x8*)(a0 + ao), am = *(const bf16x8*)(a0 + (size_t)NE * DM + ao), al = *(const bf16x8*)(a0 + (size_t)2 * NE * DM + ao);
                acc = __builtin_amdgcn_mfma_f32_32x32x16_bf16(al, hb, acc, 0, 0, 0); acc = __builtin_amdgcn_mfma_f32_32x32x16_bf16(am, hb, acc, 0, 0, 0); acc = __builtin_amdgcn_mfma_f32_32x32x16_bf16(ah, hb, acc, 0, 0, 0); } }
        if (kq == 1) { LAS float* xp = xch + grp * 17 * 64 + F.lane;
#pragma unroll
            for (int r = 0; r < 16; ++r) xp[r * 64] = acc[r];
            xp[16 * 64] = ss; }
        __syncthreads();
        if (kq == 0) {
            { const LAS float* xp = xch + grp * 17 * 64 + F.lane;
#pragma unroll
                for (int r = 0; r < 16; ++r) acc[r] += xp[r * 64];
                ss += xp[16 * 64]; }
            ss += __shfl_xor(ss, 32);
            rstd = 1.f / sqrtf(ss * (1.f / DM) + NORM_EPS);
            float cv[8]; int ci[8];
            float lv[16];
#pragma unroll
            for (int r = 0; r < 16; ++r) lv[r] = acc[r] * rstd + F.router_b[att::crow(r, kh)];
#pragma unroll
            for (int k = 0; k < 4; ++k) { float bv = -INFINITY; int bi = 0;
#pragma unroll
                for (int r = 0; r < 16; ++r) { const bool better = lv[r] > bv; bv = better ? lv[r] : bv; bi = better ? r : bi; }
#pragma unroll
                for (int r = 0; r < 16; ++r) if (r == bi) lv[r] = -INFINITY;
                cv[k] = bv; ci[k] = att::crow(bi, kh); }
#pragma unroll
            for (int k = 0; k < 4; ++k) { cv[4 + k] = __shfl_xor(cv[k], 32); ci[4 + k] = __shfl_xor(ci[k], 32); }
#pragma unroll
            for (int k = 0; k < 4; ++k) { float bv = -INFINITY; int bi = 1 << 20, bp = 0;
#pragma unroll
                for (int c = 0; c < 8; ++c) { const bool better = (cv[c] > bv) || (cv[c] == bv && ci[c] < bi); bv = better ? cv[c] : bv; bi = better ? ci[c] : bi; bp = better ? c : bp; }
#pragma unroll
                for (int c = 0; c < 8; ++c) if (c == bp) cv[c] = -INFINITY;
                tg[k] = bv; te[k] = bi; }
            { const float e1 = __expf(tg[1] - tg[0]), e2 = __expf(tg[2] - tg[0]), e3 = __expf(tg[3] - tg[0]); const float inv = 1.f / (1.f + e1 + e2 + e3); tg[0] = inv; tg[1] = e1 * inv; tg[2] = e2 * inv; tg[3] = e3 * inv; }
            if (kh == 0) {
#pragma unroll
                for (int k = 0; k < 4; ++k) sl[k] = __hip_atomic_fetch_add((LAS int*)&cnt_l[te[k]], 1, __ATOMIC_RELAXED, __HIP_MEMORY_SCOPE_WORKGROUP); }
        }
        __syncthreads();
        if (F.tid < 32) base_l[F.tid] = atomicAdd(gcount + F.tid, cnt_l[F.tid]);
        __syncthreads();
        if (kq == 0 && kh == 0) {
#pragma unroll
            for (int k = 0; k < 4; ++k) { const int slot = base_l[te[k]] + sl[k]; const size_t li = (size_t)te[k] * ECAP + slot;
                LTOK[li] = token; LW[li] = tg[k]; LRS[li] = rstd; TOKPOS[token * 4 + k] = te[k] * ECAP + slot; } }
        __syncthreads();
    }
}

__device__ __forceinline__ void moe_table(Ctx& F) {
    volatile LAS int* tb = (volatile LAS int*)(F.lds + LDSCTL_OFF); volatile LAS int* cnt = (volatile LAS int*)(F.lds + LDSCTL_OFF + 256);
    if (F.tid < 64) { const int* gcount = (const int*)(F.ctl + CW_CNT); const int c = (F.lane < NE) ? gcount[F.lane] : 0; const int nt = (c + 255) >> 8;
        int incl = nt;
#pragma unroll
        for (int o = 1; o < 32; o <<= 1) { const int v = __shfl_up(incl, o); if ((F.lane & 31) >= o) incl += v; }
        if (F.lane < NE) { cnt[F.lane] = c; tb[F.lane] = incl - nt; if (F.lane == NE - 1) tb[NE] = incl; } }
    __syncthreads();
    { const int TT = tb[NE];
      for (int mt = F.tid; mt < TT; mt += 512) { int e = 0;
#pragma unroll
          for (int st = 16; st >= 1; st >>= 1) if (e + st < NE && tb[e + st] <= mt) e += st;
          tb[512 + mt] = e; } }
    __syncthreads();
}

__device__ __forceinline__ void p11_combine(Ctx& F) {
    const volatile LAS int* tb = (const volatile LAS int*)(F.lds + LDSCTL_OFF);
    const int gw = F.vcu * 8 + F.wave, NGW = F.G * 8;
    const bf16* H1 = WSP(bf16, WS_H1B); const unsigned char* Y = WSP(unsigned char, WS_Y); const int* TOKPOS = WSP(int, WS_TOKPOS);
    typedef int i32x4v __attribute__((ext_vector_type(4)));
    const i32x4v* TP4 = (const i32x4v*)TOKPOS;
    i32x4v tp[2]; { const int m0 = gw, m1 = gw + NGW; tp[0] = TP4[m0 < MT ? m0 : 0]; tp[1] = TP4[m1 < MT ? m1 : 0]; }
    for (int mb = gw; mb < MT; mb += 2 * NGW) {
        i32x4v tn[2]; { const int n0 = mb + 2 * NGW, n1 = mb + 3 * NGW; tn[0] = TP4[n0 < MT ? n0 : 0]; tn[1] = TP4[n1 < MT ? n1 : 0]; }
        u32x4 hw[2][2], yw[2][4];
#pragma unroll
        for (int q = 0; q < 2; ++q) { const int m = mb + q * NGW; const int mm = m < MT ? m : mb;
            const u32x4* hp = (const u32x4*)(H1 + (size_t)mm * DM + 16 * F.lane); hw[q][0] = __builtin_nontemporal_load(hp); hw[q][1] = __builtin_nontemporal_load(hp + 1);
#pragma unroll
            for (int k = 0; k < 4; ++k) { const int p = tp[q][k], e = p >> 15, slot = p & (ECAP - 1); const size_t yr = (size_t)tb[e] * 256 + slot;
                yw[q][k] = __builtin_nontemporal_load((const u32x4*)(Y + yr * DM + 16 * F.lane)); } }
#pragma unroll
        for (int q = 0; q < 2; ++q) { const int m = mb + q * NGW; if (m < MT) {
            f32x4 a0, a1, a2, a3; unpack8(hw[q][0], a0, a1); unpack8(hw[q][1], a2, a3);
            f32x4 s0 = {0.f, 0.f, 0.f, 0.f}, s1 = s0, s2 = s0, s3 = s0;
#pragma unroll
            for (int k = 0; k < 4; ++k) { const u32x4 y = yw[q][k];
                { const f32x2 p0 = __builtin_amdgcn_cvt_pk_f32_fp8((int)y.x, false), p1 = __builtin_amdgcn_cvt_pk_f32_fp8((int)y.x, true); s0[0] += p0[0]; s0[1] += p0[1]; s0[2] += p1[0]; s0[3] += p1[1]; }
                { const f32x2 p0 = __builtin_amdgcn_cvt_pk_f32_fp8((int)y.y, false), p1 = __builtin_amdgcn_cvt_pk_f32_fp8((int)y.y, true); s1[0] += p0[0]; s1[1] += p0[1]; s1[2] += p1[0]; s1[3] += p1[1]; }
                { const f32x2 p0 = __builtin_amdgcn_cvt_pk_f32_fp8((int)y.z, false), p1 = __builtin_amdgcn_cvt_pk_f32_fp8((int)y.z, true); s2[0] += p0[0]; s2[1] += p0[1]; s2[2] += p1[0]; s2[3] += p1[1]; }
                { const f32x2 p0 = __builtin_amdgcn_cvt_pk_f32_fp8((int)y.w, false), p1 = __builtin_amdgcn_cvt_pk_f32_fp8((int)y.w, true); s3[0] += p0[0]; s3[1] += p0[1]; s3[2] += p1[0]; s3[3] += p1[1]; } }
            a0 += s0 * Y8_INV; a1 += s1 * Y8_INV; a2 += s2 * Y8_INV; a3 += s3 * Y8_INV;
            f32x4* op = (f32x4*)(F.out + (size_t)m * DM + 16 * F.lane); op[0] = a0; op[1] = a1; op[2] = a2; op[3] = a3; } }
        tp[0] = tn[0]; tp[1] = tn[1];
    }
}

#define LDS_TB ((const volatile LAS int*)(F.lds + LDSCTL_OFF))
#define LDS_CNT ((const volatile LAS int*)(F.lds + LDSCTL_OFF + 256))
__device__ __forceinline__ void ph1_inproj(Ctx& F) { p1_meta(F);
    pg8::Dense P; P.init(WSP(bf16, INPROJ_FP8 ? WS_XQ : WS_XN), WSP(bf16, WS_WIN), MT, NINP, INPROJ_FP8 ? DM / 2 : DM, F.G, (int)blockIdx.x);
    EpiInProj E{WSP(bf16, WS_HG), WSP(bf16, WS_QLAT), WSP(bf16, WS_KVLAT), WSP(bf16, WS_G), WSP(bf16, WS_G) + (size_t)MT * 1024, F.gate_b, WSP(float, WS_KPESS), WSP(float, WS_RSX), WSP(float, WS_RSQ), WSP(float, WS_RSC)};
    pg8::gemm_phase<pg8::Dense, EpiInProj, INPROJ_FP8 != 0>(F.lds, P, E); }
#ifndef PROBE_P3
#define PROBE_P3 0
#endif
__device__ __forceinline__ void ph3_smallgemms(Ctx& F) { p2_thin(F); p4_headnorm(F);
#if PROBE_P3 == 1
    __syncthreads(); p2_thin(F); p4_headnorm(F);
#endif
    { pg8::Dense P; P.init(WSP(bf16, WS_QLAT), WSP(bf16, WS_WQB), MT, 1024, 256, F.G, (int)blockIdx.x); EpiQHead E{WSP(bf16, WS_QF), WSP(float, WS_RSQ), F.q_nw, WSP(float, WS_ROPE), F.lds}; pg8::gemm_phase(F.lds, P, E); }
    { pg8::Dense P; P.init(WSP(bf16, WS_KVLAT), WSP(bf16, WS_WKVB), MT, 1024, 256, F.G, (int)blockIdx.x); EpiKVHead E{WSP(bf16, WS_KF), WSP(bf16, WS_KVRAW), WSP(bf16, WS_KVLAT), WSP(float, WS_RSC), WSP(float, WS_KPESS), F.k_nw, WSP(float, WS_ROPE), F.lds}; pg8::gemm_phase(F.lds, P, E); }
 }
__device__ __forceinline__ void ph6_wo(Ctx& F) { pg8::Dense P; P.init(WSP(bf16, WS_HCO), WSP(bf16, WS_W2T), MT, 1024, 1024, F.G, (int)blockIdx.x); EpiMix E{WSP(bf16, WS_MIX), WSP(bf16, WS_G), WSP(bf16, WS_G) + (size_t)MT * 1024}; pg8::gemm_phase<pg8::Dense, EpiMix, false, true>(F.lds, P, E); }
__device__ __forceinline__ void ph7_wout(Ctx& F) { pg8::Dense P; P.init(WSP(bf16, WS_MIX), WSP(bf16, WS_WOUT), MT, 1024, 1024, F.G, (int)blockIdx.x); EpiResid E{WSP(bf16, WS_XN), WSP(bf16, WS_H1B), WSP(unsigned char, WS_H1Q)}; pg8::gemm_phase<pg8::Dense, EpiResid, false, true>(F.lds, P, E); }
__device__ __forceinline__ void ph9_moe1(Ctx& F) { moe_table(F);
    pg8::Moe<true> P{WSP(bf16, WS_H1Q), WSP(bf16, WS_WGU), DM / 2, 8, F.G, F.vcu, WSP(int, WS_LTOK), LDS_TB, LDS_CNT};
    EpiSwiGLU E{WSP(unsigned char, WS_ACT), F.b_gu, WSP(float, WS_LRS), LDS_TB}; pg8::gemm_phase<pg8::Moe<true>, EpiSwiGLU, true>(F.lds, P, E); }
__device__ __forceinline__ void ph10_moe2(Ctx& F) {
#if !MK_ONE_LAUNCH
    moe_table(F);
#endif
    pg8::Moe<false> P{WSP(bf16, WS_ACT), WSP(bf16, WS_WD), DFF / 2, 4, F.G, F.vcu, nullptr, LDS_TB, LDS_CNT};
    EpiDown E{WSP(unsigned char, WS_Y), F.b_d, WSP(float, WS_LW), LDS_TB}; pg8::gemm_phase<pg8::Moe<false>, EpiDown, true, true>(F.lds, P, E); }
__device__ __forceinline__ void ph11_combine(Ctx& F) {
#if !MK_ONE_LAUNCH
    moe_table(F);
#endif
    p11_combine(F); }

struct Args { const float* in[25]; float* out; unsigned char* ws; int ph_lo, ph_hi; };
__global__ void __launch_bounds__(512, 2) mk_fwd(Args args) {
    extern __shared__ __attribute__((aligned(16))) unsigned char lds_raw[];
    Ctx F;
    F.lds = (LAS unsigned char*)lds_raw; F.ws = args.ws; F.ctl = (gu32*)(args.ws + WS_CTL);
    F.tid = threadIdx.x; F.lane = F.tid & 63; F.wave = __builtin_amdgcn_readfirstlane(F.tid >> 6);
    F.G = gridDim.x; { const int bx = blockIdx.x; F.vcu = (F.G % 8 == 0) ? (bx % 8) * (F.G / 8) + bx / 8 : bx; }
    F.x = args.in[0]; F.meta = args.in[1]; F.attn_nw = args.in[2]; F.w_in = args.in[3]; F.dw_w = args.in[4]; F.dw_b = args.in[5]; F.ln_w = args.in[6]; F.ln_b = args.in[7]; F.pw2_w = args.in[8];
    F.qa_nw = args.in[9]; F.w_qb = args.in[10]; F.kva_nw = args.in[11]; F.w_kvb = args.in[12]; F.q_nw = args.in[13]; F.k_nw = args.in[14]; F.w_o = args.in[15]; F.gate_b = args.in[16]; F.w_out = args.in[17];
    F.ffn_nw = args.in[18]; F.router_w = args.in[19]; F.router_b = args.in[20]; F.w_gu = args.in[21]; F.b_gu = args.in[22]; F.w_d = args.in[23]; F.b_d = args.in[24]; F.out = args.out;
    for (int u = F.tid; u < (LDS_BYTES - LDSCTL_OFF) / 4; u += 512) ((LAS unsigned*)(F.lds + LDSCTL_OFF))[u] = 0u;
    __syncthreads();
    const int lo = args.ph_lo, hi = args.ph_hi;
    XcdBarrier bar; bar.bar = (unsigned*)(F.ctl + CW_BAR); bar.x = 0; bar.st = nullptr;
    if (hi - lo > 1) bar = xcd_barrier_post((unsigned*)(F.ctl + CW_BAR), (volatile LAS unsigned*)(F.lds + LDSCTL_OFF + 512));
#ifdef ONLY_PHASE
#define IN(k) ((k) == ONLY_PHASE && lo <= (k) && (k) < hi)
#else
#define IN(k) (lo <= (k) && (k) < hi)
#endif
#define SEAM(k) do { if (IN(k) && IN((k) + 1)) xcd_barrier(bar); } while (0)
#if USE_REFRESH
#define REFRESH() do { int _t = threadIdx.x; asm volatile("" : "+v"(_t)); F.tid = _t; F.lane = _t & 63; F.wave = __builtin_amdgcn_readfirstlane(_t >> 6); } while (0)
#else
#define REFRESH() do { } while (0)
#endif
#define PHASE(k, call) do { if (IN(k)) { REFRESH(); call; if (PROBE_REPEAT == (k)) { xcd_barrier(bar); call; } } SEAM(k); } while (0)

    PHASE(0, p0_prologue(F));
    PHASE(1, ph1_inproj(F));
    PHASE(3, ph3_smallgemms(F));
    PHASE(5, att::attn_phase(F));
    PHASE(6, ph6_wo(F));
    PHASE(7, ph7_wout(F));
#if PROBE_REPEAT == 8
    if (IN(8)) { REFRESH(); p8_router(F); xcd_barrier(bar); if (blockIdx.x == 0 && F.tid < NE) ((int*)(F.ctl + CW_CNT))[F.tid] = 0; xcd_barrier(bar); p8_router(F); } SEAM(8);
#else
    PHASE(8, p8_router(F));
#endif
    PHASE(9, ph9_moe1(F));
    PHASE(10, ph10_moe2(F));
    PHASE(11, ph11_combine(F));
#undef IN
#undef SEAM
#undef PHASE
}

extern "C" void kernel_launch(void* const* d_in, const int* in_sizes, int n_in, void* d_out, int out_size, void* d_ws, size_t ws_size, hipStream_t stream) {
    static int grid = 0;
    if (grid == 0) {
        if (n_in != 25 || in_sizes[0] != MT * DM || out_size != MT * DM || ws_size < WS_END) { fprintf(stderr, "kernel_launch: unexpected shapes (n_in %d, in0 %d, out %d, ws %zu < %zu); nothing launched\n", n_in, n_in > 0 ? in_sizes[0] : -1, out_size, ws_size, (size_t)WS_END); grid = -1; return; }
        int dev = 0, cus = 0, per_cu = 0;
        if (hipGetDevice(&dev) != hipSuccess || hipDeviceGetAttribute(&cus, hipDeviceAttributeMultiprocessorCount, dev) != hipSuccess) { grid = -1; return; }
        if (hipFuncSetAttribute((const void*)mk_fwd, hipFuncAttributeMaxDynamicSharedMemorySize, LDS_BYTES) != hipSuccess) { fprintf(stderr, "kernel_launch: hipFuncSetAttribute failed\n"); grid = -1; return; }
        if (hipOccupancyMaxActiveBlocksPerMultiprocessor(&per_cu, (const void*)mk_fwd, 512, LDS_BYTES) != hipSuccess || per_cu < 1) fprintf(stderr, "kernel_launch: note: occupancy query reports %d\n", per_cu);
        (void)hipGetLastError();
        grid = cus;
    }
    if (grid < 0) return;
    if (hipMemsetAsync((char*)d_ws + WS_CTL, 0, CTL_ZERO_BYTES, stream) != hipSuccess) return;
    Args a{};
    for (int i = 0; i < 25; ++i) a.in[i] = (const float*)d_in[i];
    a.out = (float*)d_out; a.ws = (unsigned char*)d_ws;
#if MK_ONE_LAUNCH
    a.ph_lo = 0; a.ph_hi = NPH;
    hipLaunchKernelGGL(mk_fwd, dim3(grid), dim3(512), LDS_BYTES, stream, a);
#else
    for (int p = 0; p < NPH; ++p) { a.ph_lo = p; a.ph_hi = p + 1; hipLaunchKernelGGL(mk_fwd, dim3(grid), dim3(512), LDS_BYTES, stream, a); }
#endif
}
```

```cpp
#include <hip/hip_runtime.h>
#include <cstdio>
#include <cstdint>

#define GAS __attribute__((address_space(1)))
#define LAS __attribute__((address_space(3)))
typedef unsigned short bf16;
typedef unsigned u32x4 __attribute__((ext_vector_type(4)));
typedef unsigned u32x2 __attribute__((ext_vector_type(2)));
typedef float f32x2 __attribute__((ext_vector_type(2)));
typedef float f32x4 __attribute__((ext_vector_type(4)));
typedef float f32x16 __attribute__((ext_vector_type(16)));
typedef short bf16x8 __attribute__((ext_vector_type(8)));
typedef short s16x4 __attribute__((ext_vector_type(4)));
typedef int i32x4 __attribute__((ext_vector_type(4)));
typedef int i32x8 __attribute__((ext_vector_type(8)));
typedef GAS unsigned gu32;

#ifndef PROBE_REPEAT
#define PROBE_REPEAT (-1)
#endif
#ifndef INPROJ_FP8
#define INPROJ_FP8 1
#endif
#ifndef PROBE_KLOOP2
#define PROBE_KLOOP2 0
#endif
#ifndef USE_REFRESH
#define USE_REFRESH 0
#endif
#ifndef RELAX_WAITS
#define RELAX_WAITS 0
#endif
#ifndef PROBE_EPI2
#define PROBE_EPI2 0
#endif
#ifndef PROBE_P2A
#define PROBE_P2A 0
#endif
#ifndef PROBE_P2B
#define PROBE_P2B 0
#endif
#ifndef MK_ONE_LAUNCH
#define MK_ONE_LAUNCH 1
#endif

constexpr int NB = 8, SEQ = 4096, DM = 1024, MT = NB * SEQ;
constexpr int NMETA = 16;
constexpr int CDIM = 512, CWID = 31;
constexpr int NH = 8, DNOPE = 64, DROPE = 32, DQK = 96, DV = 64, QLR = 256, KVLR = 128;
constexpr int INC = 3488, NINP = 3584;
constexpr int NE = 32, DFF = 1024, ECAP = 32768;
constexpr int LPC = 4128, HGOFF = 32;
constexpr int LPK = 4160, KOFF = 64;
constexpr int PMC = 1184;
constexpr float NORM_EPS = 1e-6f;
constexpr float SW_LIMIT = 7.0f, SW_ALPHA = 1.702f;
constexpr float QSCALE = 0.10206207261596577f * 1.4426950408889634f;
constexpr int NPH = 12;

constexpr size_t MiB = 1u << 20;
constexpr size_t WS_CTL = 0, CTL_ZERO_BYTES = 1 * MiB;
constexpr int CW_TMO = 0, CW_CODE = 1, CW_BAR = 4096, CW_CNT = 8192, CW_PM = 16384;
constexpr size_t WS_METARS = 1 * MiB;
constexpr size_t WS_KVMETA = 1 * MiB + 4096;
constexpr size_t WS_ROPE = 1 * MiB + 512 * 1024;
constexpr size_t WS_RSQ = 156 * MiB, WS_RSC = 157 * MiB;
constexpr size_t WS_KPESS = 2 * MiB + 384 * 1024;
constexpr size_t WS_RWP = 2 * MiB + 512 * 1024;
constexpr size_t WS_RW3 = 2 * MiB + 768 * 1024;
constexpr size_t WS_TOKPOS = 3 * MiB;
constexpr size_t WS_LTOK = 4 * MiB, WS_LW = 8 * MiB, WS_LRS = 12 * MiB;
constexpr size_t WS_WIN = 16 * MiB, WS_WPW2 = 23 * MiB, WS_WQB = 24 * MiB, WS_WKVB = 24 * MiB + 512 * 1024, WS_WO = 25 * MiB, WS_WOUT = 26 * MiB;
constexpr size_t WS_WGU = 28 * MiB, WS_WD = 92 * MiB;
constexpr size_t WS_XQ = 124 * MiB;
constexpr float XQ_SCALE = 16.f;
constexpr size_t WS_H1Q = 124 * MiB;
constexpr size_t WS_W2T = 220 * MiB, WS_H1B = 348 * MiB;
constexpr size_t WS_BIG = 412 * MiB;
constexpr size_t WS_ACT = WS_BIG, WS_Y = WS_BIG + 273 * MiB;
constexpr size_t WS_XN = WS_BIG + 289 * MiB, WS_QF = WS_BIG;
constexpr size_t WS_RSX = 2 * MiB + 640 * 1024;
constexpr size_t WS_G = WS_BIG + 64 * MiB, WS_HG = WS_BIG + 192 * MiB, WS_MIX = WS_BIG + 192 * MiB;
constexpr size_t WS_QLAT = WS_BIG + 225 * MiB, WS_KVLAT = WS_BIG + 241 * MiB, WS_HC = WS_BIG + 257 * MiB;
constexpr size_t WS_QRAW = WS_BIG + 289 * MiB, WS_KVRAW = WS_BIG + 353 * MiB, WS_HCO = WS_BIG + 418 * MiB, WS_KF = WS_BIG + 482 * MiB;
constexpr size_t WS_PMP = WS_BIG + 564 * MiB, WS_PMF = WS_BIG + 565 * MiB;
constexpr size_t WS_END = WS_BIG + 566 * MiB;
static_assert(WS_Y + (size_t)139520 * 2048 <= WS_END && WS_HG + (size_t)NB * LPC * CDIM * 2 <= WS_QLAT && WS_KVRAW + (size_t)NB * LPK * 2048 <= WS_HCO && WS_KF + (size_t)NB * LPK * 1536 <= WS_BIG + 531 * MiB, "ws map");

constexpr int RING_BYTES = 131072;
constexpr int LDSCTL_OFF = RING_BYTES;
constexpr int LDS_BYTES = 147456;

#define RLX_AGENT __ATOMIC_RELAXED, __HIP_MEMORY_SCOPE_AGENT
#define LDS_WAIT() asm volatile("s_waitcnt lgkmcnt(0)" ::: "memory")
#define VM_WAIT() asm volatile("s_waitcnt vmcnt(0)" ::: "memory")
__device__ __forceinline__ unsigned f2bf(float f) { unsigned u = __builtin_bit_cast(unsigned, f); return (u + 0x7fffu + ((u >> 16) & 1u)) >> 16; }
typedef __bf16 hwbf16x2 __attribute__((ext_vector_type(2)));
__device__ __forceinline__ unsigned pk2(float lo, float hi) { const f32x2 v = {lo, hi}; return __builtin_bit_cast(unsigned, __builtin_convertvector(v, hwbf16x2)); }
__device__ __forceinline__ float bflo(unsigned w) { return __builtin_bit_cast(float, w << 16); }
__device__ __forceinline__ float bfhi(unsigned w) { return __builtin_bit_cast(float, w & 0xffff0000u); }
constexpr float Y8_SCALE = 8.f, Y8_INV = 1.f / 8.f;
constexpr float W8_SCALE = 64.f, W8_INV = 1.f / 64.f;
__device__ __forceinline__ unsigned pk4_fp8(float a, float b, float c, float d) { int v = __builtin_amdgcn_cvt_pk_fp8_f32(a, b, 0, false); v = __builtin_amdgcn_cvt_pk_fp8_f32(c, d, v, true); return (unsigned)v; }
__device__ __forceinline__ float sigmoid_f(float x) { return __builtin_amdgcn_rcpf(1.f + __expf(-x)); }
__device__ __forceinline__ float sum16(float v) {
#pragma unroll
    for (int o = 1; o < 16; o <<= 1) v += __shfl_xor(v, o);
    return v;
}
__device__ __forceinline__ float wave_sum(float v) {
#pragma unroll
    for (int o = 1; o < 64; o <<= 1) v += __shfl_xor(v, o);
    return v;
}

#define XB_TMO      128
#define XB_XCNT(j)  (256  + 64 * (j))
#define XB_XSUB(j)  (1280 + 64 * (j))
#define XB_XGEN(j)  (2304 + 64 * (j))
#define XB_TOP      3328
#define XB_TOPGEN   3392
#define XCD_BAR_WORDS 3456
#define XB_SPIN_CAP (1u << 18)
__device__ __forceinline__ unsigned xb_ld(unsigned* p)              { return __hip_atomic_load(p, __ATOMIC_RELAXED, __HIP_MEMORY_SCOPE_AGENT); }
__device__ __forceinline__ unsigned xb_add(unsigned* p, unsigned v) { return __hip_atomic_fetch_add(p, v, __ATOMIC_RELAXED, __HIP_MEMORY_SCOPE_AGENT); }
__device__ __forceinline__ unsigned xb_xcc_id() { return (unsigned)__builtin_amdgcn_s_getreg((3 << 11) | 20) & 0xFu; }
#define XB_SPIN(cond, bar) do { unsigned _sp = 0; while (cond) { __builtin_amdgcn_s_sleep(1); \
    if ((++_sp & 255u) == 0u) { if (xb_ld(&(bar)[XB_TMO])) break; if (_sp > XB_SPIN_CAP) { atomicAdd(&(bar)[XB_TMO], 1u); break; } } } } while (0)
struct XcdBarrier { unsigned* bar; unsigned x; volatile LAS unsigned* st; };
__device__ __forceinline__ XcdBarrier xcd_barrier_post(unsigned* bar, volatile LAS unsigned* st) {
    XcdBarrier b; b.bar = bar; b.x = xb_xcc_id(); b.st = st;
    if (threadIdx.x == 0) (void)xb_add(&bar[XB_XCNT(b.x)], 1u);
    return b;
}
__device__ __forceinline__ void xcd_barrier_complete(unsigned* bar, unsigned x, unsigned& nloc, unsigned& nx) {
    const unsigned G = gridDim.x * gridDim.y * gridDim.z;
    unsigned sum, cnt, mine, sp = 0u;
    for (;;) {
        sum = 0u; cnt = 0u; mine = 0u;
#pragma unroll
        for (unsigned j = 0; j < 16; ++j) { const unsigned c = xb_ld(&bar[XB_XCNT(j)]); sum += c; cnt += (c > 0u) ? 1u : 0u; mine = (j == x) ? c : mine; }
        if (sum == G) break;
        __builtin_amdgcn_s_sleep(1);
        if ((++sp & 255u) == 0u) { if (xb_ld(&bar[XB_TMO])) break; if (sp > XB_SPIN_CAP) { atomicAdd(&bar[XB_TMO], 1u); break; } }
    }
    nloc = mine > 0u ? mine : 1u; nx = cnt > 0u ? cnt : 1u;
}
__device__ __forceinline__ void xcd_barrier(const XcdBarrier& b) {
    asm volatile("s_waitcnt vmcnt(0)" ::: "memory");
    __syncthreads();
    if (threadIdx.x == 0) {
        unsigned* bar = b.bar;
        __builtin_amdgcn_s_waitcnt(0);
        unsigned nloc = b.st[0], nx = b.st[1];
        if (nloc == 0u) { xcd_barrier_complete(bar, b.x, nloc, nx); b.st[0] = nloc; b.st[1] = nx; }
        const unsigned old = xb_add(&bar[XB_XSUB(b.x)], 1u);
        const unsigned gen = old / nloc;
        if (old + 1u == (gen + 1u) * nloc) {
            __builtin_amdgcn_fence(__ATOMIC_RELEASE, "agent");
            asm volatile("s_waitcnt vmcnt(0)" ::: "memory");
            const unsigned og = xb_add(&bar[XB_TOP], 1u);
            const unsigned tg = og / nx;
            if (og + 1u == (tg + 1u) * nx) xb_add(&bar[XB_TOPGEN], 1u);
            else XB_SPIN(xb_ld(&bar[XB_TOPGEN]) == tg, bar);
            xb_add(&bar[XB_XGEN(b.x)], 1u);
            __builtin_amdgcn_fence(__ATOMIC_ACQUIRE, "agent");
            asm volatile("s_waitcnt vmcnt(0)" ::: "memory");
        } else {
            XB_SPIN(xb_ld(&bar[XB_XGEN(b.x)]) == gen, bar);
            __builtin_amdgcn_fence(__ATOMIC_ACQUIRE, "agent");
            asm volatile("s_waitcnt vmcnt(0)" ::: "memory");
        }
    }
    __syncthreads();
}

namespace pg8 {
constexpr int BM = 256, BK = 64, HALF = 128, HTB = HALF * BK * 2, NXCD = 8, WGM = 8;
__host__ __device__ __forceinline__ int lds_byte(int r, int c) { const int st = (r >> 4) * 2 + (c >> 5), rr = r & 15, cc = c & 31, ob = rr * 64 + cc * 2; return st * 1024 + (ob ^ (((ob >> 9) & 1) << 5)); }
__host__ __device__ __forceinline__ void stage_rc(int b, int& R, int& C) { const int st = b / 1024, sb = b % 1024, swz = sb ^ (((sb >> 9) & 1) << 5); R = (st >> 1) * 16 + swz / 64; C = (st & 1) * 32 + (swz % 64) / 2; }
__host__ __device__ __forceinline__ int perm32(int rho) { const int n = rho >> 4, i = rho & 15; return 8 * (i >> 2) + 4 * n + (i & 3); }

struct Unit { int pm, pn, e, cnt; };

struct Dense {
    static constexpr bool GATHER = false;
    const bf16* A; const bf16* Bt; int K; int nM, nN, nwg, G, c;
    __device__ __forceinline__ void init(const bf16* A_, const bf16* Bt_, int M, int N, int K_, int G_, int c_) { A = A_; Bt = Bt_; K = K_; nM = M / BM; nN = N / BM; nwg = nM * nN; G = G_; c = c_; }
    __device__ __forceinline__ bool next(int i, Unit& u) const {
        const long L = (long)i * G + c; if (L >= nwg) return false;
        int wgid = (int)L; { const int q = nwg / NXCD, r = nwg % NXCD, xcd = wgid % NXCD, off = wgid / NXCD; wgid = (xcd < r ? xcd * (q + 1) : r * (q + 1) + (xcd - r) * q) + off; }
        const int nig = WGM * nN, gid = wgid / nig, fm = gid * WGM, gsz = (nM - fm) < WGM ? (nM - fm) : WGM;
        u.pm = fm + ((wgid % nig) % gsz); u.pn = (wgid % nig) / gsz; u.e = 0; u.cnt = 256; return true;
    }
    __device__ __forceinline__ const char* a_base(const Unit& u) const { return (const char*)A + (size_t)u.pm * BM * K * 2; }
    __device__ __forceinline__ const char* b_base(const Unit& u) const { return (const char*)Bt + (size_t)u.pn * BM * K * 2; }
    __device__ __forceinline__ void a_off(const Unit&, const int (&R)[2], const int (&C)[2], unsigned (&vo)[2][2]) const {
#pragma unroll
        for (int h = 0; h < 2; ++h)
#pragma unroll
            for (int i = 0; i < 2; ++i) vo[h][i] = (unsigned)((R[i] + HALF * h) * K + C[i]) * 2u;
    }
};

template <bool GATHER_> struct Moe {
    static constexpr bool GATHER = GATHER_;
    const bf16* A; const bf16* Bt; int K, nN, G, vcu; const int* ltok; const volatile LAS int* tb; const volatile LAS int* cnt;
    __device__ __forceinline__ bool next(int i, Unit& u) const {
        const int L = i * G + vcu; const int TT = __builtin_amdgcn_readfirstlane(tb[NE]); if (L >= TT * nN) return false;
        const int mt = L / nN; u.pn = L - mt * nN;
        const int e = __builtin_amdgcn_readfirstlane(tb[512 + mt]);
        u.e = e; u.pm = mt; const int rem = __builtin_amdgcn_readfirstlane(cnt[e]) - (mt - __builtin_amdgcn_readfirstlane(tb[e])) * BM; u.cnt = rem < BM ? rem : BM; return true;
    }
    __device__ __forceinline__ const char* a_base(const Unit& u) const { return GATHER ? (const char*)A : (const char*)A + (size_t)u.pm * BM * K * 2; }
    __device__ __forceinline__ const char* b_base(const Unit& u) const { return (const char*)Bt + ((size_t)u.e * nN + u.pn) * BM * K * 2; }
    __device__ __forceinline__ const int* idx_src(const Unit& u) const { return ltok + (size_t)u.e * ECAP + (u.pm - __builtin_amdgcn_readfirstlane(tb[u.e])) * BM; }
    __device__ __forceinline__ void a_idx(const Unit& u, const int (&R)[2], int (&tk)[2][2]) const {
        const int slot0 = (u.pm - __builtin_amdgcn_readfirstlane(tb[u.e])) * BM; const int* lt = ltok + (size_t)u.e * ECAP + slot0;
        const unsigned o0 = (unsigned)R[0] * 4u, o1 = (unsigned)R[1] * 4u;
        asm volatile("global_load_dword %0, %4, %6\n\tglobal_load_dword %1, %5, %6\n\tglobal_load_dword %2, %4, %6 offset:512\n\tglobal_load_dword %3, %5, %6 offset:512"
                     : "=&v"(tk[0][0]), "=&v"(tk[0][1]), "=&v"(tk[1][0]), "=&v"(tk[1][1]) : "v"(o0), "v"(o1), "s"(lt) : "memory");
    }
    __device__ __forceinline__ void a_fin(const Unit& u, const int (&R)[2], const int (&C)[2], int (&tk)[2][2], unsigned (&vo)[2][2]) const {
        asm volatile("" : "+v"(tk[0][0]), "+v"(tk[0][1]), "+v"(tk[1][0]), "+v"(tk[1][1]));
#pragma unroll
        for (int h = 0; h < 2; ++h)
#pragma unroll
            for (int i = 0; i < 2; ++i) { const int r = R[i] + HALF * h; const int tok = (r < u.cnt) ? tk[h][i] : 0; vo[h][i] = (unsigned)(tok * K + C[i]) * 2u; }
    }
    __device__ __forceinline__ void a_off(const Unit& u, const int (&R)[2], const int (&C)[2], unsigned (&vo)[2][2]) const {
        if constexpr (GATHER) {
            const int slot0 = (u.pm - __builtin_amdgcn_readfirstlane(tb[u.e])) * BM; const int* lt = ltok + (size_t)u.e * ECAP + slot0; int tk[2][2];
#pragma unroll
            for (int h = 0; h < 2; ++h)
#pragma unroll
                for (int i = 0; i < 2; ++i) tk[h][i] = lt[R[i] + HALF * h];
            asm volatile("" : "+v"(tk[0][0]), "+v"(tk[0][1]), "+v"(tk[1][0]), "+v"(tk[1][1]));
#pragma unroll
            for (int h = 0; h < 2; ++h)
#pragma unroll
                for (int i = 0; i < 2; ++i) { const int r = R[i] + HALF * h; const int tok = (r < u.cnt) ? tk[h][i] : 0; vo[h][i] = (unsigned)(tok * K + C[i]) * 2u; }
        } else {
#pragma unroll
            for (int h = 0; h < 2; ++h)
#pragma unroll
                for (int i = 0; i < 2; ++i) vo[h][i] = (unsigned)((R[i] + HALF * h) * K + C[i]) * 2u;
        }
    }
};

template <class Prob, class Epi, bool FP8 = false, bool ADJ = false>
__device__ __forceinline__ void gemm_phase(LAS unsigned char* lds, const Prob& P, const Epi& E) {
    const int tid = threadIdx.x, wid = __builtin_amdgcn_readfirstlane(tid >> 6), lane = tid & 63, wr = wid >> 2, wc = wid & 3, fr = lane & 15, fq = lane >> 4;
    const int K = P.K, nt = K / BK;
    constexpr bool PRE11 = RELAX_WAITS && !Epi::LDSX;
    int Rr[2], Cc[2]; unsigned voffB[2];
#pragma unroll
    for (int i = 0; i < 2; ++i) { int R, C; stage_rc(tid * 16 + i * 8192, R, C); const int rho = R & 31;
        const int Rb = ADJ ? (64 * (R >> 5) + 16 * ((rho >> 2) & 3) + 4 * (rho >> 4) + (rho & 3)) : ((R & ~31) + perm32(rho)); Rr[i] = R; Cc[i] = C; voffB[i] = (unsigned)(Rb * K + C) * 2u; }
    const size_t kstep = (size_t)(BK * 2);
    const size_t hstep = (size_t)(ADJ ? 8 : HALF) * K * 2;
    const unsigned ldsw = (unsigned)wid * 1024u;
    const int aoff = lds_byte(wr * 64 + fr, fq * 8), boff = lds_byte(wc * 32 + fr, fq * 8);
#define PG8_SA(b, h) (((b) * 2 + (h)) * HTB)
#define PG8_SB(b, h) ((4 + (b) * 2 + (h)) * HTB)
#define PG8_STAGE(bufoff, gbase, voff) do { const char* _g = (const char*)(gbase); asm volatile("" : "+s"(_g));     \
        _Pragma("unroll") for (int _i = 0; _i < 2; ++_i) \
        __builtin_amdgcn_global_load_lds((const unsigned*)(_g + (voff)[_i]), (LAS unsigned*)(lds + (bufoff) + ldsw + _i * 8192), 16, 0, 0); } while (0)
#define PG8_LD8(addr) __builtin_shufflevector(*(const LAS i32x4*)(addr), *(const LAS i32x4*)((addr) + 1024), 0, 1, 2, 3, 4, 5, 6, 7)
#define PG8_LDA(dst, b, h) do { _Pragma("unroll") for (int m = 0; m < 4; ++m) dst[m] = PG8_LD8(lds + PG8_SA(b, h) + aoff + m * 2048); } while (0)
#define PG8_LDB(dst, b, h) do { _Pragma("unroll") for (int n = 0; n < 2; ++n) dst[n] = PG8_LD8(lds + PG8_SB(b, h) + boff + n * 2048); } while (0)
#define PG8_LO(x) __builtin_bit_cast(bf16x8, __builtin_shufflevector(x, x, 0, 1, 2, 3))
#define PG8_HI(x) __builtin_bit_cast(bf16x8, __builtin_shufflevector(x, x, 4, 5, 6, 7))
#define PG8_MMA(ai, bj, At, Bt) do { __builtin_amdgcn_s_setprio(1); _Pragma("unroll") for (int m = 0; m < 4; ++m) _Pragma("unroll") for (int n = 0; n < 2; ++n) { \
        if constexpr (FP8) asm volatile("v_mfma_scale_f32_16x16x128_f8f6f4 %0, %1, %2, %0, %3, %3 op_sel_hi:[0,0,0]" : "+v"(acc[ai][bj][m][n]) : "v"(Bt[n]), "v"(At[m]), "v"(one_scale)); \
        else { acc[ai][bj][m][n] = __builtin_amdgcn_mfma_f32_16x16x32_bf16(PG8_LO(Bt[n]), PG8_LO(At[m]), acc[ai][bj][m][n], 0, 0, 0); \
               acc[ai][bj][m][n] = __builtin_amdgcn_mfma_f32_16x16x32_bf16(PG8_HI(Bt[n]), PG8_HI(At[m]), acc[ai][bj][m][n], 0, 0, 0); } } \
        __builtin_amdgcn_s_setprio(0); } while (0)
#define PG8_MMA_Z(ai, bj, At, Bt) do { __builtin_amdgcn_s_setprio(1); _Pragma("unroll") for (int m = 0; m < 4; ++m) _Pragma("unroll") for (int n = 0; n < 2; ++n) \
        asm volatile("v_mfma_scale_f32_16x16x128_f8f6f4 %0, %1, %2, 0, %3, %3 op_sel_hi:[0,0,0]" : "=&v"(acc[ai][bj][m][n]) : "v"(Bt[n]), "v"(At[m]), "v"(one_scale)); \
        __builtin_amdgcn_s_setprio(0); } while (0)
#define PG8_MMA2(ai, At, B0, B1) do { if constexpr (FP8) { if (zfirst) { PG8_MMA_Z(ai, 0, At, B0); PG8_MMA_Z(ai, 1, At, B1); } else { PG8_MMA(ai, 0, At, B0); PG8_MMA(ai, 1, At, B1); } } else { PG8_MMA(ai, 0, At, B0); PG8_MMA(ai, 1, At, B1); } } while (0)
#define PG8_WAIT_V(n) asm volatile("s_waitcnt vmcnt(" #n ")" ::: "memory")
#define PG8_WAIT_L(n) asm volatile("s_waitcnt lgkmcnt(" #n ")" ::: "memory")
#define PG8_BAR __builtin_amdgcn_s_barrier()
#define PG8_SCHED __builtin_amdgcn_sched_barrier(0)
    Unit cur, nxt; int ui = 0;
    if (!P.next(0, cur)) return;
    f32x4 acc[2][2][4][2];
    if constexpr (!FP8) {
#pragma unroll
    for (int a = 0; a < 2; ++a)
#pragma unroll
        for (int b = 0; b < 2; ++b)
#pragma unroll
            for (int m = 0; m < 4; ++m)
#pragma unroll
                for (int n = 0; n < 2; ++n) acc[a][b][m][n] = (f32x4){0.f, 0.f, 0.f, 0.f}; }
    int one_scale = 0x7f7f7f7f; asm volatile("" : "+v"(one_scale));
    i32x8 At[4], B0[2], B1[2];
    unsigned vc[2][2], vn[2][2];
    P.a_off(cur, Rr, Cc, vc);
    const char* cA = P.a_base(cur); const char* cB = P.b_base(cur);
    PG8_STAGE(PG8_SB(0, 0), cB, voffB); PG8_STAGE(PG8_SB(0, 1), cB + hstep, voffB); PG8_STAGE(PG8_SA(0, 0), cA, vc[0]); PG8_STAGE(PG8_SA(0, 1), cA, vc[1]);
    if (wr == 1) PG8_BAR;
    PG8_WAIT_V(2); PG8_BAR;
    PG8_STAGE(PG8_SB(1, 0), cB + kstep, voffB); PG8_STAGE(PG8_SA(1, 0), cA + kstep, vc[0]); PG8_STAGE(PG8_SB(1, 1), cB + hstep + kstep, voffB);
    PG8_WAIT_V(6); PG8_BAR;
    for (;;) {
        const bool has_next = P.next(ui + 1, nxt);
        const char* nA = has_next ? P.a_base(nxt) : cA; const char* nB = has_next ? P.b_base(nxt) : cB;
        int tkr[2][2] = {{0, 0}, {0, 0}};
        if constexpr (Prob::GATHER) { if (has_next) P.a_idx(nxt, Rr, tkr); }
#pragma unroll
        for (int h = 0; h < 2; ++h)
#pragma unroll
            for (int i = 0; i < 2; ++i) vn[h][i] = vc[h][i];
        if constexpr (Prob::GATHER) { if (nt < 6 && has_next) { PG8_WAIT_V(0); P.a_fin(nxt, Rr, Cc, tkr, vn); } }
        const bool post = ui > 0;
#if PROBE_KLOOP2
        const int ntt = ((PROBE_KLOOP2 == 1 && FP8) || (PROBE_KLOOP2 == 2 && !FP8 && nt == 16)) ? 2 * nt : nt;
#else
        const int ntt = nt;
#endif
        for (int t = 0; t < ntt; t += 2) {
#if PROBE_KLOOP2
            if (t == nt) {
#pragma unroll
                for (int a = 0; a < 2; ++a)
#pragma unroll
                    for (int b = 0; b < 2; ++b)
#pragma unroll
                        for (int m = 0; m < 4; ++m)
#pragma unroll
                            for (int n = 0; n < 2; ++n) acc[a][b][m][n] = (f32x4){0.f, 0.f, 0.f, 0.f};
            }
            const int tq = t >= nt ? t - nt : t;
#else
            const int tq = t;
#endif
            if constexpr (Epi::MID) { if (tq == nt / 2) { int l2 = 0; asm volatile("" : "+v"(l2)); l2 = (int)__builtin_amdgcn_mbcnt_hi(~0u, __builtin_amdgcn_mbcnt_lo(~0u, (unsigned)l2)); E.mid(acc, cur, wr, wc, l2 & 15, l2 >> 4); } }
            const bool last = (t == ntt - 2);
            const int tq2 = (tq + 2 == nt) ? 0 : tq + 2;
            const char* a1 = cA + (size_t)(tq + 1) * kstep;
            const char* a2 = last ? nA : cA + (size_t)tq2 * kstep; const char* b2 = last ? nB : cB + (size_t)tq2 * kstep;
            const char* a3 = a2 + kstep; const char* b3 = b2 + kstep;
            unsigned w0[2], w1[2];
            if constexpr (Prob::GATHER) { w0[0] = last ? vn[0][0] : vc[0][0]; w0[1] = last ? vn[0][1] : vc[0][1]; w1[0] = last ? vn[1][0] : vc[1][0]; w1[1] = last ? vn[1][1] : vc[1][1]; }
            else { w0[0] = vc[0][0]; w0[1] = vc[0][1]; w1[0] = vc[1][0]; w1[1] = vc[1][1]; }
            int tz = t; asm volatile("" : "+s"(tz));
            const bool relax = PRE11 && post && tz == 0;
            int tzq = tq; asm volatile("" : "+s"(tzq)); const bool zfirst = (tzq == 0);
            PG8_LDB(B0, 0, 0); PG8_LDB(B1, 0, 1); PG8_SCHED; PG8_LDA(At, 0, 0); if (!relax) PG8_STAGE(PG8_SA(1, 1), a1, vc[1]);
            if (!relax) PG8_WAIT_V(8); PG8_WAIT_L(0); PG8_BAR; PG8_MMA2(0, At, B0, B1); PG8_BAR; PG8_SCHED;
            PG8_LDA(At, 0, 1); PG8_STAGE(PG8_SB(0, 0), b2, voffB); PG8_STAGE(PG8_SB(0, 1), b2 + hstep, voffB); PG8_STAGE(PG8_SA(0, 0), a2, w0);
            if (!relax) PG8_WAIT_V(8); PG8_WAIT_L(0); PG8_BAR; PG8_MMA2(1, At, B0, B1); PG8_BAR; PG8_SCHED;
            PG8_LDB(B0, 1, 0); PG8_LDB(B1, 1, 1); PG8_SCHED; PG8_LDA(At, 1, 0); PG8_STAGE(PG8_SA(0, 1), a2, w1);
            if (!relax) PG8_WAIT_V(8); PG8_WAIT_L(0); PG8_BAR; PG8_MMA(0, 0, At, B0); PG8_MMA(0, 1, At, B1); PG8_BAR; PG8_SCHED;
            PG8_LDA(At, 1, 1); PG8_STAGE(PG8_SB(1, 0), b3, voffB); PG8_STAGE(PG8_SB(1, 1), b3 + hstep, voffB); PG8_STAGE(PG8_SA(1, 0), a3, w0);
            PG8_WAIT_V(8); PG8_WAIT_L(0); PG8_BAR; PG8_MMA(1, 0, At, B0); PG8_MMA(1, 1, At, B1); PG8_BAR; PG8_SCHED;
            if constexpr (Prob::GATHER) { if (nt >= 6 && t + 4 == ntt && has_next) P.a_fin(nxt, Rr, Cc, tkr, vn); }
        }
        if (wr == 0) PG8_BAR;
        if constexpr (PRE11) PG8_STAGE(PG8_SA(1, 1), nA + kstep, vn[1]);
        if constexpr (FP8) asm volatile("s_nop 15\n\ts_nop 3" ::: "memory");
        { int l2 = 0; asm volatile("" : "+v"(l2)); l2 = (int)__builtin_amdgcn_mbcnt_hi(~0u, __builtin_amdgcn_mbcnt_lo(~0u, (unsigned)l2));
          E(acc, cur, wr, wc, l2 & 15, l2 >> 4);
#if PROBE_EPI2
          if ((PROBE_EPI2 == 1 && FP8) || (PROBE_EPI2 == 2 && !FP8 && P.nN == 14)) { int l3 = threadIdx.x & 63; asm volatile("" : "+v"(l3)); E(acc, cur, wr, wc, l3 & 15, l3 >> 4); }
#endif
        }
        if (!has_next) break;
        if constexpr (!FP8) {
#pragma unroll
        for (int a = 0; a < 2; ++a)
#pragma unroll
            for (int b = 0; b < 2; ++b)
#pragma unroll
                for (int m = 0; m < 4; ++m)
#pragma unroll
                    for (int n = 0; n < 2; ++n) acc[a][b][m][n] = (f32x4){0.f, 0.f, 0.f, 0.f}; }
        cur = nxt; cA = nA; cB = nB; ++ui;
#pragma unroll
        for (int h = 0; h < 2; ++h)
#pragma unroll
            for (int i = 0; i < 2; ++i) vc[h][i] = vn[h][i];
        if (wr == 1) PG8_BAR;
    }
    PG8_WAIT_V(0);
    PG8_BAR;
#undef PG8_SA
#undef PG8_SB
#undef PG8_STAGE
#undef PG8_LDA
#undef PG8_LDB
#undef PG8_MMA
#undef PG8_MMA_Z
#undef PG8_MMA2
#undef PG8_LO
#undef PG8_HI
#undef PG8_LD8
#undef PG8_WAIT_V
#undef PG8_WAIT_L
#undef PG8_BAR
#undef PG8_SCHED
}
}

using pg8::Unit;
__device__ __forceinline__ u32x4 pack8(const f32x4& a, const f32x4& b) { u32x4 w; w.x = pk2(a[0], a[1]); w.y = pk2(a[2], a[3]); w.z = pk2(b[0], b[1]); w.w = pk2(b[2], b[3]); return w; }
#define EPI_LOOP_AI_M _Pragma("unroll") for (int ai = 0; ai < 2; ++ai) _Pragma("unroll") for (int m = 0; m < 4; ++m)
#define EPI_LOADS_DONE() asm volatile("s_waitcnt vmcnt(0)" ::: "memory")

struct EpiInProj {
    static constexpr bool MID = false, LDSX = false;
    bf16* HG; bf16* QLAT; bf16* KVLAT; bf16* G; bf16* GR; const float* gate_b; float* KPESS; const float* RSX; float* SSQ; float* SSC;
    __device__ __forceinline__ void operator()(const f32x4 (&acc)[2][2][4][2], const Unit& u, int wr, int wc, int fr, int fq) const {
        const int rowu = u.pm * 256 + wr * 64, cwu = wc * 32, cw = cwu + 8 * fq;
        float rx[2][4];
        { const float* rxp = RSX + rowu; EPI_LOOP_AI_M rx[ai][m] = rxp[fr + 128 * ai + 16 * m]; }
        f32x4 bv[2][2];
        { const int cbg = 128 * (u.pn < 6 ? 0 : u.pn - 6) + cw;
#pragma unroll
          for (int bj = 0; bj < 2; ++bj)
#pragma unroll
              for (int n = 0; n < 2; ++n) bv[bj][n] = *(const f32x4*)(gate_b + 1024 * bj + cbg + 4 * n); }
        __builtin_amdgcn_sched_barrier(0);
        EPI_LOADS_DONE();
        asm volatile("" : "+v"(bv[0][0]), "+v"(bv[0][1]), "+v"(bv[1][0]), "+v"(bv[1][1]));
        if (u.pn < 4) {
            const int bb = rowu >> 12, tu = rowu & 4095;
            char* hb = (char*)HG + (((size_t)bb * LPC + HGOFF + tu) * CDIM + 128 * u.pn + cwu) * 2; const unsigned lo = (unsigned)(fr * CDIM + 8 * fq) * 2u;
            EPI_LOOP_AI_M {
                const f32x2 r2 = {rx[ai][m], rx[ai][m]}, nr2 = r2 * -1.4426950408889634f; f32x4 v[2];
#pragma unroll
                for (int n = 0; n < 2; ++n)
#pragma unroll
                    for (int h = 0; h < 2; ++h) { const f32x2 a2 = {acc[ai][0][m][n][2 * h], acc[ai][0][m][n][2 * h + 1]}, g2 = {acc[ai][1][m][n][2 * h], acc[ai][1][m][n][2 * h + 1]};
                        const f32x2 t = g2 * nr2; f32x2 d = {__builtin_amdgcn_exp2f(t[0]), __builtin_amdgcn_exp2f(t[1])}; d = d + 1.f;
                        const f32x2 rc = {__builtin_amdgcn_rcpf(d[0]), __builtin_amdgcn_rcpf(d[1])}, o = (a2 * r2) * rc; v[n][2 * h] = o[0]; v[n][2 * h + 1] = o[1]; }
                *(u32x4*)(hb + (size_t)(128 * ai + 16 * m) * (CDIM * 2) + lo) = pack8(v[0], v[1]); }
        } else if (u.pn < 6) {
            char* db = (char*)((u.pn == 4) ? QLAT : KVLAT) + ((size_t)rowu * 256 + cwu) * 2; const unsigned lo = (unsigned)(fr * 256 + 8 * fq) * 2u;
            EPI_LOOP_AI_M {
#pragma unroll
                for (int bj = 0; bj < 2; ++bj) *(u32x4*)(db + (size_t)(128 * ai + 16 * m) * 512 + 256 * bj + lo) = pack8(acc[ai][bj][m][0] * rx[ai][m], acc[ai][bj][m][1] * rx[ai][m]); }
            { float* ssd = ((u.pn == 4) ? SSQ : SSC) + (size_t)rowu * 4 + wc; const int nbj = (u.pn == 4) ? 2 : 1;
                EPI_LOOP_AI_M { float ss = 0.f;
#pragma unroll
                    for (int bj = 0; bj < 2; ++bj) if (bj < nbj) { const f32x4 a = acc[ai][bj][m][0], b = acc[ai][bj][m][1]; ss += ((a[0] * a[0] + a[1] * a[1]) + (a[2] * a[2] + a[3] * a[3])) + ((b[0] * b[0] + b[1] * b[1]) + (b[2] * b[2] + b[3] * b[3])); }
                    ss += __shfl_xor(ss, 16); ss += __shfl_xor(ss, 32);
                    if (fq == 0) ssd[(fr + 128 * ai + 16 * m) * 4] = ss * rx[ai][m] * rx[ai][m]; } }
            if (u.pn == 5 && wc == 0) {
                float* kp = KPESS + rowu;
                EPI_LOOP_AI_M { const f32x4 a = acc[ai][1][m][0], b = acc[ai][1][m][1];
                    float ss = ((a[0] * a[0] + a[1] * a[1]) + (a[2] * a[2] + a[3] * a[3])) + ((b[0] * b[0] + b[1] * b[1]) + (b[2] * b[2] + b[3] * b[3]));
                    ss += __shfl_xor(ss, 16); ss += __shfl_xor(ss, 32);
                    if (fq == 0) kp[fr + 128 * ai + 16 * m] = ss * rx[ai][m] * rx[ai][m]; } }
        } else {
            const size_t ub = ((size_t)rowu * 1024 + 128 * (u.pn - 6) + cwu) * 2; char* rb = (char*)GR + ub; char* gb = (char*)G + ub; const unsigned lo = (unsigned)(fr * 1024 + 8 * fq) * 2u;
#pragma unroll
            for (int bj = 0; bj < 2; ++bj)
#pragma unroll
                for (int n = 0; n < 2; ++n) bv[bj][n] = bv[bj][n] * -1.4426950408889634f;
            EPI_LOOP_AI_M { f32x4 rr[2], gg[2]; const float nr = rx[ai][m] * -1.4426950408889634f; const f32x2 nr2 = {nr, nr};
#pragma unroll
                for (int n = 0; n < 2; ++n)
#pragma unroll
                    for (int h = 0; h < 2; ++h) { const f32x2 z0 = {acc[ai][0][m][n][2 * h], acc[ai][0][m][n][2 * h + 1]}, z1 = {acc[ai][1][m][n][2 * h], acc[ai][1][m][n][2 * h + 1]};
                        const f32x2 b0 = {bv[0][n][2 * h], bv[0][n][2 * h + 1]}, b1 = {bv[1][n][2 * h], bv[1][n][2 * h + 1]};
                        const f32x2 t0 = z0 * nr2 + b0, t1 = z1 * nr2 + b1;
                        f32x2 d0 = {__builtin_amdgcn_exp2f(t0[0]), __builtin_amdgcn_exp2f(t0[1])}, d1 = {__builtin_amdgcn_exp2f(t1[0]), __builtin_amdgcn_exp2f(t1[1])}; d0 = d0 + 1.f; d1 = d1 + 1.f;
                        const f32x2 q0 = {__builtin_amdgcn_rcpf(d0[0]), __builtin_amdgcn_rcpf(d0[1])}, g1 = {__builtin_amdgcn_rcpf(d1[0]), __builtin_amdgcn_rcpf(d1[1])}, r = d1 * q0;
                        gg[n][2 * h] = g1[0]; gg[n][2 * h + 1] = g1[1]; rr[n][2 * h] = r[0]; rr[n][2 * h + 1] = r[1]; }
                *(u32x4*)(rb + (size_t)(128 * ai + 16 * m) * 2048 + lo) = pack8(rr[0], rr[1]); *(u32x4*)(gb + (size_t)(128 * ai + 16 * m) * 2048 + lo) = pack8(gg[0], gg[1]); }
        }
    }
};
template <bool REMAP> struct EpiRowScale {
    static constexpr bool MID = false, LDSX = false;
    bf16* O; const float* rs;
    __device__ __forceinline__ void operator()(const f32x4 (&acc)[2][2][4][2], const Unit& u, int wr, int wc, int fr, int fq) const {
        const int rowt = u.pm * 256 + wr * 64 + fr, cb = 256 * u.pn + 64 * wc + 16 * fq;
        float sv[2][4];
        EPI_LOOP_AI_M sv[ai][m] = rs[rowt + 128 * ai + 16 * m];
        __builtin_amdgcn_sched_barrier(0);
        EPI_LOADS_DONE();
        EPI_LOOP_AI_M { const int row = rowt + 128 * ai + 16 * m; const float s = sv[ai][m];
            const size_t orow = REMAP ? ((size_t)(row >> 12) * LPK + KOFF + (row & 4095)) : (size_t)row;
#pragma unroll
            for (int bj = 0; bj < 2; ++bj) *(u32x4*)(O + orow * 1024 + cb + 8 * bj) = pack8(acc[ai][bj][m][0] * s, acc[ai][bj][m][1] * s); }
    }
};
__device__ __forceinline__ void unpack8(const u32x4& w, f32x4& a, f32x4& b) { a[0] = bflo(w.x); a[1] = bfhi(w.x); a[2] = bflo(w.y); a[3] = bfhi(w.y); b[0] = bflo(w.z); b[1] = bfhi(w.z); b[2] = bflo(w.w); b[3] = bfhi(w.w); }
struct EpiQHead {
    static constexpr bool MID = false, LDSX = true;
    bf16* QF; const float* rs; const float* q_nw; const float* ROPE; LAS unsigned char* lds;
    __device__ __forceinline__ void operator()(const f32x4 (&acc)[2][2][4][2], const Unit& u, int wr, int wc, int fr, int fq) const {
        LAS float* S = (LAS float*)(lds + 3 * 16384);
        const int rowu = u.pm * 256 + wr * 64, rl0 = wr * 64 + fr;
        float sv[2][4];
        { f32x4 pp[2][4]; const char* rsb = (const char*)(rs + (size_t)rowu * 4); const unsigned lo = (unsigned)fr * 16u;
          EPI_LOOP_AI_M pp[ai][m] = *(const f32x4*)(rsb + (128 * ai + 16 * m) * 16 + lo);
          __builtin_amdgcn_sched_barrier(0);
          EPI_LOADS_DONE();
          EPI_LOOP_AI_M sv[ai][m] = 1.f / sqrtf(((pp[ai][m][0] + pp[ai][m][1]) + (pp[ai][m][2] + pp[ai][m][3])) * (1.f / QLR) + NORM_EPS); }
        EPI_LOOP_AI_M {
#pragma unroll
            for (int bj = 0; bj < 2; ++bj) { const f32x4 a = acc[ai][bj][m][0], b = acc[ai][bj][m][1];
                float ss = ((a[0] * a[0] + a[1] * a[1]) + (a[2] * a[2] + a[3] * a[3])) + ((b[0] * b[0] + b[1] * b[1]) + (b[2] * b[2] + b[3] * b[3]));
                ss += __shfl_xor(ss, 16); ss += __shfl_xor(ss, 32);
                if (fq == 0) S[((rl0 + 128 * ai + 16 * m) * 2 + bj) * 4 + wc] = ss; } }
        asm volatile("s_waitcnt lgkmcnt(0)\n\ts_barrier" ::: "memory");
        if (wc < 3) {
            const f32x4 w0 = *(const f32x4*)(q_nw + 32 * wc + 8 * fq), w1 = *(const f32x4*)(q_nw + 32 * wc + 8 * fq + 4);
            char* qb = (char*)QF + ((size_t)rowu * 768 + (size_t)(2 * u.pn) * DQK + 32 * wc) * 2; const unsigned qlo = (unsigned)(fr * 768 + 8 * fq) * 2u;
            const char* rb = (const char*)(ROPE + (size_t)(NMETA + (rowu & 4095)) * 32); const unsigned rlo = (unsigned)(fr * 32 + 16 * (fq & 1)) * 4u;
            f32x4 cn[4] = {{0.f, 0.f, 0.f, 0.f}, {0.f, 0.f, 0.f, 0.f}, {0.f, 0.f, 0.f, 0.f}, {0.f, 0.f, 0.f, 0.f}};
            if (wc == 2) { cn[0] = *(const f32x4*)(rb + rlo); cn[1] = *(const f32x4*)(rb + rlo + 16); cn[2] = *(const f32x4*)(rb + rlo + 32); cn[3] = *(const f32x4*)(rb + rlo + 48); }
            EPI_LOOP_AI_M { const int rl = rl0 + 128 * ai + 16 * m; const float rsq = sv[ai][m];
                const f32x4 c0 = cn[0], c1 = cn[1], c2 = cn[2], c3 = cn[3];
                if (wc == 2 && (ai * 4 + m) < 7) { const int q1 = ai * 4 + m + 1; const char* rp = rb + (128 * (q1 >> 2) + 16 * (q1 & 3)) * 128 + rlo;
                    cn[0] = *(const f32x4*)rp; cn[1] = *(const f32x4*)(rp + 16); cn[2] = *(const f32x4*)(rp + 32); cn[3] = *(const f32x4*)(rp + 48); }
#pragma unroll
                for (int bj = 0; bj < 2; ++bj) { const f32x4 pt = *(const LAS f32x4*)(S + (rl * 2 + bj) * 4);
                    const float tot = ((pt[0] + pt[1]) + (pt[2] + pt[3])) * rsq * rsq, sc = rsq * QSCALE / sqrtf(tot * (1.f / DQK) + NORM_EPS);
                    f32x4 o0 = acc[ai][bj][m][0] * sc * w0, o1 = acc[ai][bj][m][1] * sc * w1;
                    if (wc == 2) {
                        const float sg = (fq < 2) ? -1.f : 1.f; f32x4 p0, p1;
#pragma unroll
                        for (int e = 0; e < 4; ++e) { p0[e] = __shfl_xor(o0[e], 32); p1[e] = __shfl_xor(o1[e], 32); }
                        o0 = (f32x4){o0[0] * c0[0] + sg * p0[0] * c0[1], o0[1] * c0[2] + sg * p0[1] * c0[3], o0[2] * c1[0] + sg * p0[2] * c1[1], o0[3] * c1[2] + sg * p0[3] * c1[3]};
                        o1 = (f32x4){o1[0] * c2[0] + sg * p1[0] * c2[1], o1[1] * c2[2] + sg * p1[1] * c2[3], o1[2] * c3[0] + sg * p1[2] * c3[1], o1[3] * c3[2] + sg * p1[3] * c3[3]}; }
                    *(u32x4*)(qb + (size_t)(128 * ai + 16 * m) * 1536 + bj * (DQK * 2) + qlo) = pack8(o0, o1); } }
        }
        asm volatile("s_waitcnt lgkmcnt(0)\n\ts_barrier" ::: "memory");
    }
};
struct EpiKVHead {
    static constexpr bool MID = false, LDSX = true;
    bf16* KF; bf16* VO; const bf16* KVLAT; const float* rs; const float* kpess; const float* k_nw; const float* ROPE; LAS unsigned char* lds;
    __device__ __forceinline__ void operator()(const f32x4 (&acc)[2][2][4][2], const Unit& u, int wr, int wc, int fr, int fq) const {
        LAS float* S = (LAS float*)(lds + 3 * 16384);
        const int rl0 = wr * 64 + fr, rowt = u.pm * 256 + rl0;
        float sv[2][4];
        { f32x4 pp[2][4];
          EPI_LOOP_AI_M pp[ai][m] = *(const f32x4*)(rs + (size_t)(rowt + 128 * ai + 16 * m) * 4);
          __builtin_amdgcn_sched_barrier(0);
          EPI_LOADS_DONE();
          EPI_LOOP_AI_M sv[ai][m] = 1.f / sqrtf(((pp[ai][m][0] + pp[ai][m][1]) + (pp[ai][m][2] + pp[ai][m][3])) * (1.f / KVLR) + NORM_EPS); }
        if (wc < 2) {
            EPI_LOOP_AI_M {
#pragma unroll
                for (int bj = 0; bj < 2; ++bj) { const f32x4 a = acc[ai][bj][m][0], b = acc[ai][bj][m][1];
                    float ss = ((a[0] * a[0] + a[1] * a[1]) + (a[2] * a[2] + a[3] * a[3])) + ((b[0] * b[0] + b[1] * b[1]) + (b[2] * b[2] + b[3] * b[3]));
                    ss += __shfl_xor(ss, 16); ss += __shfl_xor(ss, 32);
                    if (fq == 0) S[((rl0 + 128 * ai + 16 * m) * 2 + bj) * 4 + wc] = ss; } }
        } else if (fq == 0) {
            EPI_LOOP_AI_M { const float val = (wc == 2) ? sv[ai][m] : kpess[rowt + 128 * ai + 16 * m];
                S[((rl0 + 128 * ai + 16 * m) * 2 + 0) * 4 + wc] = val; S[((rl0 + 128 * ai + 16 * m) * 2 + 1) * 4 + wc] = val; }
        }
        asm volatile("s_waitcnt lgkmcnt(0)\n\ts_barrier" ::: "memory");
        if (wc < 2) {
            const int d0 = 32 * wc + 8 * fq; const f32x4 w0 = *(const f32x4*)(k_nw + d0), w1 = *(const f32x4*)(k_nw + d0 + 4);
            EPI_LOOP_AI_M { const int rl = rl0 + 128 * ai + 16 * m, row = rowt + 128 * ai + 16 * m, b = row >> 12, t = row & 4095;
#pragma unroll
                for (int bj = 0; bj < 2; ++bj) { const f32x4 pt = *(const LAS f32x4*)(S + (rl * 2 + bj) * 4);
                    const float tot = (pt[0] + pt[1]) * pt[2] * pt[2] + pt[3], sc = pt[2] / sqrtf(tot * (1.f / DQK) + NORM_EPS);
                    *(u32x4*)(KF + ((size_t)(b * NH + 2 * u.pn + bj) * LPK + KOFF + t) * DQK + d0) = pack8(acc[ai][bj][m][0] * sc * w0, acc[ai][bj][m][1] * sc * w1); } }
        } else {
            const int d0 = 32 * (wc - 2) + 8 * fq;
            EPI_LOOP_AI_M { const int row = rowt + 128 * ai + 16 * m, b = row >> 12, t = row & 4095; const float rsc = sv[ai][m];
#pragma unroll
                for (int bj = 0; bj < 2; ++bj) *(u32x4*)(VO + ((size_t)b * LPK + KOFF + t) * 1024 + (2 * u.pn + bj) * 128 + 64 + d0) = pack8(acc[ai][bj][m][0] * rsc, acc[ai][bj][m][1] * rsc); }
        }
        __builtin_amdgcn_sched_barrier(0);
        if (wc == 2) {
            const f32x4 wo0 = *(const f32x4*)(k_nw + 64 + 8 * fq), wo1 = *(const f32x4*)(k_nw + 68 + 8 * fq), wp0 = *(const f32x4*)(k_nw + 64 + 8 * (fq ^ 2)), wp1 = *(const f32x4*)(k_nw + 68 + 8 * (fq ^ 2));
            const float sg = (fq < 2) ? -1.f : 1.f;
#pragma unroll 2
            for (int q = 0; q < 8; ++q) { const int rl = rl0 + 128 * (q >> 2) + 16 * (q & 3), row = u.pm * 256 + rl, b = row >> 12, t = row & 4095;
                f32x4 xo0, xo1, xp0, xp1; const bf16* pe = KVLAT + (size_t)row * 256 + KVLR; unpack8(*(const u32x4*)(pe + 8 * fq), xo0, xo1); unpack8(*(const u32x4*)(pe + 8 * (fq ^ 2)), xp0, xp1);
                const float* rp = ROPE + (size_t)(NMETA + t) * 32 + 16 * (fq & 1); const f32x4 c0 = *(const f32x4*)rp, c1 = *(const f32x4*)(rp + 4), c2 = *(const f32x4*)(rp + 8), c3 = *(const f32x4*)(rp + 12);
#pragma unroll
                for (int bj = 0; bj < 2; ++bj) { const f32x4 pt = *(const LAS f32x4*)(S + (rl * 2 + bj) * 4);
                    const float tot = (pt[0] + pt[1]) * pt[2] * pt[2] + pt[3], rh = 1.f / sqrtf(tot * (1.f / DQK) + NORM_EPS);
                    const f32x4 a0 = xo0 * rh * wo0, a1 = xo1 * rh * wo1, p0 = xp0 * rh * wp0, p1 = xp1 * rh * wp1;
                    const f32x4 o0 = {a0[0] * c0[0] + sg * p0[0] * c0[1], a0[1] * c0[2] + sg * p0[1] * c0[3], a0[2] * c1[0] + sg * p0[2] * c1[1], a0[3] * c1[2] + sg * p0[3] * c1[3]};
                    const f32x4 o1 = {a1[0] * c2[0] + sg * p1[0] * c2[1], a1[1] * c2[2] + sg * p1[1] * c2[3], a1[2] * c3[0] + sg * p1[2] * c3[1], a1[3] * c3[2] + sg * p1[3] * c3[3]};
                    *(u32x4*)(KF + ((size_t)(b * NH + 2 * u.pn + bj) * LPK + KOFF + t) * DQK + 64 + 8 * fq) = pack8(o0, o1); } }
        }
        asm volatile("s_waitcnt lgkmcnt(0)\n\ts_barrier" ::: "memory");
    }
};
struct EpiMix {
    static constexpr bool MID = true, LDSX = false;
    bf16* O; const bf16* G1; const bf16* GR;
    __device__ __forceinline__ void mid(f32x4 (&acc)[2][2][4][2], const Unit& u, int wr, int wc, int fr, int fq) const {
        const char* gb = (const char*)GR + ((size_t)(u.pm * 256 + wr * 64) * 1024 + 256 * u.pn + 64 * wc) * 2; const unsigned lo = (unsigned)(fr * 1024 + 16 * fq) * 2u;
#pragma unroll
        for (int ai = 0; ai < 2; ++ai) { u32x4 gw[4][2];
#pragma unroll
            for (int m = 0; m < 4; ++m)
#pragma unroll
                for (int bj = 0; bj < 2; ++bj) gw[m][bj] = *(const u32x4*)(gb + (size_t)(128 * ai + 16 * m) * 2048 + lo + 16 * bj);
            __builtin_amdgcn_sched_barrier(0);
#pragma unroll
            for (int m = 0; m < 4; ++m)
#pragma unroll
                for (int bj = 0; bj < 2; ++bj) { f32x4 g0, g1; unpack8(gw[m][bj], g0, g1); acc[ai][bj][m][0] *= g0; acc[ai][bj][m][1] *= g1; }
            __builtin_amdgcn_sched_barrier(0); }
    }
    __device__ __forceinline__ void operator()(const f32x4 (&acc)[2][2][4][2], const Unit& u, int wr, int wc, int fr, int fq) const {
        const size_t ub = ((size_t)(u.pm * 256 + wr * 64) * 1024 + 256 * u.pn + 64 * wc) * 2; const unsigned lo = (unsigned)(fr * 1024 + 16 * fq) * 2u;
        const char* gb = (const char*)G1 + ub; char* ob = (char*)O + ub;
        u32x4 gw[2][4][2];
        EPI_LOOP_AI_M {
#pragma unroll
            for (int bj = 0; bj < 2; ++bj) gw[ai][m][bj] = *(const u32x4*)(gb + (size_t)(128 * ai + 16 * m) * 2048 + lo + 16 * bj); }
        __builtin_amdgcn_sched_barrier(0);
        EPI_LOADS_DONE();
        EPI_LOOP_AI_M {
#pragma unroll
            for (int bj = 0; bj < 2; ++bj) { f32x4 g0, g1; unpack8(gw[ai][m][bj], g0, g1);
                *(u32x4*)(ob + (size_t)(128 * ai + 16 * m) * 2048 + lo + 16 * bj) = pack8(g0 * acc[ai][bj][m][0], g1 * acc[ai][bj][m][1]); } }
    }
};
struct EpiResid {
    static constexpr bool MID = false, LDSX = false;
    const bf16* X; bf16* H1B; unsigned char* H1Q;
    __device__ __forceinline__ void operator()(const f32x4 (&acc)[2][2][4][2], const Unit& u, int wr, int wc, int fr, int fq) const {
        const size_t ue = (size_t)(u.pm * 256 + wr * 64) * 1024 + 256 * u.pn + 64 * wc; const unsigned le = (unsigned)(fr * 1024 + 16 * fq);
        const char* xb = (const char*)X + ue * 2; char* hb = (char*)H1B + ue * 2; unsigned char* qb = H1Q + ue;
        u32x4 xv[2][4][2];
        EPI_LOOP_AI_M {
#pragma unroll
            for (int bj = 0; bj < 2; ++bj) xv[ai][m][bj] = *(const u32x4*)(xb + (size_t)(128 * ai + 16 * m) * 2048 + le * 2u + 16 * bj); }
        __builtin_amdgcn_sched_barrier(0);
        EPI_LOADS_DONE();
        EPI_LOOP_AI_M {
#pragma unroll
            for (int bj = 0; bj < 2; ++bj) {
                f32x4 x0, x1; unpack8(xv[ai][m][bj], x0, x1); const f32x4 v0 = x0 + acc[ai][bj][m][0], v1 = x1 + acc[ai][bj][m][1];
                *(u32x4*)(hb + (size_t)(128 * ai + 16 * m) * 2048 + le * 2u + 16 * bj) = pack8(v0, v1);
                *(u32x2*)(qb + (size_t)(128 * ai + 16 * m) * 1024 + le + 8 * bj) = (u32x2){pk4_fp8(v0[0], v0[1], v0[2], v0[3]), pk4_fp8(v1[0], v1[1], v1[2], v1[3])}; } }
    }
};
struct EpiSwiGLU {
    static constexpr bool MID = false, LDSX = false;
    unsigned char* ACT; const float* bgu; const float* lrs; const volatile LAS int* tb;
    __device__ __forceinline__ void operator()(const f32x4 (&acc)[2][2][4][2], const Unit& u, int wr, int wc, int fr, int fq) const {
        const int r0 = wr * 64 + fr, cw = wc * 32 + 8 * fq, slot0 = (u.pm - __builtin_amdgcn_readfirstlane(tb[u.e])) * 256;
        const float* bg = bgu + (size_t)u.e * 2048 + 128 * u.pn + cw; const float* lr = lrs + (size_t)u.e * ECAP + slot0;
        const f32x4 bg0 = *(const f32x4*)(bg), bg1 = *(const f32x4*)(bg + 4), bu0 = *(const f32x4*)(bg + 1024), bu1 = *(const f32x4*)(bg + 1028);
        float sv[2][4];
        EPI_LOOP_AI_M sv[ai][m] = lr[r0 + 128 * ai + 16 * m];
        asm volatile("" : "+v"(sv[0][0]), "+v"(sv[0][1]), "+v"(sv[0][2]), "+v"(sv[0][3]), "+v"(sv[1][0]), "+v"(sv[1][1]), "+v"(sv[1][2]), "+v"(sv[1][3]));
        EPI_LOADS_DONE();
        constexpr float NC = -SW_ALPHA * 1.4426950408889634f;
        f32x4 bgv[2] = {bg0, bg1}, buv[2] = {bu0 + 1.f, bu1 + 1.f};
        EPI_LOOP_AI_M { const int r = r0 + 128 * ai + 16 * m; const float s = (r < u.cnt) ? sv[ai][m] * W8_INV : 0.f; const f32x2 s2 = {s, s};
            f32x4 v[2];
#pragma unroll
            for (int n = 0; n < 2; ++n)
#pragma unroll
                for (int h = 0; h < 2; ++h) {
                    const f32x2 ag = {acc[ai][0][m][n][2 * h], acc[ai][0][m][n][2 * h + 1]}, au = {acc[ai][1][m][n][2 * h], acc[ai][1][m][n][2 * h + 1]};
                    const f32x2 bg2 = {bgv[n][2 * h], bgv[n][2 * h + 1]}, bu2 = {buv[n][2 * h], buv[n][2 * h + 1]};
                    f32x2 g = ag * s2 + bg2; g[0] = fminf(g[0], SW_LIMIT); g[1] = fminf(g[1], SW_LIMIT);
                    f32x2 uu = au * s2 + bu2; uu[0] = __builtin_amdgcn_fmed3f(uu[0], 1.f - SW_LIMIT, 1.f + SW_LIMIT); uu[1] = __builtin_amdgcn_fmed3f(uu[1], 1.f - SW_LIMIT, 1.f + SW_LIMIT);
                    const f32x2 x = g * NC; f32x2 d = {__builtin_amdgcn_exp2f(x[0]), __builtin_amdgcn_exp2f(x[1])}; d = d + 1.f;
                    const f32x2 rc = {__builtin_amdgcn_rcpf(d[0]), __builtin_amdgcn_rcpf(d[1])};
                    const f32x2 o = (uu * g) * rc; v[n][2 * h] = o[0]; v[n][2 * h + 1] = o[1]; }
            *(u32x2*)(ACT + ((size_t)u.pm * 256 + r) * 1024 + 128 * u.pn + cw) = (u32x2){pk4_fp8(v[0][0], v[0][1], v[0][2], v[0][3]), pk4_fp8(v[1][0], v[1][1], v[1][2], v[1][3])}; }
    }
};
struct EpiDown {
    static constexpr bool MID = false, LDSX = false;
    unsigned char* Y; const float* bd; const float* lw; const volatile LAS int* tb;
    __device__ __forceinline__ void operator()(const f32x4 (&acc)[2][2][4][2], const Unit& u, int wr, int wc, int fr, int fq) const {
        const int r0 = wr * 64 + fr, cb = 256 * u.pn + 64 * wc + 16 * fq, slot0 = (u.pm - __builtin_amdgcn_readfirstlane(tb[u.e])) * 256;
        const float* bp = bd + (size_t)u.e * 1024 + cb; const float* lwp = lw + (size_t)u.e * ECAP + slot0;
        f32x4 bv[2][2];
#pragma unroll
        for (int bj = 0; bj < 2; ++bj)
#pragma unroll
            for (int n = 0; n < 2; ++n) bv[bj][n] = *(const f32x4*)(bp + 8 * bj + 4 * n);
        float wv[2][4];
        EPI_LOOP_AI_M wv[ai][m] = lwp[r0 + 128 * ai + 16 * m];
        asm volatile("" : "+v"(wv[0][0]), "+v"(wv[0][1]), "+v"(wv[0][2]), "+v"(wv[0][3]), "+v"(wv[1][0]), "+v"(wv[1][1]), "+v"(wv[1][2]), "+v"(wv[1][3]));
        EPI_LOADS_DONE();
        EPI_LOOP_AI_M { const int r = r0 + 128 * ai + 16 * m; const float w = (r < u.cnt) ? wv[ai][m] * Y8_SCALE : 0.f; u32x4 o;
            { const f32x4 v0 = (acc[ai][0][m][0] * W8_INV + bv[0][0]) * w, v1 = (acc[ai][0][m][1] * W8_INV + bv[0][1]) * w; o.x = pk4_fp8(v0[0], v0[1], v0[2], v0[3]); o.y = pk4_fp8(v1[0], v1[1], v1[2], v1[3]); }
            { const f32x4 v0 = (acc[ai][1][m][0] * W8_INV + bv[1][0]) * w, v1 = (acc[ai][1][m][1] * W8_INV + bv[1][1]) * w; o.z = pk4_fp8(v0[0], v0[1], v0[2], v0[3]); o.w = pk4_fp8(v1[0], v1[1], v1[2], v1[3]); }
            *(u32x4*)(Y + ((size_t)u.pm * 256 + r) * 1024 + cb) = o; }
    }
};

struct Ctx {
    LAS unsigned char* lds; gu32* ctl; unsigned char* ws;
    int tid, lane, wave, vcu, G;
    const float *x, *meta, *attn_nw, *w_in, *dw_w, *dw_b, *ln_w, *ln_b, *pw2_w, *qa_nw, *w_qb, *kva_nw, *w_kvb, *q_nw, *k_nw, *w_o, *gate_b, *w_out, *ffn_nw, *router_w, *router_b, *w_gu, *b_gu, *w_d, *b_d;
    float* out;
};
#define WSP(T, off) ((T*)(F.ws + (off)))

__device__ __forceinline__ void tr_item(const float* src, int ld_src, int k0, int colA, int colB, const float* ks, bf16* dst, int ld_dst, LAS unsigned* scr, int lane) {
    const int nq = lane & 15, kq = lane >> 4; const int col = (nq >> 3) ? colB : colA; const int c4 = col + 4 * (nq & 7);
#pragma unroll
    for (int i = 0; i < 8; ++i) { const int kp = 4 * i + kq; f32x4 a = {0.f, 0.f, 0.f, 0.f}, b = {0.f, 0.f, 0.f, 0.f};
        if (col >= 0) { a = *(const f32x4*)(src + (size_t)(k0 + 2 * kp) * ld_src + c4); b = *(const f32x4*)(src + (size_t)(k0 + 2 * kp + 1) * ld_src + c4); }
        if (ks) { a *= ks[k0 + 2 * kp]; b *= ks[k0 + 2 * kp + 1]; }
        LAS unsigned* p = scr + kp * 65 + 4 * nq; p[0] = pk2(a[0], b[0]); p[1] = pk2(a[1], b[1]); p[2] = pk2(a[2], b[2]); p[3] = pk2(a[3], b[3]); }
    LDS_WAIT(); asm volatile("" ::: "memory");
    const int c = lane & 7;
#pragma unroll
    for (int j = 0; j < 8; ++j) { const int n = (lane >> 3) + 8 * j; const LAS unsigned* s = scr + (4 * c) * 65 + n;
        u32x4 o; o.x = s[0]; o.y = s[65]; o.z = s[130]; o.w = s[195];
        *(u32x4*)(dst + (size_t)n * ld_dst + 8 * c) = o; }
    LDS_WAIT(); asm volatile("" ::: "memory");
}
__device__ __forceinline__ void tr_item8(const float* src, int ld_src, int k0, int colA, int colB, const float* ks, unsigned char* dst, int ld_dst, LAS unsigned* scr, int lane) {
    const int nq = lane & 15, kq = lane >> 4; const int col = (nq >> 3) ? colB : colA; const int c4 = col + 4 * (nq & 7);
#pragma unroll
    for (int i = 0; i < 8; ++i) { const int kg = 4 * i + kq; const float* sp = src + (size_t)(k0 + 4 * kg) * ld_src + c4;
        f32x4 a = {0.f, 0.f, 0.f, 0.f}, b = a, c = a, d = a;
        if (col >= 0) { a = __builtin_nontemporal_load((const f32x4*)sp); b = __builtin_nontemporal_load((const f32x4*)(sp + ld_src)); c = __builtin_nontemporal_load((const f32x4*)(sp + 2 * (size_t)ld_src)); d = __builtin_nontemporal_load((const f32x4*)(sp + 3 * (size_t)ld_src)); }
        float s0 = W8_SCALE, s1 = W8_SCALE, s2 = W8_SCALE, s3 = W8_SCALE;
        if (ks) { const f32x4 kv = *(const f32x4*)(ks + k0 + 4 * kg); s0 *= kv[0]; s1 *= kv[1]; s2 *= kv[2]; s3 *= kv[3]; }
        a *= s0; b *= s1; c *= s2; d *= s3;
        LAS unsigned* p = scr + kg * 65 + 4 * nq;
        p[0] = pk4_fp8(a[0], b[0], c[0], d[0]); p[1] = pk4_fp8(a[1], b[1], c[1], d[1]); p[2] = pk4_fp8(a[2], b[2], c[2], d[2]); p[3] = pk4_fp8(a[3], b[3], c[3], d[3]); }
    LDS_WAIT(); asm volatile("" ::: "memory");
    const int c = lane & 7;
#pragma unroll
    for (int j = 0; j < 8; ++j) { const int n = (lane >> 3) + 8 * j; const LAS unsigned* s = scr + (4 * c) * 65 + n;
        u32x4 o; o.x = s[0]; o.y = s[65]; o.z = s[130]; o.w = s[195];
        *(u32x4*)(dst + (size_t)n * ld_dst + 16 * c) = o; }
    LDS_WAIT(); asm volatile("" ::: "memory");
}
__device__ __forceinline__ int colmap_in(int n32) { const int tile = n32 >> 3, j = n32 & 7;
    if (tile < 4) return (j < 4) ? 128 * tile + 32 * j : 512 + 128 * tile + 32 * (j - 4);
    if (tile == 4) return 1024 + 32 * j;
    if (tile == 5) return (j < 5) ? 1280 + 32 * j : -1;
    return (j < 4) ? 1440 + 128 * (tile - 6) + 32 * j : 1440 + 1024 + 128 * (tile - 6) + 32 * (j - 4); }
__device__ __forceinline__ int colmap_gu(int n32) { const int tile = n32 >> 3, j = n32 & 7; return (j < 4) ? 128 * tile + 32 * j : 1024 + 128 * tile + 32 * (j - 4); }
__device__ __forceinline__ int colmap_qb(int n32) { const int h = n32 >> 2, j = n32 & 3; return (j < 3) ? 96 * h + 32 * j : -1; }

__device__ __forceinline__ void p0_item(Ctx& F, int it, LAS unsigned* scr) {
    constexpr int I_GU = 256, I_D = 128, N_GU = NE * I_GU, N_D = NE * I_D, N_WIN = INPROJ_FP8 ? 56 * 8 : 56 * 16, N_WOUT = 256, N_PW2 = 128, N_WO = 128, N_QB = 64;
    int r = it;
    if (r < N_GU) { const int e = r / I_GU, q = r % I_GU, nb = q & 31, kb = q >> 5;
        tr_item8(F.w_gu + (size_t)e * 1024 * 2048, 2048, 128 * kb, colmap_gu(2 * nb), colmap_gu(2 * nb + 1), F.ffn_nw, WSP(unsigned char, WS_WGU) + ((size_t)e * 2048 + 64 * nb) * 1024 + 128 * kb, 1024, scr, F.lane); return; }
    r -= N_GU;
    if (r < N_D) { const int e = r / I_D, q = r % I_D, nb = q & 15, kb = q >> 4;
        tr_item8(F.w_d + (size_t)e * 1024 * 1024, 1024, 128 * kb, 64 * nb, 64 * nb + 32, nullptr, WSP(unsigned char, WS_WD) + ((size_t)e * 1024 + 64 * nb) * 1024 + 128 * kb, 1024, scr, F.lane); return; }
    r -= N_D;
#if INPROJ_FP8
    if (r < N_WIN) { const int nb = r >> 3, kb = r & 7;
        tr_item8(F.w_in, INC, 128 * kb, colmap_in(2 * nb), colmap_in(2 * nb + 1), F.attn_nw, WSP(unsigned char, WS_WIN) + (size_t)(64 * nb) * 1024 + 128 * kb, 1024, scr, F.lane); return; }
#else
    if (r < N_WIN) { const int nb = r >> 4, kb = r & 15;
        tr_item(F.w_in, INC, 64 * kb, colmap_in(2 * nb), colmap_in(2 * nb + 1), F.attn_nw, WSP(bf16, WS_WIN) + (size_t)(64 * nb) * 1024 + 64 * kb, 1024, scr, F.lane); return; }
#endif
    r -= N_WIN;
    if (r < N_WOUT) { const int nb = r >> 4, kb = r & 15;
        tr_item(F.w_out, 1024, 64 * kb, 64 * nb, 64 * nb + 32, nullptr, WSP(bf16, WS_WOUT) + (size_t)(64 * nb) * 1024 + 64 * kb, 1024, scr, F.lane); return; }
    r -= N_WOUT;
    if (r < N_PW2) { const int nb = r >> 3, kb = r & 7;
        tr_item(F.pw2_w, 1024, 64 * kb, 64 * nb, 64 * nb + 32, nullptr, WSP(bf16, WS_W2T) + (size_t)(64 * nb) * 1024 + 64 * kb, 1024, scr, F.lane); return; }
    r -= N_PW2;
    if (r < N_WO) { const int nb = r >> 3, kb = r & 7;
        tr_item(F.w_o, 1024, 64 * kb, 64 * nb, 64 * nb + 32, nullptr, WSP(bf16, WS_W2T) + (size_t)(64 * nb) * 1024 + 512 + 64 * kb, 1024, scr, F.lane); return; }
    r -= N_WO;
    if (r < N_QB) { const int nb = r >> 2, kb = r & 3;
        tr_item(F.w_qb, 768, 64 * kb, colmap_qb(2 * nb), colmap_qb(2 * nb + 1), F.qa_nw, WSP(bf16, WS_WQB) + (size_t)(64 * nb) * 256 + 64 * kb, 256, scr, F.lane); return; }
    r -= N_QB;
    { const int nb = r >> 2, kb = r & 3; const bool real = kb < 2;
        tr_item(F.w_kvb, 1024, real ? 64 * kb : 0, real ? 64 * nb : -1, real ? 64 * nb + 32 : -1, real ? F.kva_nw : nullptr, WSP(bf16, WS_WKVB) + (size_t)(64 * nb) * 256 + 64 * kb, 256, scr, F.lane); }
}
constexpr int P0_NITEMS = NE * 256 + NE * 128 + (INPROJ_FP8 ? 56 * 8 : 56 * 16) + 256 + 128 + 128 + 64 + 64;

__device__ __forceinline__ void p0_prologue(Ctx& F) {
    LAS unsigned* scr = (LAS unsigned*)F.lds + F.wave * 2080;
    const int gw = F.vcu * 8 + F.wave, NGW = F.G * 8, gth = gw * 64 + F.lane, NGT = NGW * 64;
    for (int it = gw; it < P0_NITEMS; it += NGW) p0_item(F, it, scr);
    bf16* XN = WSP(bf16, WS_XN);
    for (int m2 = gw; m2 < MT / 2; m2 += NGW) {
        f32x4 v[2][4]; float ss[2];
#pragma unroll
        for (int q = 0; q < 2; ++q) { const f32x4* xr = (const f32x4*)(F.x + (size_t)(2 * m2 + q) * DM) + F.lane;
#pragma unroll
            for (int j = 0; j < 4; ++j) v[q][j] = __builtin_nontemporal_load(xr + 64 * j); }
#pragma unroll
        for (int q = 0; q < 2; ++q) { float sq = 0.f;
#pragma unroll
            for (int j = 0; j < 4; ++j) sq += (v[q][j][0] * v[q][j][0] + v[q][j][1] * v[q][j][1]) + (v[q][j][2] * v[q][j][2] + v[q][j][3] * v[q][j][3]);
            ss[q] = sq; }
        ss[0] = wave_sum(ss[0]); ss[1] = wave_sum(ss[1]);
#pragma unroll
        for (int q = 0; q < 2; ++q) { if (F.lane == 0) WSP(float, WS_RSX)[2 * m2 + q] = (INPROJ_FP8 ? 1.f / (XQ_SCALE * W8_SCALE) : 1.f) / sqrtf(ss[q] * (1.f / DM) + NORM_EPS);
            u32x2* o8 = (u32x2*)(XN + (size_t)(2 * m2 + q) * DM) + F.lane;
#pragma unroll
            for (int j = 0; j < 4; ++j) { u32x2 o; o.x = pk2(v[q][j][0], v[q][j][1]); o.y = pk2(v[q][j][2], v[q][j][3]); o8[64 * j] = o; }
#if INPROJ_FP8
            unsigned* o4 = (unsigned*)(WSP(unsigned char, WS_XQ) + (size_t)(2 * m2 + q) * DM) + F.lane;
#pragma unroll
            for (int j = 0; j < 4; ++j) o4[64 * j] = pk4_fp8(v[q][j][0] * XQ_SCALE, v[q][j][1] * XQ_SCALE, v[q][j][2] * XQ_SCALE, v[q][j][3] * XQ_SCALE);
#endif
        }
    }
    float* PMP = WSP(float, WS_PMP);
    for (int task = gw; task < 19 * 8; task += NGW) { const int cg = task >> 3, kc = task & 7, cp = 64 * cg + F.lane; const bool valid = cp < PMC;
        const int sc = (cp < 1024) ? cp : 1280 + (cp - 1024);
        LAS float* ms = (LAS float*)scr;
#pragma unroll
        for (int r = 0; r < 16; ++r) { ms[r * 128 + F.lane] = F.meta[r * DM + kc * 128 + F.lane] * F.attn_nw[kc * 128 + F.lane]; ms[r * 128 + 64 + F.lane] = F.meta[r * DM + kc * 128 + 64 + F.lane] * F.attn_nw[kc * 128 + 64 + F.lane]; }
        LDS_WAIT(); asm volatile("" ::: "memory");
        float acc[16];
#pragma unroll
        for (int r = 0; r < 16; ++r) acc[r] = 0.f;
        const float* wp = F.w_in + (size_t)(kc * 128) * INC + (valid ? sc : 0);
        for (int k = 0; k < 128; k += 4) { const float w0 = wp[(size_t)k * INC], w1 = wp[(size_t)(k + 1) * INC], w2 = wp[(size_t)(k + 2) * INC], w3 = wp[(size_t)(k + 3) * INC];
#pragma unroll
            for (int r = 0; r < 16; ++r) { const f32x4 mv = *(const LAS f32x4*)(ms + r * 128 + k); acc[r] += (mv[0] * w0 + mv[1] * w1) + (mv[2] * w2 + mv[3] * w3); } }
        if (valid) {
#pragma unroll
            for (int r = 0; r < 16; ++r) PMP[(kc * 16 + r) * PMC + cp] = acc[r]; }
        LDS_WAIT(); asm volatile("" ::: "memory");
    }
    float* ROPE = WSP(float, WS_ROPE);
    for (int idx = gth; idx < (SEQ + NMETA) * 16; idx += NGT) { const int pos = idx >> 4, i = idx & 15;
        const double invf[16] = {1, 0.56234132519034907, 0.31622776601683794, 0.17782794100389229, 0.10000000000000001, 0.056234132519034911, 0.031622776601683791, 0.017782794100389229, 0.01, 0.005623413251903491, 0.0031622776601683794, 0.0017782794100389228, 0.001, 0.0005623413251903491, 0.00031622776601683794, 0.00017782794100389227};
        double fq = invf[0];
#pragma unroll
        for (int q = 1; q < 16; ++q) fq = (i == q) ? invf[q] : fq;
        const double ang = (double)pos * fq, red = ang - 6.283185307179586477 * __builtin_rint(ang * 0.15915494309189533577);
        float sn, cs; sincosf((float)red, &sn, &cs);
        ROPE[2 * idx] = cs; ROPE[2 * idx + 1] = sn; }
    for (int r = gw; r < NMETA; r += NGW) { float s = 0.f;
        for (int k = F.lane; k < DM; k += 64) { const float v = F.meta[r * DM + k]; s += v * v; }
        s = wave_sum(s); if (F.lane == 0) WSP(float, WS_METARS)[r] = 1.f / sqrtf(s * (1.f / DM) + NORM_EPS); }
    { unsigned short* RW3 = WSP(unsigned short, WS_RW3);
      for (int idx = gth; idx < DM * NE; idx += NGT) { const int k = idx >> 5, e = idx & 31; const float w = F.ffn_nw[k] * F.router_w[idx];
          const unsigned h = pk2(w, 0.f) & 0xffffu; const float r1 = w - __builtin_bit_cast(float, h << 16);
          const unsigned m = pk2(r1, 0.f) & 0xffffu; const float r2 = r1 - __builtin_bit_cast(float, m << 16);
          const unsigned l = pk2(r2, 0.f) & 0xffffu;
          const size_t o = ((size_t)((k >> 3) * NE + e)) * 8 + (k & 7);
          RW3[o] = (unsigned short)h; RW3[(size_t)NE * DM + o] = (unsigned short)m; RW3[(size_t)2 * NE * DM + o] = (unsigned short)l; } }
}

__device__ __forceinline__ float pm_sum(const float* PMP, int r, int c) { float s = 0.f;
#pragma unroll
    for (int kc = 0; kc < 8; ++kc) s += PMP[(kc * 16 + r) * PMC + c];
    return s; }
__device__ __forceinline__ void p1_meta(Ctx& F) {
    const float* PMP = WSP(float, WS_PMP); float* MRS = WSP(float, WS_METARS);
    const int bx = blockIdx.x;
    if (bx < 16) { const int rm = bx, c = F.tid; bf16* HG = WSP(bf16, WS_HG);
        const float rs = MRS[rm]; const float val = rs * pm_sum(PMP, rm, c) * sigmoid_f(rs * pm_sum(PMP, rm, 512 + c)); const bf16 hv = (bf16)f2bf(val);
#pragma unroll
        for (int b = 0; b < NB; ++b) { HG[((size_t)b * LPC + rm) * CDIM + c] = (bf16)0; HG[((size_t)b * LPC + 16 + rm) * CDIM + c] = hv; }
    } else if (bx == 16) {
#pragma unroll
        for (int q = 0; q < 2; ++q) { const int r = 2 * F.wave + q; const float rs = MRS[r];
            const float v0 = rs * pm_sum(PMP, r, 1024 + F.lane), v1 = rs * pm_sum(PMP, r, 1024 + 64 + F.lane);
            const float ss = wave_sum(v0 * v0 + v1 * v1); if (F.lane == 0) MRS[16 + r] = 1.f / sqrtf(ss * (1.f / KVLR) + NORM_EPS); }
    } else if (bx < 17 + 37) { float* PMF = WSP(float, WS_PMF);
        const int idx = (bx - 17) * 512 + F.tid; if (idx < 16 * PMC) PMF[idx] = pm_sum(PMP, idx / PMC, idx % PMC);
    } else if (bx < 54 + 8) {
        const int q = bx - 54, n = (q & 1) * 512 + F.tid, r0 = 4 * (q >> 1); LAS float* cs = (LAS float*)F.lds;
        { const int r = F.tid >> 7, k = F.tid & 127; cs[F.tid] = MRS[r0 + r] * pm_sum(PMP, r0 + r, 1024 + k); }
        __syncthreads();
        if (F.tid < 256) { const int r = F.tid >> 6, l = F.tid & 63; const float v0 = cs[r * 128 + l], v1 = cs[r * 128 + 64 + l]; const float ss = wave_sum(v0 * v0 + v1 * v1);
            if (l == 0) cs[512 + r] = 1.f / sqrtf(ss * (1.f / KVLR) + NORM_EPS); }
        __syncthreads();
        { const int r = F.tid >> 7, k = F.tid & 127; cs[F.tid] *= cs[512 + r] * F.kva_nw[k]; }
        __syncthreads();
        float acc[4] = {0.f, 0.f, 0.f, 0.f};
#pragma unroll 8
        for (int k = 0; k < KVLR; k += 4) { const float w0 = F.w_kvb[k * 1024 + n], w1 = F.w_kvb[(k + 1) * 1024 + n], w2 = F.w_kvb[(k + 2) * 1024 + n], w3 = F.w_kvb[(k + 3) * 1024 + n];
#pragma unroll
            for (int r = 0; r < 4; ++r) { const f32x4 c = *(const LAS f32x4*)(cs + r * 128 + k); acc[r] += (c[0] * w0 + c[1] * w1) + (c[2] * w2 + c[3] * w3); } }
#pragma unroll
        for (int r = 0; r < 4; ++r) WSP(float, WS_KVMETA)[(r0 + r) * 1024 + n] = acc[r];
        __syncthreads();
    }
}

__device__ __forceinline__ void p2_thin(Ctx& F) {
    {
        const bf16* HG = WSP(bf16, WS_HG); bf16* HC = WSP(bf16, WS_HCO);
        LAS unsigned char* lin = F.lds; LAS float* lout = (LAS float*)(F.lds + 63488);
        const int cp = F.tid & 255, th = F.tid >> 8;
        float wlo[CWID], whi[CWID];
#pragma unroll
        for (int j = 0; j < CWID; ++j) { const f32x2 w = *(const f32x2*)(F.dw_w + j * CDIM + 2 * cp); wlo[j] = w[0]; whi[j] = w[1]; }
        const f32x2 cb = *(const f32x2*)(F.dw_b + 2 * cp);
#define P2_LBAR() asm volatile("s_waitcnt lgkmcnt(0)\n\ts_barrier" ::: "memory")
        for (int rp = 0; rp < 1 + PROBE_P2A; ++rp) {
        u32x4 nx[8];
        if (F.vcu < NB * (SEQ / 32)) { const int b = F.vcu >> 7, t0 = (F.vcu & 127) * 32;
#pragma unroll
            for (int i = 0; i < 8; ++i) { const int p = F.tid + 512 * i; nx[i] = (u32x4){0u, 0u, 0u, 0u}; if (p < 62 * 64) nx[i] = *(const u32x4*)(HG + ((size_t)b * LPC + t0 + 2 + (p >> 6)) * CDIM + (p & 63) * 8); } }
        for (int un = F.vcu; un < NB * (SEQ / 32); un += F.G) { const int b = un >> 7, t0 = (un & 127) * 32;
#pragma unroll
            for (int i = 0; i < 8; ++i) { const int p = F.tid + 512 * i; if (p < 62 * 64) { const int row = p >> 6, ch = p & 63; *(LAS u32x4*)(lin + row * 1024 + ch * 16) = nx[i]; } }
            P2_LBAR();
            if (un + F.G < NB * (SEQ / 32)) { const int un1 = un + F.G, b1 = un1 >> 7, t1 = (un1 & 127) * 32;
#pragma unroll
                for (int i = 0; i < 8; ++i) { const int p = F.tid + 512 * i; if (p < 62 * 64) nx[i] = *(const u32x4*)(HG + ((size_t)b1 * LPC + t1 + 2 + (p >> 6)) * CDIM + (p & 63) * 8); } }
#pragma unroll
            for (int g = 0; g < 2; ++g) { const int tl0 = th * 16 + g * 8; float a0[8], a1[8];
#pragma unroll
                for (int o = 0; o < 8; ++o) { a0[o] = cb[0]; a1[o] = cb[1]; }
#pragma unroll
                for (int jj = 0; jj < 38; ++jj) { const unsigned v = *(const LAS unsigned*)(lin + (tl0 + jj) * 1024 + 4 * cp); const float lo = bflo(v), hi = bfhi(v);
#pragma unroll
                    for (int o = 0; o < 8; ++o) { const int j = jj - o; if (j >= 0 && j < CWID) { a0[o] += wlo[j] * lo; a1[o] += whi[j] * hi; } } }
#pragma unroll
                for (int o = 0; o < 8; ++o) *(LAS f32x2*)(lout + (tl0 + o) * CDIM + 2 * cp) = (f32x2){a0[o], a1[o]}; }
            P2_LBAR();
            { const int tok = 4 * F.wave + (F.lane >> 4), l16 = F.lane & 15;
                f32x4 v[4][2]; float sm = 0.f;
#pragma unroll
                for (int j = 0; j < 4; ++j) { const LAS float* lr = lout + tok * CDIM + 128 * j + 8 * l16; v[j][0] = *(const LAS f32x4*)lr; v[j][1] = *(const LAS f32x4*)(lr + 4);
                    sm += (v[j][0][0] + v[j][0][1]) + (v[j][0][2] + v[j][0][3]) + (v[j][1][0] + v[j][1][1]) + (v[j][1][2] + v[j][1][3]); }
                const float mean = sum16(sm) * (1.f / CDIM); float sv = 0.f;
#pragma unroll
                for (int j = 0; j < 4; ++j)
#pragma unroll
                    for (int q = 0; q < 2; ++q) { v[j][q] = v[j][q] - mean; sv += (v[j][q][0] * v[j][q][0] + v[j][q][1] * v[j][q][1]) + (v[j][q][2] * v[j][q][2] + v[j][q][3] * v[j][q][3]); }
                const float rstd = 1.f / sqrtf(sum16(sv) * (1.f / CDIM) + NORM_EPS);
#pragma unroll
                for (int j = 0; j < 4; ++j) { const int c0 = 128 * j + 8 * l16;
                    const f32x4 w0 = *(const f32x4*)(F.ln_w + c0), w1 = *(const f32x4*)(F.ln_w + c0 + 4), b0 = *(const f32x4*)(F.ln_b + c0), b1 = *(const f32x4*)(F.ln_b + c0 + 4);
                    f32x4 y0 = v[j][0] * rstd * w0 + b0, y1 = v[j][1] * rstd * w1 + b1;
#pragma unroll
                    for (int e = 0; e < 4; ++e) { y0[e] = y0[e] * sigmoid_f(y0[e]); y1[e] = y1[e] * sigmoid_f(y1[e]); }
                    *(u32x4*)(HC + ((size_t)b * SEQ + t0 + tok) * 1024 + c0) = pack8(y0, y1); } }
            P2_LBAR();
        }
        }
#undef P2_LBAR
    }
}

__device__ __forceinline__ void norm_rope_store(float (&v)[48], int part, const float* nw, const float* rp, float scale, bf16* dst) {
    float ss = 0.f;
#pragma unroll
    for (int d = 0; d < 48; ++d) ss += v[d] * v[d];
    ss += __shfl_xor(ss, 1);
    const float r = scale / sqrtf(ss * (1.f / DQK) + NORM_EPS);
    const float* nwp = nw + 48 * part;
#pragma unroll
    for (int d = 0; d < 48; ++d) v[d] *= r * nwp[d];
    if (part) {
#pragma unroll
        for (int i = 0; i < 16; ++i) { const float c = rp[2 * i], s = rp[2 * i + 1], x1 = v[16 + i], x2 = v[32 + i]; v[16 + i] = x1 * c - x2 * s; v[32 + i] = x2 * c + x1 * s; }
    }
#pragma unroll
    for (int q = 0; q < 6; ++q) { u32x4 w; w.x = pk2(v[8 * q], v[8 * q + 1]); w.y = pk2(v[8 * q + 2], v[8 * q + 3]); w.z = pk2(v[8 * q + 4], v[8 * q + 5]); w.w = pk2(v[8 * q + 6], v[8 * q + 7]); *(u32x4*)(dst + 8 * q) = w; }
}
__device__ __forceinline__ void ld8(const bf16* p, float* v) { const u32x4 w = *(const u32x4*)p; v[0] = bflo(w.x); v[1] = bfhi(w.x); v[2] = bflo(w.y); v[3] = bfhi(w.y); v[4] = bflo(w.z); v[5] = bfhi(w.z); v[6] = bflo(w.w); v[7] = bfhi(w.w); }

__device__ __forceinline__ void p4_headnorm(Ctx& F) {
    const int gw = F.vcu * 8 + F.wave, NGW = F.G * 8;
    const bf16* QRAW = WSP(bf16, WS_QRAW); bf16* KVRAW = WSP(bf16, WS_KVRAW); const bf16* KVLAT = WSP(bf16, WS_KVLAT);
    bf16* QF = WSP(bf16, WS_QF); bf16* KF = WSP(bf16, WS_KF); const float* ROPE = WSP(float, WS_ROPE);
    const float* PM = WSP(float, WS_PMF); const float* MRS = WSP(float, WS_METARS); const float* KVM = WSP(float, WS_KVMETA);
    constexpr int T_REAL = 0, T_META = NB * 4, T_DUMMY = NB * 48;
    const int part = F.lane & 1, h = (F.lane >> 1) & 7, tl = F.lane >> 4;
    for (int wt = gw; wt < T_REAL + T_META + T_DUMMY; wt += NGW) {
        if (false) {
        } else if (wt < T_REAL + T_META) {
            const int q = wt - T_REAL, b = q >> 2, r = tl + 4 * (q & 3); const float* rp = ROPE + (size_t)r * 32;
            float v[48]; const float* src = KVM + r * 1024 + h * 128; const float rs = MRS[r];
            if (part == 0) {
#pragma unroll
                for (int d = 0; d < 48; ++d) v[d] = src[d];
            } else {
#pragma unroll
                for (int d = 0; d < 16; ++d) v[d] = src[48 + d];
#pragma unroll
                for (int i = 0; i < 32; ++i) v[16 + i] = rs * PM[r * PMC + 1152 + i];
            }
            const size_t kr = (size_t)b * LPK + r;
            norm_rope_store(v, part, F.k_nw, rp, 1.f, KF + ((size_t)(b * NH + h) * LPK + r) * DQK + 48 * part);
            bf16* vd = KVRAW + kr * 1024 + h * 128 + 64 + 32 * part; const float* vs = src + 64 + 32 * part;
#pragma unroll
            for (int q8 = 0; q8 < 4; ++q8) { u32x4 w; w.x = pk2(vs[8 * q8], vs[8 * q8 + 1]); w.y = pk2(vs[8 * q8 + 2], vs[8 * q8 + 3]); w.z = pk2(vs[8 * q8 + 4], vs[8 * q8 + 5]); w.w = pk2(vs[8 * q8 + 6], vs[8 * q8 + 7]); *(u32x4*)(vd + 8 * q8) = w; }
        } else {
            const int q = wt - T_REAL - T_META, b = q / 48, r = 16 + q % 48; const size_t kr = (size_t)b * LPK + r; const u32x4 z = {0u, 0u, 0u, 0u};
            u32x4* vd = (u32x4*)(KVRAW + kr * 1024); vd[F.lane] = z; vd[64 + F.lane] = z;
            for (int q2 = F.lane; q2 < NH * 12; q2 += 64) { const int hh = q2 / 12, c = q2 % 12; *(u32x4*)(KF + ((size_t)(b * NH + hh) * LPK + r) * DQK + 8 * c) = z; }
        }
    }
}

namespace att {
constexpr int KSLOT = 16384, VSLOT = 8192, SLOT = KSLOT + VSLOT, NSLOT = 4, L_WS = NSLOT * SLOT, L_OST = 0, L_END = L_WS + 8 * 256;
static_assert(8 * 4096 <= 2 * SLOT && L_END <= RING_BYTES, "attention LDS map");
constexpr float THR = 8.f;
__device__ __forceinline__ int crow(int r, int hi) { return (r & 3) + 8 * (r >> 2) + 4 * hi; }
__device__ __forceinline__ float max3f(float a, float b, float c) { float r; asm("v_max3_f32 %0, %1, %2, %3" : "=v"(r) : "v"(a), "v"(b), "v"(c)); return r; }
__device__ __forceinline__ float max2f(float a, float b) { float r; asm("v_max_f32_e32 %0, %1, %2" : "=v"(r) : "v"(a), "v"(b)); return r; }
__device__ __forceinline__ void glds16(const void* gsrc, unsigned lds_dst) { unsigned keep;
    asm volatile("s_mov_b32 %0, m0\n\ts_mov_b32 m0, %2\n\ts_nop 0\n\tglobal_load_lds_dwordx4 %1, off\n\ts_mov_b32 m0, %0" : "=&s"(keep) : "v"(gsrc), "s"(lds_dst) : "memory"); }
typedef short v4i16_t __attribute__((ext_vector_type(4)));
__device__ __forceinline__ s16x4 vtr(const LAS unsigned char* p) { return __builtin_bit_cast(s16x4, __builtin_amdgcn_ds_read_tr16_b64_v4i16((LAS v4i16_t*)p)); }
__device__ __forceinline__ void pv(f32x16* o, const LAS unsigned char* vp, bf16x8 pa0, bf16x8 pa1, bf16x8 pa2, bf16x8 pa3) {
#pragma unroll
    for (int d0 = 0; d0 < 2; ++d0) { s16x4 lo[4], hi[4];
#pragma unroll
        for (int ks = 0; ks < 4; ++ks) { lo[ks] = vtr(vp + d0 * 4096 + ks * 1024); hi[ks] = vtr(vp + d0 * 4096 + ks * 1024 + 512); }
#define PK(k) (bf16x8){lo[k][0], lo[k][1], lo[k][2], lo[k][3], hi[k][0], hi[k][1], hi[k][2], hi[k][3]}
        o[d0] = __builtin_amdgcn_mfma_f32_32x32x16_bf16(pa0, PK(0), o[d0], 0, 0, 0);
        o[d0] = __builtin_amdgcn_mfma_f32_32x32x16_bf16(pa1, PK(1), o[d0], 0, 0, 0);
        o[d0] = __builtin_amdgcn_mfma_f32_32x32x16_bf16(pa2, PK(2), o[d0], 0, 0, 0);
        o[d0] = __builtin_amdgcn_mfma_f32_32x32x16_bf16(pa3, PK(3), o[d0], 0, 0, 0);
#undef PK
    }
}
__device__ __forceinline__ void attn_unit(Ctx& F, int b, int h, int qb) {
    const int lane = F.lane, r32 = lane & 31, hi = lane >> 5, wid = F.wave;
    const bf16* QF = WSP(bf16, WS_QF); const bf16* KF = WSP(bf16, WS_KF); const bf16* KVRAW = WSP(bf16, WS_KVRAW); bf16* O = WSP(bf16, WS_HCO) + 512;
    const size_t rowq0 = (size_t)b * SEQ + 256 * qb + 32 * wid;
    const bf16* Kh = KF + (size_t)(b * NH + h) * LPK * DQK; const bf16* Vh = KVRAW + (size_t)b * LPK * 1024 + h * 128 + 64;
    const unsigned lds0 = (unsigned)(uintptr_t)F.lds;
    const int NT = 4 * qb + 5;
    const bf16* ksrc0; const bf16* ksrc1;
    { const int row0 = 8 * wid + (lane >> 4), row1 = row0 + 4; int c0 = (lane & 15) ^ (row0 & 15), c1 = (lane & 15) ^ (row1 & 15); c0 -= (c0 >= 12) ? 4 : 0; c1 -= (c1 >= 12) ? 4 : 0;
      ksrc0 = Kh + (size_t)row0 * DQK + c0 * 8; ksrc1 = Kh + (size_t)row1 * DQK + c1 * 8; }
    const bf16* vsrc = Vh + (size_t)(16 * (wid & 3) + (lane >> 2)) * 1024 + (wid >> 2) * 32 + (lane & 3) * 8;
#define ATT_TIX(i) (((i) == 0) ? 0 : (((i) < 5) ? 4 * qb + (i) : (i) - 4))
#define ATT_DMA(i, slot) do { const int _t = ATT_TIX(i); const unsigned _s = lds0 + (slot); glds16(ksrc0 + (size_t)_t * 64 * DQK, (unsigned)__builtin_amdgcn_readfirstlane(_s + wid * 2048)); \
        glds16(ksrc1 + (size_t)_t * 64 * DQK, (unsigned)__builtin_amdgcn_readfirstlane(_s + wid * 2048 + 1024)); \
        glds16(vsrc + (size_t)_t * 64 * 1024, (unsigned)__builtin_amdgcn_readfirstlane(_s + KSLOT + wid * 1024)); } while (0)
#define ATT_BAR() asm volatile("s_waitcnt vmcnt(0) lgkmcnt(0)\n\ts_barrier" ::: "memory")
#define ATT_BARC(issued) do { if (issued) asm volatile("s_waitcnt vmcnt(3) lgkmcnt(0)\n\ts_barrier" ::: "memory"); else ATT_BAR(); } while (0)
#define ATT_KLD(slot, hh) do { const LAS unsigned char* kb_ = kp0 + (slot) + (hh) * 8192; int xk_ = xk; asm volatile("" : "+v"(xk_));     \
        _Pragma("unroll") for (int d0 = 0; d0 < 6; ++d0) kf[d0] = *(const LAS bf16x8*)(kb_ + (((2 * d0 + hi) ^ xk_) << 4)); } while (0)
#define ATT_QKM(S) do { S = __builtin_amdgcn_mfma_f32_32x32x16_bf16(kf[0], qr[0], negm, 0, 0, 0); _Pragma("unroll") for (int d0 = 1; d0 < 6; ++d0) S = __builtin_amdgcn_mfma_f32_32x32x16_bf16(kf[d0], qr[d0], S, 0, 0, 0); } while (0)
#define ATT_RMAX(S, RM) do { float a_ = max3f(S[0], S[1], S[2]), b_ = max3f(S[3], S[4], S[5]); a_ = max3f(a_, S[6], S[7]); b_ = max3f(b_, S[8], S[9]); a_ = max3f(a_, S[10], S[11]); b_ = max3f(b_, S[12], S[13]); a_ = max3f(a_, S[14], S[15]); a_ = max2f(a_, b_); \
        { const auto rr = __builtin_amdgcn_permlane32_swap(__float_as_uint(a_), __float_as_uint(a_), false, false); RM = max2f(__uint_as_float(rr[0]), __uint_as_float(rr[1])); } } while (0)
#define ATT_RESC(S, rm) do { \
        if (__any(rm > THR)) { const float dl = fmaxf(rm, 0.f), f = __builtin_amdgcn_exp2f(-dl); m_run += dl; l_run *= f; if (hi == 0) wsf[r32] = f; \
            _Pragma("unroll") for (int r = 0; r < 16; ++r) { const float fr_ = wsf[crow(r, hi)]; o[0][r] *= fr_; o[1][r] *= fr_; } \
            _Pragma("unroll") for (int r = 0; r < 16; ++r) { S[r] -= dl; negm[r] = -m_run; } } } while (0)
#define ATT_SMA(S) do { float rm_; ATT_RMAX(S, rm_); ATT_RESC(S, rm_); } while (0)
#define ATT_VLD(slot, hh) do { const LAS unsigned char* vp_ = vp0 + (slot) + (hh) * 2048; \
        _Pragma("unroll") for (int d0 = 0; d0 < 2; ++d0) _Pragma("unroll") for (int kk = 0; kk < 2; ++kk) { vl[d0 * 2 + kk] = vtr(vp_ + d0 * 4096 + kk * 1024); vh[d0 * 2 + kk] = vtr(vp_ + d0 * 4096 + kk * 1024 + 512); } } while (0)
#define ATT_VF(x) ((bf16x8){vl[x][0], vl[x][1], vl[x][2], vl[x][3], vh[x][0], vh[x][1], vh[x][2], vh[x][3]})
#define ATT_PVM(PA, PB) do { _Pragma("unroll") for (int d0 = 0; d0 < 2; ++d0) { \
            o[d0] = __builtin_amdgcn_mfma_f32_32x32x16_bf16(__builtin_bit_cast(bf16x8, PA), ATT_VF(d0 * 2), o[d0], 0, 0, 0); \
            o[d0] = __builtin_amdgcn_mfma_f32_32x32x16_bf16(__builtin_bit_cast(bf16x8, PB), ATT_VF(d0 * 2 + 1), o[d0], 0, 0, 0); } } while (0)
#define ATT_SMB(S, PA, PB) do { float sacc = 0.f; \
        _Pragma("unroll") for (int r = 0; r < 16; ++r) { S[r] = __builtin_amdgcn_exp2f(S[r]); sacc += S[r]; } \
        l_run += sacc; \
        PA = (u32x4){pk2(S[0], S[1]), pk2(S[2], S[3]), pk2(S[4], S[5]), pk2(S[6], S[7])}; PB = (u32x4){pk2(S[8], S[9]), pk2(S[10], S[11]), pk2(S[12], S[13]), pk2(S[14], S[15])}; } while (0)
#define ATT_PVH(slot, hh, PA, PB) do { const LAS unsigned char* vp_ = vp0 + (slot) + (hh) * 2048; \
        _Pragma("unroll") for (int d0 = 0; d0 < 2; ++d0) { const s16x4 l0_ = vtr(vp_ + d0 * 4096), h0_ = vtr(vp_ + d0 * 4096 + 512), l1_ = vtr(vp_ + d0 * 4096 + 1024), h1_ = vtr(vp_ + d0 * 4096 + 1536); \
            o[d0] = __builtin_amdgcn_mfma_f32_32x32x16_bf16(__builtin_bit_cast(bf16x8, PA), ((bf16x8){l0_[0], l0_[1], l0_[2], l0_[3], h0_[0], h0_[1], h0_[2], h0_[3]}), o[d0], 0, 0, 0); \
            o[d0] = __builtin_amdgcn_mfma_f32_32x32x16_bf16(__builtin_bit_cast(bf16x8, PB), ((bf16x8){l1_[0], l1_[1], l1_[2], l1_[3], h1_[0], h1_[1], h1_[2], h1_[3]}), o[d0], 0, 0, 0); } } while (0)
    ATT_DMA(0, 0); ATT_DMA(1, SLOT); if (2 < NT) ATT_DMA(2, 2 * SLOT);
    bf16x8 qr[6], kf[6];
    { const bf16* Qw = QF + (rowq0 + r32) * 768 + h * DQK + hi * 8;
#pragma unroll
        for (int d0 = 0; d0 < 6; ++d0) qr[d0] = *(const bf16x8*)(Qw + 16 * d0); }
    LAS float* wsf = (LAS float*)(F.lds + L_WS) + wid * 64;
    float m_run = 0.f, l_run = 0.f; f32x16 o[2]; o[0] = f32x16{}; o[1] = f32x16{}; f32x16 negm = f32x16{};
    const LAS unsigned char* kp0 = F.lds + r32 * 256;
    const int xk = r32 & 15;
    const LAS unsigned char* vp0 = F.lds + KSLOT + ((lane >> 4) & 1) * 32 + (lane & 3) * 8 + (4 * hi + ((lane & 15) >> 2)) * 64;
    u32x4 pw0, pw1; f32x16 sa, sb;
    ATT_BAR();
    int sl = 0, sl3 = 3 * SLOT;
#define ATT_ROT() do { sl = (sl == 3 * SLOT) ? 0 : sl + SLOT; sl3 = (sl3 == 3 * SLOT) ? 0 : sl3 + SLOT; } while (0)
#pragma unroll 1
    for (int i = 0; i < 5; ++i) {
        if (i + 3 < NT) ATT_DMA(i + 3, sl3);
        const int jb = i - 1;
#pragma unroll
        for (int hh = 0; hh < 2; ++hh) {
            const bool skip = (i == 0) ? (hh == 1) : (64 * jb + 32 * hh > 32 * wid + 31);
            if (!skip) {
                ATT_KLD(sl, hh); ATT_QKM(sa);
                if (i == 0) {
#pragma unroll
                    for (int r = 0; r < 16; ++r) if (crow(r, hi) >= NMETA) sa[r] = -INFINITY;
                } else if (64 * jb + 32 * hh + 31 > 32 * wid) {
                    const int qrel = 32 * wid + r32 - 64 * jb - 32 * hh;
#pragma unroll
                    for (int r = 0; r < 16; ++r) if (crow(r, hi) > qrel) sa[r] = -INFINITY;
                }
                ATT_SMA(sa); ATT_SMB(sa, pw0, pw1); ATT_PVH(sl, hh, pw0, pw1);
            }
        }
        ATT_BARC(i + 3 < NT); ATT_ROT();
    }
    if (NT > 5) {
        s16x4 vl[4], vh[4]; float rm;
        ATT_KLD(sl, 0); ATT_QKM(sa);
        ATT_KLD(sl, 1); __builtin_amdgcn_sched_barrier(0);
        ATT_RMAX(sa, rm); ATT_RESC(sa, rm);
        ATT_QKM(sb); ATT_SMB(sa, pw0, pw1);
        ATT_VLD(sl, 0);
#pragma unroll 1
        for (int i = 5; i < NT - 1; ++i) {
            if (i + 3 < NT) ATT_DMA(i + 3, sl3);
            const int sln = (sl == 3 * SLOT) ? 0 : sl + SLOT;
            ATT_KLD(sln, 0); __builtin_amdgcn_sched_barrier(0);
            ATT_PVM(pw0, pw1); ATT_RMAX(sb, rm);
            ATT_RESC(sb, rm);
            ATT_QKM(sa); ATT_SMB(sb, pw0, pw1);
            ATT_VLD(sl, 1);
            ATT_BARC(i + 3 < NT); ATT_ROT();
            ATT_KLD(sl, 1); __builtin_amdgcn_sched_barrier(0);
            ATT_PVM(pw0, pw1); ATT_RMAX(sa, rm);
            ATT_RESC(sa, rm);
            ATT_QKM(sb); ATT_SMB(sa, pw0, pw1);
            ATT_VLD(sl, 0);
        }
        ATT_PVM(pw0, pw1); ATT_RMAX(sb, rm);
        ATT_RESC(sb, rm);
        ATT_SMB(sb, pw0, pw1);
        ATT_VLD(sl, 1);
        ATT_PVM(pw0, pw1);
        ATT_BAR();
    }
    { const auto rr = __builtin_amdgcn_permlane32_swap(__float_as_uint(l_run), __float_as_uint(l_run), false, false); l_run = __uint_as_float(rr[0]) + __uint_as_float(rr[1]); }
    if (hi == 0) wsf[32 + r32] = l_run;
    float rli[16];
#pragma unroll
    for (int r = 0; r < 16; ++r) rli[r] = __builtin_amdgcn_rcpf(wsf[32 + crow(r, hi)]);
    { LAS bf16* stg = (LAS bf16*)(F.lds + L_OST) + wid * 2048;
#pragma unroll
        for (int r = 0; r < 16; ++r) { const int orow = crow(r, hi);
#pragma unroll
            for (int d0 = 0; d0 < 2; ++d0) stg[orow * 64 + d0 * 32 + r32] = (bf16)f2bf(o[d0][r] * rli[r]); }
        asm volatile("s_waitcnt lgkmcnt(0)" ::: "memory");
#pragma unroll
        for (int i = 0; i < 4; ++i) { const int row = i * 8 + (lane >> 3), ch = lane & 7; const u32x4 v = *(const LAS u32x4*)(stg + row * 64 + ch * 8);
            *(u32x4*)(O + (rowq0 + row) * 1024 + h * DV + ch * 8) = v; } }
    asm volatile("s_waitcnt lgkmcnt(0)\n\ts_barrier" ::: "memory");
#undef ATT_TIX
#undef ATT_DMA
#undef ATT_BAR
#undef ATT_BARC
#undef ATT_KLD
#undef ATT_QKM
#undef ATT_SMA
#undef ATT_RMAX
#undef ATT_RESC
#undef ATT_VLD
#undef ATT_VF
#undef ATT_PVM
#undef ATT_SMB
#undef ATT_PVH
#undef ATT_ROT
}
__device__ __forceinline__ void attn_phase(Ctx& F) {
    for (int v = F.vcu; v < 256; v += F.G) { const int bh = v >> 2, s = v & 3;
#pragma unroll 1
        for (int i = 0; i < 4; ++i) { const int qb = (i == 0) ? s : (i == 1) ? 7 - s : (i == 2) ? 8 + s : 15 - s; attn_unit(F, bh >> 3, bh & 7, qb); } }
}
}

__device__ __forceinline__ void p8_router(Ctx& F) {
    LAS float* xch = (LAS float*)F.lds;
    volatile LAS int* cnt_l = (volatile LAS int*)(F.lds + LDSCTL_OFF + 1024); volatile LAS int* base_l = cnt_l + 32;
    const bf16* H1 = WSP(bf16, WS_H1B);
    int* gcount = (int*)(F.ctl + CW_CNT); int* LTOK = WSP(int, WS_LTOK); float* LW = WSP(float, WS_LW); float* LRS = WSP(float, WS_LRS); int* TOKPOS = WSP(int, WS_TOKPOS);
    for (int un = F.vcu; un < MT / 128; un += F.G) {
        if (F.tid < 32) cnt_l[F.tid] = 0;
        const int j = F.lane & 31, kh = F.lane >> 5, grp = F.wave & 3, kq = F.wave >> 2; const int token = un * 128 + 32 * grp + j;
        int te[4] = {0, 0, 0, 0}, sl[4] = {0, 0, 0, 0}; float tg[4] = {0.f, 0.f, 0.f, 0.f}; float rstd = 0.f;
        f32x16 acc = f32x16{}; float ss = 0.f;
        { const bf16* row = H1 + (size_t)token * DM + 512 * kq + 32 * kh;
          const bf16* a0 = WSP(bf16, WS_RW3) + ((size_t)(64 * kq + 4 * kh) * NE + j) * 8;
#pragma unroll 4
            for (int st = 0; st < 32; ++st) { const u32x4 hw = *(const u32x4*)(row + 64 * (st >> 2) + 8 * (st & 3)); f32x4 h0, h1; unpack8(hw, h0, h1);
                ss += ((h0[0] * h0[0] + h0[1] * h0[1]) + (h0[2] * h0[2] + h0[3] * h0[3])) + ((h1[0] * h1[0] + h1[1] * h1[1]) + (h1[2] * h1[2] + h1[3] * h1[3]));
                const bf16x8 hb = __builtin_bit_cast(bf16x8, hw);
                const int ao = (8 * (st >> 2) + (st & 3)) * (NE * 8);
                const bf16x8 ah = *(const bf16x8*)(a0 + ao), am = *(const bf16x8*)(a0 + (size_t)NE * DM + ao), al = *(const bf16x8*)(a0 + (size_t)2 * NE * DM + ao);
                acc = __builtin_amdgcn_mfma_f32_32x32x16_bf16(al, hb, acc, 0, 0, 0); acc = __builtin_amdgcn_mfma_f32_32x32x16_bf16(am, hb, acc, 0, 0, 0); acc = __builtin_amdgcn_mfma_f32_32x32x16_bf16(ah, hb, acc, 0, 0, 0); } }
        if (kq == 1) { LAS float* xp = xch + grp * 17 * 64 + F.lane;
#pragma unroll
            for (int r = 0; r < 16; ++r) xp[r * 64] = acc[r];
            xp[16 * 64] = ss; }
        __syncthreads();
        if (kq == 0) {
            { const LAS float* xp = xch + grp * 17 * 64 + F.lane;
#pragma unroll
                for (int r = 0; r < 16; ++r) acc[r] += xp[r * 64];
                ss += xp[16 * 64]; }
            ss += __shfl_xor(ss, 32);
            rstd = 1.f / sqrtf(ss * (1.f / DM) + NORM_EPS);
            float cv[8]; int ci[8];
            float lv[16];
#pragma unroll
            for (int r = 0; r < 16; ++r) lv[r] = acc[r] * rstd + F.router_b[att::crow(r, kh)];
#pragma unroll
            for (int k = 0; k < 4; ++k) { float bv = -INFINITY; int bi = 0;
#pragma unroll
                for (int r = 0; r < 16; ++r) { const bool better = lv[r] > bv; bv = better ? lv[r] : bv; bi = better ? r : bi; }
#pragma unroll
                for (int r = 0; r < 16; ++r) if (r == bi) lv[r] = -INFINITY;
                cv[k] = bv; ci[k] = att::crow(bi, kh); }
#pragma unroll
            for (int k = 0; k < 4; ++k) { cv[4 + k] = __shfl_xor(cv[k], 32); ci[4 + k] = __shfl_xor(ci[k], 32); }
#pragma unroll
            for (int k = 0; k < 4; ++k) { float bv = -INFINITY; int bi = 1 << 20, bp = 0;
#pragma unroll
                for (int c = 0; c < 8; ++c) { const bool better = (cv[c] > bv) || (cv[c] == bv && ci[c] < bi); bv = better ? cv[c] : bv; bi = better ? ci[c] : bi; bp = better ? c : bp; }
#pragma unroll
                for (int c = 0; c < 8; ++c) if (c == bp) cv[c] = -INFINITY;
                tg[k] = bv; te[k] = bi; }
            { const float e1 = __expf(tg[1] - tg[0]), e2 = __expf(tg[2] - tg[0]), e3 = __expf(tg[3] - tg[0]); const float inv = 1.f / (1.f + e1 + e2 + e3); tg[0] = inv; tg[1] = e1 * inv; tg[2] = e2 * inv; tg[3] = e3 * inv; }
            if (kh == 0) {
#pragma unroll
                for (int k = 0; k < 4; ++k) sl[k] = __hip_atomic_fetch_add((LAS int*)&cnt_l[te[k]], 1, __ATOMIC_RELAXED, __HIP_MEMORY_SCOPE_WORKGROUP); }
        }
        __syncthreads();
        if (F.tid < 32) base_l[F.tid] = atomicAdd(gcount + F.tid, cnt_l[F.tid]);
        __syncthreads();
        if (kq == 0 && kh == 0) {
#pragma unroll
            for (int k = 0; k < 4; ++k) { const int slot = base_l[te[k]] + sl[k]; const size_t li = (size_t)te[k] * ECAP + slot;
                LTOK[li] = token; LW[li] = tg[k]; LRS[li] = rstd; TOKPOS[token * 4 + k] = te[k] * ECAP + slot; } }
        __syncthreads();
    }
}

__device__ __forceinline__ void moe_table(Ctx& F) {
    volatile LAS int* tb = (volatile LAS int*)(F.lds + LDSCTL_OFF); volatile LAS int* cnt = (volatile LAS int*)(F.lds + LDSCTL_OFF + 256);
    if (F.tid < 64) { const int* gcount = (const int*)(F.ctl + CW_CNT); const int c = (F.lane < NE) ? gcount[F.lane] : 0; const int nt = (c + 255) >> 8;
        int incl = nt;
#pragma unroll
        for (int o = 1; o < 32; o <<= 1) { const int v = __shfl_up(incl, o); if ((F.lane & 31) >= o) incl += v; }
        if (F.lane < NE) { cnt[F.lane] = c; tb[F.lane] = incl - nt; if (F.lane == NE - 1) tb[NE] = incl; } }
    __syncthreads();
    { const int TT = tb[NE];
      for (int mt = F.tid; mt < TT; mt += 512) { int e = 0;
#pragma unroll
          for (int st = 16; st >= 1; st >>= 1) if (e + st < NE && tb[e + st] <= mt) e += st;
          tb[512 + mt] = e; } }
    __syncthreads();
}

__device__ __forceinline__ void p11_combine(Ctx& F) {
    const volatile LAS int* tb = (const volatile LAS int*)(F.lds + LDSCTL_OFF);
    const int gw = F.vcu * 8 + F.wave, NGW = F.G * 8;
    const bf16* H1 = WSP(bf16, WS_H1B); const unsigned char* Y = WSP(unsigned char, WS_Y); const int* TOKPOS = WSP(int, WS_TOKPOS);
    typedef int i32x4v __attribute__((ext_vector_type(4)));
    const i32x4v* TP4 = (const i32x4v*)TOKPOS;
    i32x4v tp[2]; { const int m0 = gw, m1 = gw + NGW; tp[0] = TP4[m0 < MT ? m0 : 0]; tp[1] = TP4[m1 < MT ? m1 : 0]; }
    for (int mb = gw; mb < MT; mb += 2 * NGW) {
        i32x4v tn[2]; { const int n0 = mb + 2 * NGW, n1 = mb + 3 * NGW; tn[0] = TP4[n0 < MT ? n0 : 0]; tn[1] = TP4[n1 < MT ? n1 : 0]; }
        u32x4 hw[2][2], yw[2][4];
#pragma unroll
        for (int q = 0; q < 2; ++q) { const int m = mb + q * NGW; const int mm = m < MT ? m : mb;
            const u32x4* hp = (const u32x4*)(H1 + (size_t)mm * DM + 16 * F.lane); hw[q][0] = __builtin_nontemporal_load(hp); hw[q][1] = __builtin_nontemporal_load(hp + 1);
#pragma unroll
            for (int k = 0; k < 4; ++k) { const int p = tp[q][k], e = p >> 15, slot = p & (ECAP - 1); const size_t yr = (size_t)tb[e] * 256 + slot;
                yw[q][k] = __builtin_nontemporal_load((const u32x4*)(Y + yr * DM + 16 * F.lane)); } }
#pragma unroll
        for (int q = 0; q < 2; ++q) { const int m = mb + q * NGW; if (m < MT) {
            f32x4 a0, a1, a2, a3; unpack8(hw[q][0], a0, a1); unpack8(hw[q][1], a2, a3);
            f32x4 s0 = {0.f, 0.f, 0.f, 0.f}, s1 = s0, s2 = s0, s3 = s0;
#pragma unroll
            for (int k = 0; k < 4; ++k) { const u32x4 y = yw[q][k];
                { const f32x2 p0 = __builtin_amdgcn_cvt_pk_f32_fp8((int)y.x, false), p1 = __builtin_amdgcn_cvt_pk_f32_fp8((int)y.x, true); s0[0] += p0[0]; s0[1] += p0[1]; s0[2] += p1[0]; s0[3] += p1[1]; }
                { const f32x2 p0 = __builtin_amdgcn_cvt_pk_f32_fp8((int)y.y, false), p1 = __builtin_amdgcn_cvt_pk_f32_fp8((int)y.y, true); s1[0] += p0[0]; s1[1] += p0[1]; s1[2] += p1[0]; s1[3] += p1[1]; }
                { const f32x2 p0 = __builtin_amdgcn_cvt_pk_f32_fp8((int)y.z, false), p1 = __builtin_amdgcn_cvt_pk_f32_fp8((int)y.z, true); s2[0] += p0[0]; s2[1] += p0[1]; s2[2] += p1[0]; s2[3] += p1[1]; }
                { const f32x2 p0 = __builtin_amdgcn_cvt_pk_f32_fp8((int)y.w, false), p1 = __builtin_amdgcn_cvt_pk_f32_fp8((int)y.w, true); s3[0] += p0[0]; s3[1] += p0[1]; s3[2] += p1[0]; s3[3] += p1[1]; } }
            a0 += s0 * Y8_INV; a1 += s1 * Y8_INV; a2 += s2 * Y8_INV; a3 += s3 * Y8_INV;
            f32x4* op = (f32x4*)(F.out + (size_t)m * DM + 16 * F.lane); op[0] = a0; op[1] = a1; op[2] = a2; op[3] = a3; } }
        tp[0] = tn[0]; tp[1] = tn[1];
    }
}

#define LDS_TB ((const volatile LAS int*)(F.lds + LDSCTL_OFF))
#define LDS_CNT ((const volatile LAS int*)(F.lds + LDSCTL_OFF + 256))
__device__ __forceinline__ void ph1_inproj(Ctx& F) { p1_meta(F);
    pg8::Dense P; P.init(WSP(bf16, INPROJ_FP8 ? WS_XQ : WS_XN), WSP(bf16, WS_WIN), MT, NINP, INPROJ_FP8 ? DM / 2 : DM, F.G, (int)blockIdx.x);
    EpiInProj E{WSP(bf16, WS_HG), WSP(bf16, WS_QLAT), WSP(bf16, WS_KVLAT), WSP(bf16, WS_G), WSP(bf16, WS_G) + (size_t)MT * 1024, F.gate_b, WSP(float, WS_KPESS), WSP(float, WS_RSX), WSP(float, WS_RSQ), WSP(float, WS_RSC)};
    pg8::gemm_phase<pg8::Dense, EpiInProj, INPROJ_FP8 != 0>(F.lds, P, E); }
#ifndef PROBE_P3
#define PROBE_P3 0
#endif
__device__ __forceinline__ void ph3_smallgemms(Ctx& F) { p2_thin(F); p4_headnorm(F);
#if PROBE_P3 == 1
    __syncthreads(); p2_thin(F); p4_headnorm(F);
#endif
    { pg8::Dense P; P.init(WSP(bf16, WS_QLAT), WSP(bf16, WS_WQB), MT, 1024, 256, F.G, (int)blockIdx.x); EpiQHead E{WSP(bf16, WS_QF), WSP(float, WS_RSQ), F.q_nw, WSP(float, WS_ROPE), F.lds}; pg8::gemm_phase(F.lds, P, E); }
    { pg8::Dense P; P.init(WSP(bf16, WS_KVLAT), WSP(bf16, WS_WKVB), MT, 1024, 256, F.G, (int)blockIdx.x); EpiKVHead E{WSP(bf16, WS_KF), WSP(bf16, WS_KVRAW), WSP(bf16, WS_KVLAT), WSP(float, WS_RSC), WSP(float, WS_KPESS), F.k_nw, WSP(float, WS_ROPE), F.lds}; pg8::gemm_phase(F.lds, P, E); }
 }
__device__ __forceinline__ void ph6_wo(Ctx& F) { pg8::Dense P; P.init(WSP(bf16, WS_HCO), WSP(bf16, WS_W2T), MT, 1024, 1024, F.G, (int)blockIdx.x); EpiMix E{WSP(bf16, WS_MIX), WSP(bf16, WS_G), WSP(bf16, WS_G) + (size_t)MT * 1024}; pg8::gemm_phase<pg8::Dense, EpiMix, false, true>(F.lds, P, E); }
__device__ __forceinline__ void ph7_wout(Ctx& F) { pg8::Dense P; P.init(WSP(bf16, WS_MIX), WSP(bf16, WS_WOUT), MT, 1024, 1024, F.G, (int)blockIdx.x); EpiResid E{WSP(bf16, WS_XN), WSP(bf16, WS_H1B), WSP(unsigned char, WS_H1Q)}; pg8::gemm_phase<pg8::Dense, EpiResid, false, true>(F.lds, P, E); }
__device__ __forceinline__ void ph9_moe1(Ctx& F) { moe_table(F);
    pg8::Moe<true> P{WSP(bf16, WS_H1Q), WSP(bf16, WS_WGU), DM / 2, 8, F.G, F.vcu, WSP(int, WS_LTOK), LDS_TB, LDS_CNT};
    EpiSwiGLU E{WSP(unsigned char, WS_ACT), F.b_gu, WSP(float, WS_LRS), LDS_TB}; pg8::gemm_phase<pg8::Moe<true>, EpiSwiGLU, true>(F.lds, P, E); }
__device__ __forceinline__ void ph10_moe2(Ctx& F) {
#if !MK_ONE_LAUNCH
    moe_table(F);
#endif
    pg8::Moe<false> P{WSP(bf16, WS_ACT), WSP(bf16, WS_WD), DFF / 2, 4, F.G, F.vcu, nullptr, LDS_TB, LDS_CNT};
    EpiDown E{WSP(unsigned char, WS_Y), F.b_d, WSP(float, WS_LW), LDS_TB}; pg8::gemm_phase<pg8::Moe<false>, EpiDown, true, true>(F.lds, P, E); }
__device__ __forceinline__ void ph11_combine(Ctx& F) {
#if !MK_ONE_LAUNCH
    moe_table(F);
#endif
    p11_combine(F); }

struct Args { const float* in[25]; float* out; unsigned char* ws; int ph_lo, ph_hi; };
__global__ void __launch_bounds__(512, 2) mk_fwd(Args args) {
    extern __shared__ __attribute__((aligned(16))) unsigned char lds_raw[];
    Ctx F;
    F.lds = (LAS unsigned char*)lds_raw; F.ws = args.ws; F.ctl = (gu32*)(args.ws + WS_CTL);
    F.tid = threadIdx.x; F.lane = F.tid & 63; F.wave = __builtin_amdgcn_readfirstlane(F.tid >> 6);
    F.G = gridDim.x; { const int bx = blockIdx.x; F.vcu = (F.G % 8 == 0) ? (bx % 8) * (F.G / 8) + bx / 8 : bx; }
    F.x = args.in[0]; F.meta = args.in[1]; F.attn_nw = args.in[2]; F.w_in = args.in[3]; F.dw_w = args.in[4]; F.dw_b = args.in[5]; F.ln_w = args.in[6]; F.ln_b = args.in[7]; F.pw2_w = args.in[8];
    F.qa_nw = args.in[9]; F.w_qb = args.in[10]; F.kva_nw = args.in[11]; F.w_kvb = args.in[12]; F.q_nw = args.in[13]; F.k_nw = args.in[14]; F.w_o = args.in[15]; F.gate_b = args.in[16]; F.w_out = args.in[17];
    F.ffn_nw = args.in[18]; F.router_w = args.in[19]; F.router_b = args.in[20]; F.w_gu = args.in[21]; F.b_gu = args.in[22]; F.w_d = args.in[23]; F.b_d = args.in[24]; F.out = args.out;
    for (int u = F.tid; u < (LDS_BYTES - LDSCTL_OFF) / 4; u += 512) ((LAS unsigned*)(F.lds + LDSCTL_OFF))[u] = 0u;
    __syncthreads();
    const int lo = args.ph_lo, hi = args.ph_hi;
    XcdBarrier bar; bar.bar = (unsigned*)(F.ctl + CW_BAR); bar.x = 0; bar.st = nullptr;
    if (hi - lo > 1) bar = xcd_barrier_post((unsigned*)(F.ctl + CW_BAR), (volatile LAS unsigned*)(F.lds + LDSCTL_OFF + 512));
#ifdef ONLY_PHASE
#define IN(k) ((k) == ONLY_PHASE && lo <= (k) && (k) < hi)
#else
#define IN(k) (lo <= (k) && (k) < hi)
#endif
#define SEAM(k) do { if (IN(k) && IN((k) + 1)) xcd_barrier(bar); } while (0)
#if USE_REFRESH
#define REFRESH() do { int _t = threadIdx.x; asm volatile("" : "+v"(_t)); F.tid = _t; F.lane = _t & 63; F.wave = __builtin_amdgcn_readfirstlane(_t >> 6); } while (0)
#else
#define REFRESH() do { } while (0)
#endif
#define PHASE(k, call) do { if (IN(k)) { REFRESH(); call; if (PROBE_REPEAT == (k)) { xcd_barrier(bar); call; } } SEAM(k); } while (0)

    PHASE(0, p0_prologue(F));
    PHASE(1, ph1_inproj(F));
    PHASE(3, ph3_smallgemms(F));
    PHASE(5, att::attn_phase(F));
    PHASE(6, ph6_wo(F));
    PHASE(7, ph7_wout(F));
#if PROBE_REPEAT == 8
    if (IN(8)) { REFRESH(); p8_router(F); xcd_barrier(bar); if (blockIdx.x == 0 && F.tid < NE) ((int*)(F.ctl + CW_CNT))[F.tid] = 0; xcd_barrier(bar); p8_router(F); } SEAM(8);
#else
    PHASE(8, p8_router(F));
#endif
    PHASE(9, ph9_moe1(F));
    PHASE(10, ph10_moe2(F));
    PHASE(11, ph11_combine(F));
#undef IN
#undef SEAM
#undef PHASE
}

extern "C" void kernel_launch(void* const* d_in, const int* in_sizes, int n_in, void* d_out, int out_size, void* d_ws, size_t ws_size, hipStream_t stream) {
    static int grid = 0;
    if (grid == 0) {
        if (n_in != 25 || in_sizes[0] != MT * DM || out_size != MT * DM || ws_size < WS_END) { fprintf(stderr, "kernel_launch: unexpected shapes (n_in %d, in0 %d, out %d, ws %zu < %zu); nothing launched\n", n_in, n_in > 0 ? in_sizes[0] : -1, out_size, ws_size, (size_t)WS_END); grid = -1; return; }
        int dev = 0, cus = 0, per_cu = 0;
        if (hipGetDevice(&dev) != hipSuccess || hipDeviceGetAttribute(&cus, hipDeviceAttributeMultiprocessorCount, dev) != hipSuccess) { grid = -1; return; }
        if (hipFuncSetAttribute((const void*)mk_fwd, hipFuncAttributeMaxDynamicSharedMemorySize, LDS_BYTES) != hipSuccess) { fprintf(stderr, "kernel_launch: hipFuncSetAttribute failed\n"); grid = -1; return; }
        if (hipOccupancyMaxActiveBlocksPerMultiprocessor(&per_cu, (const void*)mk_fwd, 512, LDS_BYTES) != hipSuccess || per_cu < 1) fprintf(stderr, "kernel_launch: note: occupancy query reports %d\n", per_cu);
        (void)hipGetLastError();
        grid = cus;
    }
    if (grid < 0) return;
    if (hipMemsetAsync((char*)d_ws + WS_CTL, 0, CTL_ZERO_BYTES, stream) != hipSuccess) return;
    Args a{};
    for (int i = 0; i < 25; ++i) a.in[i] = (const float*)d_in[i];
    a.out = (float*)d_out; a.ws = (unsigned char*)d_ws;
#if MK_ONE_LAUNCH
    a.ph_lo = 0; a.ph_hi = NPH;
    hipLaunchKernelGGL(mk_fwd, dim3(grid), dim3(512), LDS_BYTES, stream, a);
#else
    for (int p = 0; p < NPH; ++p) { a.ph_lo = p; a.ph_hi = p + 1; hipLaunchKernelGGL(mk_fwd, dim3(grid), dim3(512), LDS_BYTES, stream, a); }
#endif
}
```

```cpp
#include <hip/hip_runtime.h>
#include <cstdio>
#include <cstdint>

#define GAS __attribute__((address_space(1)))
#define LAS __attribute__((address_space(3)))
typedef unsigned short bf16;
typedef unsigned u32x4 __attribute__((ext_vector_type(4)));
typedef unsigned u32x2 __attribute__((ext_vector_type(2)));
typedef float f32x2 __attribute__((ext_vector_type(2)));
typedef float f32x4 __attribute__((ext_vector_type(4)));
typedef float f32x16 __attribute__((ext_vector_type(16)));
typedef short bf16x8 __attribute__((ext_vector_type(8)));
typedef short s16x4 __attribute__((ext_vector_type(4)));
typedef int i32x4 __attribute__((ext_vector_type(4)));
typedef int i32x8 __attribute__((ext_vector_type(8)));
typedef GAS unsigned gu32;

#ifndef PROBE_REPEAT
#define PROBE_REPEAT (-1)
#endif
#ifndef INPROJ_FP8
#define INPROJ_FP8 1
#endif
#ifndef PROBE_KLOOP2
#define PROBE_KLOOP2 0
#endif
#ifndef USE_REFRESH
#define USE_REFRESH 0
#endif
#ifndef RELAX_WAITS
#define RELAX_WAITS 0
#endif
#ifndef PROBE_EPI2
#define PROBE_EPI2 0
#endif
#ifndef PROBE_P2A
#define PROBE_P2A 0
#endif
#ifndef PROBE_P2B
#define PROBE_P2B 0
#endif
#ifndef MK_ONE_LAUNCH
#define MK_ONE_LAUNCH 1
#endif

constexpr int NB = 8, SEQ = 4096, DM = 1024, MT = NB * SEQ;
constexpr int NMETA = 16;
constexpr int CDIM = 512, CWID = 31;
constexpr int NH = 8, DNOPE = 64, DROPE = 32, DQK = 96, DV = 64, QLR = 256, KVLR = 128;
constexpr int INC = 3488, NINP = 3584;
constexpr int NE = 32, DFF = 1024, ECAP = 32768;
constexpr int LPC = 4128, HGOFF = 32;
constexpr int LPK = 4160, KOFF = 64;
constexpr int PMC = 1184;
constexpr float NORM_EPS = 1e-6f;
constexpr float SW_LIMIT = 7.0f, SW_ALPHA = 1.702f;
constexpr float QSCALE = 0.10206207261596577f * 1.4426950408889634f;
constexpr int NPH = 12;

constexpr size_t MiB = 1u << 20;
constexpr size_t WS_CTL = 0, CTL_ZERO_BYTES = 64 * 1024;
constexpr int CW_TMO = 0, CW_CODE = 1, CW_BAR = 4096, CW_CNT = 8192, CW_PM = 16384;
constexpr size_t WS_METARS = 1 * MiB;
constexpr size_t WS_KVMETA = 1 * MiB + 4096;
constexpr size_t WS_ROPE = 1 * MiB + 512 * 1024;
constexpr size_t WS_RSQ = 156 * MiB, WS_RSC = 157 * MiB;
constexpr size_t WS_KPESS = 2 * MiB + 384 * 1024;
constexpr size_t WS_RWP = 2 * MiB + 512 * 1024;
constexpr size_t WS_RW3 = 2 * MiB + 768 * 1024;
constexpr size_t WS_TOKPOS = 3 * MiB;
constexpr size_t WS_LTOK = 4 * MiB, WS_LW = 8 * MiB, WS_LRS = 12 * MiB;
constexpr size_t WS_WIN = 16 * MiB, WS_WPW2 = 23 * MiB, WS_WQB = 24 * MiB, WS_WKVB = 24 * MiB + 512 * 1024, WS_WO = 25 * MiB, WS_WOUT = 26 * MiB;
constexpr size_t WS_WGU = 28 * MiB, WS_WD = 92 * MiB;
constexpr size_t WS_XQ = 124 * MiB;
constexpr float XQ_SCALE = 16.f;
constexpr size_t WS_H1Q = 124 * MiB;
constexpr size_t WS_W2T = 220 * MiB, WS_H1B = 348 * MiB;
constexpr size_t WS_BIG = 412 * MiB;
constexpr size_t WS_ACT = WS_BIG, WS_Y = WS_BIG + 273 * MiB;
constexpr size_t WS_XN = WS_BIG + 289 * MiB, WS_QF = WS_BIG;
constexpr size_t WS_RSX = 2 * MiB + 640 * 1024;
constexpr size_t WS_G = WS_BIG + 64 * MiB, WS_HG = WS_BIG + 192 * MiB, WS_MIX = WS_BIG + 192 * MiB;
constexpr size_t WS_QLAT = WS_BIG + 225 * MiB, WS_KVLAT = WS_BIG + 241 * MiB, WS_HC = WS_BIG + 257 * MiB;
constexpr size_t WS_QRAW = WS_BIG + 289 * MiB, WS_KVRAW = WS_BIG + 353 * MiB, WS_HCO = WS_BIG + 418 * MiB, WS_KF = WS_BIG + 482 * MiB;
constexpr size_t WS_PMP = WS_BIG + 564 * MiB, WS_PMF = WS_BIG + 565 * MiB;
constexpr size_t WS_END = WS_BIG + 566 * MiB;
static_assert(WS_Y + (size_t)139520 * 2048 <= WS_END && WS_HG + (size_t)NB * LPC * CDIM * 2 <= WS_QLAT && WS_KVRAW + (size_t)NB * LPK * 2048 <= WS_HCO && WS_KF + (size_t)NB * LPK * 1536 <= WS_BIG + 531 * MiB, "ws map");

constexpr int RING_BYTES = 131072;
constexpr int LDSCTL_OFF = RING_BYTES;
constexpr int LDS_BYTES = 147456;

#define RLX_AGENT __ATOMIC_RELAXED, __HIP_MEMORY_SCOPE_AGENT
#define LDS_WAIT() asm volatile("s_waitcnt lgkmcnt(0)" ::: "memory")
#define VM_WAIT() asm volatile("s_waitcnt vmcnt(0)" ::: "memory")
__device__ __forceinline__ unsigned f2bf(float f) { unsigned u = __builtin_bit_cast(unsigned, f); return (u + 0x7fffu + ((u >> 16) & 1u)) >> 16; }
typedef __bf16 hwbf16x2 __attribute__((ext_vector_type(2)));
__device__ __forceinline__ unsigned pk2(float lo, float hi) { const f32x2 v = {lo, hi}; return __builtin_bit_cast(unsigned, __builtin_convertvector(v, hwbf16x2)); }
__device__ __forceinline__ float bflo(unsigned w) { return __builtin_bit_cast(float, w << 16); }
__device__ __forceinline__ float bfhi(unsigned w) { return __builtin_bit_cast(float, w & 0xffff0000u); }
constexpr float Y8_SCALE = 8.f, Y8_INV = 1.f / 8.f;
constexpr float W8_SCALE = 64.f, W8_INV = 1.f / 64.f;
__device__ __forceinline__ unsigned pk4_fp8(float a, float b, float c, float d) { int v = __builtin_amdgcn_cvt_pk_fp8_f32(a, b, 0, false); v = __builtin_amdgcn_cvt_pk_fp8_f32(c, d, v, true); return (unsigned)v; }
__device__ __forceinline__ float sigmoid_f(float x) { return __builtin_amdgcn_rcpf(1.f + __expf(-x)); }
__device__ __forceinline__ float sum16(float v) {
#pragma unroll
    for (int o = 1; o < 16; o <<= 1) v += __shfl_xor(v, o);
    return v;
}
__device__ __forceinline__ float wave_sum(float v) {
#pragma unroll
    for (int o = 1; o < 64; o <<= 1) v += __shfl_xor(v, o);
    return v;
}

#define XB_TMO      128
#define XB_XCNT(j)  (256  + 64 * (j))
#define XB_XSUB(j)  (1280 + 64 * (j))
#define XB_XGEN(j)  (2304 + 64 * (j))
#define XB_TOP      3328
#define XB_TOPGEN   3392
#define XCD_BAR_WORDS 3456
#define XB_SPIN_CAP (1u << 18)
__device__ __forceinline__ unsigned xb_ld(unsigned* p)              { return __hip_atomic_load(p, __ATOMIC_RELAXED, __HIP_MEMORY_SCOPE_AGENT); }
__device__ __forceinline__ unsigned xb_add(unsigned* p, unsigned v) { return __hip_atomic_fetch_add(p, v, __ATOMIC_RELAXED, __HIP_MEMORY_SCOPE_AGENT); }
__device__ __forceinline__ unsigned xb_xcc_id() { return (unsigned)__builtin_amdgcn_s_getreg((3 << 11) | 20) & 0xFu; }
#define XB_SPIN(cond, bar) do { unsigned _sp = 0; while (cond) { __builtin_amdgcn_s_sleep(1); \
    if ((++_sp & 255u) == 0u) { if (xb_ld(&(bar)[XB_TMO])) break; if (_sp > XB_SPIN_CAP) { atomicAdd(&(bar)[XB_TMO], 1u); break; } } } } while (0)
struct XcdBarrier { unsigned* bar; unsigned x; volatile LAS unsigned* st; };
__device__ __forceinline__ XcdBarrier xcd_barrier_post(unsigned* bar, volatile LAS unsigned* st) {
    XcdBarrier b; b.bar = bar; b.x = xb_xcc_id(); b.st = st;
    if (threadIdx.x == 0) (void)xb_add(&bar[XB_XCNT(b.x)], 1u);
    return b;
}
__device__ __forceinline__ void xcd_barrier_complete(unsigned* bar, unsigned x, unsigned& nloc, unsigned& nx) {
    const unsigned G = gridDim.x * gridDim.y * gridDim.z;
    unsigned sum, cnt, mine, sp = 0u;
    for (;;) {
        sum = 0u; cnt = 0u; mine = 0u;
#pragma unroll
        for (unsigned j = 0; j < 16; ++j) { const unsigned c = xb_ld(&bar[XB_XCNT(j)]); sum += c; cnt += (c > 0u) ? 1u : 0u; mine = (j == x) ? c : mine; }
        if (sum == G) break;
        __builtin_amdgcn_s_sleep(1);
        if ((++sp & 255u) == 0u) { if (xb_ld(&bar[XB_TMO])) break; if (sp > XB_SPIN_CAP) { atomicAdd(&bar[XB_TMO], 1u); break; } }
    }
    nloc = mine > 0u ? mine : 1u; nx = cnt > 0u ? cnt : 1u;
}
__device__ __forceinline__ void xcd_barrier(const XcdBarrier& b) {
    asm volatile("s_waitcnt vmcnt(0)" ::: "memory");
    __syncthreads();
    if (threadIdx.x == 0) {
        unsigned* bar = b.bar;
        __builtin_amdgcn_s_waitcnt(0);
        unsigned nloc = b.st[0], nx = b.st[1];
        if (nloc == 0u) { xcd_barrier_complete(bar, b.x, nloc, nx); b.st[0] = nloc; b.st[1] = nx; }
        const unsigned old = xb_add(&bar[XB_XSUB(b.x)], 1u);
        const unsigned gen = old / nloc;
        if (old + 1u == (gen + 1u) * nloc) {
            __builtin_amdgcn_fence(__ATOMIC_RELEASE, "agent");
            asm volatile("s_waitcnt vmcnt(0)" ::: "memory");
            const unsigned og = xb_add(&bar[XB_TOP], 1u);
            const unsigned tg = og / nx;
            if (og + 1u == (tg + 1u) * nx) xb_add(&bar[XB_TOPGEN], 1u);
            else XB_SPIN(xb_ld(&bar[XB_TOPGEN]) == tg, bar);
            xb_add(&bar[XB_XGEN(b.x)], 1u);
            __builtin_amdgcn_fence(__ATOMIC_ACQUIRE, "agent");
            asm volatile("s_waitcnt vmcnt(0)" ::: "memory");
        } else {
            XB_SPIN(xb_ld(&bar[XB_XGEN(b.x)]) == gen, bar);
            __builtin_amdgcn_fence(__ATOMIC_ACQUIRE, "agent");
            asm volatile("s_waitcnt vmcnt(0)" ::: "memory");
        }
    }
    __syncthreads();
}

namespace pg8 {
constexpr int BM = 256, BK = 64, HALF = 128, HTB = HALF * BK * 2, NXCD = 8, WGM = 8;
__host__ __device__ __forceinline__ int lds_byte(int r, int c) { const int st = (r >> 4) * 2 + (c >> 5), rr = r & 15, cc = c & 31, ob = rr * 64 + cc * 2; return st * 1024 + (ob ^ (((ob >> 9) & 1) << 5)); }
__host__ __device__ __forceinline__ void stage_rc(int b, int& R, int& C) { const int st = b / 1024, sb = b % 1024, swz = sb ^ (((sb >> 9) & 1) << 5); R = (st >> 1) * 16 + swz / 64; C = (st & 1) * 32 + (swz % 64) / 2; }
__host__ __device__ __forceinline__ int perm32(int rho) { const int n = rho >> 4, i = rho & 15; return 8 * (i >> 2) + 4 * n + (i & 3); }

struct Unit { int pm, pn, e, cnt; };

struct Dense {
    static constexpr bool GATHER = false;
    const bf16* A; const bf16* Bt; int K, ldk; int nM, nN, nwg, G, c;
    __device__ __forceinline__ void init(const bf16* A_, const bf16* Bt_, int M, int N, int K_, int G_, int c_, int ld_ = 0) { A = A_; Bt = Bt_; K = K_; ldk = ld_ ? ld_ : K_; nM = M / BM; nN = N / BM; nwg = nM * nN; G = G_; c = c_; }
    __device__ __forceinline__ int ld() const { return ldk; }
    __device__ __forceinline__ bool next(int i, Unit& u) const {
        const long L = (long)i * G + c; if (L >= nwg) return false;
        int wgid = (int)L; { const int q = nwg / NXCD, r = nwg % NXCD, xcd = wgid % NXCD, off = wgid / NXCD; wgid = (xcd < r ? xcd * (q + 1) : r * (q + 1) + (xcd - r) * q) + off; }
        const int nig = WGM * nN, gid = wgid / nig, fm = gid * WGM, gsz = (nM - fm) < WGM ? (nM - fm) : WGM;
        u.pm = fm + ((wgid % nig) % gsz); u.pn = (wgid % nig) / gsz; u.e = 0; u.cnt = 256; return true;
    }
    __device__ __forceinline__ const char* a_base(const Unit& u) const { return (const char*)A + (size_t)u.pm * BM * ldk * 2; }
    __device__ __forceinline__ const char* b_base(const Unit& u) const { return (const char*)Bt + (size_t)u.pn * BM * ldk * 2; }
    __device__ __forceinline__ void a_off(const Unit&, const int (&R)[2], const int (&C)[2], unsigned (&vo)[2][2]) const {
#pragma unroll
        for (int h = 0; h < 2; ++h)
#pragma unroll
            for (int i = 0; i < 2; ++i) vo[h][i] = (unsigned)((R[i] + HALF * h) * ldk + C[i]) * 2u;
    }
};

template <bool GATHER_> struct Moe {
    static constexpr bool GATHER = GATHER_;
    const bf16* A; const bf16* Bt; int K, nN, G, vcu; const int* ltok; const volatile LAS int* tb; const volatile LAS int* cnt;
    __device__ __forceinline__ int ld() const { return K; }
    __device__ __forceinline__ bool next(int i, Unit& u) const {
        const int L = i * G + vcu; const int TT = __builtin_amdgcn_readfirstlane(tb[NE]); if (L >= TT * nN) return false;
        const int mt = L / nN; u.pn = L - mt * nN;
        const int e = __builtin_amdgcn_readfirstlane(tb[512 + mt]);
        u.e = e; u.pm = mt; const int rem = __builtin_amdgcn_readfirstlane(cnt[e]) - (mt - __builtin_amdgcn_readfirstlane(tb[e])) * BM; u.cnt = rem < BM ? rem : BM; return true;
    }
    __device__ __forceinline__ const char* a_base(const Unit& u) const { return GATHER ? (const char*)A : (const char*)A + (size_t)u.pm * BM * K * 2; }
    __device__ __forceinline__ const char* b_base(const Unit& u) const { return (const char*)Bt + ((size_t)u.e * nN + u.pn) * BM * K * 2; }
    __device__ __forceinline__ const int* idx_src(const Unit& u) const { return ltok + (size_t)u.e * ECAP + (u.pm - __builtin_amdgcn_readfirstlane(tb[u.e])) * BM; }
    __device__ __forceinline__ void a_idx(const Unit& u, const int (&R)[2], int (&tk)[2][2]) const {
        const int slot0 = (u.pm - __builtin_amdgcn_readfirstlane(tb[u.e])) * BM; const int* lt = ltok + (size_t)u.e * ECAP + slot0;
        const unsigned o0 = (unsigned)R[0] * 4u, o1 = (unsigned)R[1] * 4u;
        asm volatile("global_load_dword %0, %4, %6\n\tglobal_load_dword %1, %5, %6\n\tglobal_load_dword %2, %4, %6 offset:512\n\tglobal_load_dword %3, %5, %6 offset:512"
                     : "=&v"(tk[0][0]), "=&v"(tk[0][1]), "=&v"(tk[1][0]), "=&v"(tk[1][1]) : "v"(o0), "v"(o1), "s"(lt) : "memory");
    }
    __device__ __forceinline__ void a_fin(const Unit& u, const int (&R)[2], const int (&C)[2], int (&tk)[2][2], unsigned (&vo)[2][2]) const {
        asm volatile("" : "+v"(tk[0][0]), "+v"(tk[0][1]), "+v"(tk[1][0]), "+v"(tk[1][1]));
#pragma unroll
        for (int h = 0; h < 2; ++h)
#pragma unroll
            for (int i = 0; i < 2; ++i) { const int r = R[i] + HALF * h; const int tok = (r < u.cnt) ? tk[h][i] : 0; vo[h][i] = (unsigned)(tok * K + C[i]) * 2u; }
    }
    __device__ __forceinline__ void a_off(const Unit& u, const int (&R)[2], const int (&C)[2], unsigned (&vo)[2][2]) const {
        if constexpr (GATHER) {
            const int slot0 = (u.pm - __builtin_amdgcn_readfirstlane(tb[u.e])) * BM; const int* lt = ltok + (size_t)u.e * ECAP + slot0; int tk[2][2];
#pragma unroll
            for (int h = 0; h < 2; ++h)
#pragma unroll
                for (int i = 0; i < 2; ++i) tk[h][i] = lt[R[i] + HALF * h];
            asm volatile("" : "+v"(tk[0][0]), "+v"(tk[0][1]), "+v"(tk[1][0]), "+v"(tk[1][1]));
#pragma unroll
            for (int h = 0; h < 2; ++h)
#pragma unroll
                for (int i = 0; i < 2; ++i) { const int r = R[i] + HALF * h; const int tok = (r < u.cnt) ? tk[h][i] : 0; vo[h][i] = (unsigned)(tok * K + C[i]) * 2u; }
        } else {
#pragma unroll
            for (int h = 0; h < 2; ++h)
#pragma unroll
                for (int i = 0; i < 2; ++i) vo[h][i] = (unsigned)((R[i] + HALF * h) * K + C[i]) * 2u;
        }
    }
};

template <class Prob, class Epi, bool FP8 = false, bool ADJ = false>
__device__ __forceinline__ void gemm_phase(LAS unsigned char* lds, const Prob& P, const Epi& E) {
    const int tid = threadIdx.x, wid = __builtin_amdgcn_readfirstlane(tid >> 6), lane = tid & 63, wr = wid >> 2, wc = wid & 3, fr = lane & 15, fq = lane >> 4;
    const int K = P.K, nt = K / BK;
    constexpr bool PRE11 = RELAX_WAITS && !Epi::LDSX;
    int Rr[2], Cc[2]; unsigned voffB[2];
#pragma unroll
    for (int i = 0; i < 2; ++i) { int R, C; stage_rc(tid * 16 + i * 8192, R, C); const int rho = R & 31;
        const int Rb = ADJ ? (64 * (R >> 5) + 16 * ((rho >> 2) & 3) + 4 * (rho >> 4) + (rho & 3)) : ((R & ~31) + perm32(rho)); Rr[i] = R; Cc[i] = C; voffB[i] = (unsigned)(Rb * P.ld() + C) * 2u; }
    const size_t kstep = (size_t)(BK * 2);
    const size_t hstep = (size_t)(ADJ ? 8 : HALF) * P.ld() * 2;
    const unsigned ldsw = (unsigned)wid * 1024u;
    const int aoff = lds_byte(wr * 64 + fr, fq * 8), boff = lds_byte(wc * 32 + fr, fq * 8);
#define PG8_SA(b, h) (((b) * 2 + (h)) * HTB)
#define PG8_SB(b, h) ((4 + (b) * 2 + (h)) * HTB)
#define PG8_STAGE(bufoff, gbase, voff) do { const char* _g = (const char*)(gbase); asm volatile("" : "+s"(_g));     \
        _Pragma("unroll") for (int _i = 0; _i < 2; ++_i) \
        __builtin_amdgcn_global_load_lds((const unsigned*)(_g + (voff)[_i]), (LAS unsigned*)(lds + (bufoff) + ldsw + _i * 8192), 16, 0, 0); } while (0)
#define PG8_LD8(addr) __builtin_shufflevector(*(const LAS i32x4*)(addr), *(const LAS i32x4*)((addr) + 1024), 0, 1, 2, 3, 4, 5, 6, 7)
#define PG8_LDA(dst, b, h) do { _Pragma("unroll") for (int m = 0; m < 4; ++m) dst[m] = PG8_LD8(lds + PG8_SA(b, h) + aoff + m * 2048); } while (0)
#define PG8_LDB(dst, b, h) do { _Pragma("unroll") for (int n = 0; n < 2; ++n) dst[n] = PG8_LD8(lds + PG8_SB(b, h) + boff + n * 2048); } while (0)
#define PG8_LO(x) __builtin_bit_cast(bf16x8, __builtin_shufflevector(x, x, 0, 1, 2, 3))
#define PG8_HI(x) __builtin_bit_cast(bf16x8, __builtin_shufflevector(x, x, 4, 5, 6, 7))
#define PG8_MMA(ai, bj, At, Bt) do { __builtin_amdgcn_s_setprio(1); _Pragma("unroll") for (int m = 0; m < 4; ++m) _Pragma("unroll") for (int n = 0; n < 2; ++n) { \
        if constexpr (FP8) asm volatile("v_mfma_scale_f32_16x16x128_f8f6f4 %0, %1, %2, %0, %3, %3 op_sel_hi:[0,0,0]" : "+v"(acc[ai][bj][m][n]) : "v"(Bt[n]), "v"(At[m]), "v"(one_scale)); \
        else { acc[ai][bj][m][n] = __builtin_amdgcn_mfma_f32_16x16x32_bf16(PG8_LO(Bt[n]), PG8_LO(At[m]), acc[ai][bj][m][n], 0, 0, 0); \
               acc[ai][bj][m][n] = __builtin_amdgcn_mfma_f32_16x16x32_bf16(PG8_HI(Bt[n]), PG8_HI(At[m]), acc[ai][bj][m][n], 0, 0, 0); } } \
        __builtin_amdgcn_s_setprio(0); } while (0)
#define PG8_MMA_Z(ai, bj, At, Bt) do { __builtin_amdgcn_s_setprio(1); _Pragma("unroll") for (int m = 0; m < 4; ++m) _Pragma("unroll") for (int n = 0; n < 2; ++n) \
        asm volatile("v_mfma_scale_f32_16x16x128_f8f6f4 %0, %1, %2, 0, %3, %3 op_sel_hi:[0,0,0]" : "=&v"(acc[ai][bj][m][n]) : "v"(Bt[n]), "v"(At[m]), "v"(one_scale)); \
        __builtin_amdgcn_s_setprio(0); } while (0)
#define PG8_MMA2(ai, At, B0, B1) do { if constexpr (FP8) { if (zfirst) { PG8_MMA_Z(ai, 0, At, B0); PG8_MMA_Z(ai, 1, At, B1); } else { PG8_MMA(ai, 0, At, B0); PG8_MMA(ai, 1, At, B1); } } else { PG8_MMA(ai, 0, At, B0); PG8_MMA(ai, 1, At, B1); } } while (0)
#define PG8_WAIT_V(n) asm volatile("s_waitcnt vmcnt(" #n ")" ::: "memory")
#define PG8_WAIT_L(n) asm volatile("s_waitcnt lgkmcnt(" #n ")" ::: "memory")
#define PG8_BAR __builtin_amdgcn_s_barrier()
#define PG8_SCHED __builtin_amdgcn_sched_barrier(0)
    Unit cur, nxt; int ui = 0;
    if (!P.next(0, cur)) return;
    f32x4 acc[2][2][4][2];
    if constexpr (!FP8) {
#pragma unroll
    for (int a = 0; a < 2; ++a)
#pragma unroll
        for (int b = 0; b < 2; ++b)
#pragma unroll
            for (int m = 0; m < 4; ++m)
#pragma unroll
                for (int n = 0; n < 2; ++n) acc[a][b][m][n] = (f32x4){0.f, 0.f, 0.f, 0.f}; }
    int one_scale = 0x7f7f7f7f; asm volatile("" : "+v"(one_scale));
    i32x8 At[4], B0[2], B1[2];
    unsigned vc[2][2], vn[2][2];
    P.a_off(cur, Rr, Cc, vc);
    const char* cA = P.a_base(cur); const char* cB = P.b_base(cur);
    PG8_STAGE(PG8_SB(0, 0), cB, voffB); PG8_STAGE(PG8_SB(0, 1), cB + hstep, voffB); PG8_STAGE(PG8_SA(0, 0), cA, vc[0]); PG8_STAGE(PG8_SA(0, 1), cA, vc[1]);
    if (wr == 1) PG8_BAR;
    PG8_WAIT_V(2); PG8_BAR;
    PG8_STAGE(PG8_SB(1, 0), cB + kstep, voffB); PG8_STAGE(PG8_SA(1, 0), cA + kstep, vc[0]); PG8_STAGE(PG8_SB(1, 1), cB + hstep + kstep, voffB);
    PG8_WAIT_V(6); PG8_BAR;
    for (;;) {
        const bool has_next = P.next(ui + 1, nxt);
        const char* nA = has_next ? P.a_base(nxt) : cA; const char* nB = has_next ? P.b_base(nxt) : cB;
        int tkr[2][2] = {{0, 0}, {0, 0}};
        if constexpr (Prob::GATHER) { if (has_next) P.a_idx(nxt, Rr, tkr); }
#pragma unroll
        for (int h = 0; h < 2; ++h)
#pragma unroll
            for (int i = 0; i < 2; ++i) vn[h][i] = vc[h][i];
        if constexpr (Prob::GATHER) { if (nt < 6 && has_next) { PG8_WAIT_V(0); P.a_fin(nxt, Rr, Cc, tkr, vn); } }
        const bool post = ui > 0;
#if PROBE_KLOOP2
        const int ntt = ((PROBE_KLOOP2 == 1 && FP8) || (PROBE_KLOOP2 == 2 && !FP8 && nt == 16)) ? 2 * nt : nt;
#else
        const int ntt = nt;
#endif
        for (int t = 0; t < ntt; t += 2) {
#if PROBE_KLOOP2
            if (t == nt) {
#pragma unroll
                for (int a = 0; a < 2; ++a)
#pragma unroll
                    for (int b = 0; b < 2; ++b)
#pragma unroll
                        for (int m = 0; m < 4; ++m)
#pragma unroll
                            for (int n = 0; n < 2; ++n) acc[a][b][m][n] = (f32x4){0.f, 0.f, 0.f, 0.f};
            }
            const int tq = t >= nt ? t - nt : t;
#else
            const int tq = t;
#endif
            if constexpr (Epi::MID) { if (tq == nt / 2) { int l2 = 0; asm volatile("" : "+v"(l2)); l2 = (int)__builtin_amdgcn_mbcnt_hi(~0u, __builtin_amdgcn_mbcnt_lo(~0u, (unsigned)l2)); E.mid(acc, cur, wr, wc, l2 & 15, l2 >> 4); } }
            const bool last = (t == ntt - 2);
            const int tq2 = (tq + 2 == nt) ? 0 : tq + 2;
            const char* a1 = cA + (size_t)(tq + 1) * kstep;
            const char* a2 = last ? nA : cA + (size_t)tq2 * kstep; const char* b2 = last ? nB : cB + (size_t)tq2 * kstep;
            const char* a3 = a2 + kstep; const char* b3 = b2 + kstep;
            unsigned w0[2], w1[2];
            if constexpr (Prob::GATHER) { w0[0] = last ? vn[0][0] : vc[0][0]; w0[1] = last ? vn[0][1] : vc[0][1]; w1[0] = last ? vn[1][0] : vc[1][0]; w1[1] = last ? vn[1][1] : vc[1][1]; }
            else { w0[0] = vc[0][0]; w0[1] = vc[0][1]; w1[0] = vc[1][0]; w1[1] = vc[1][1]; }
            int tz = t; asm volatile("" : "+s"(tz));
            const bool relax = PRE11 && post && tz == 0;
            int tzq = tq; asm volatile("" : "+s"(tzq)); const bool zfirst = (tzq == 0);
            PG8_LDB(B0, 0, 0); PG8_LDB(B1, 0, 1); PG8_SCHED; PG8_LDA(At, 0, 0); if (!relax) PG8_STAGE(PG8_SA(1, 1), a1, vc[1]);
            if (!relax) PG8_WAIT_V(8); PG8_WAIT_L(0); PG8_BAR; PG8_MMA2(0, At, B0, B1); PG8_BAR; PG8_SCHED;
            PG8_LDA(At, 0, 1); PG8_STAGE(PG8_SB(0, 0), b2, voffB); PG8_STAGE(PG8_SB(0, 1), b2 + hstep, voffB); PG8_STAGE(PG8_SA(0, 0), a2, w0);
            if (!relax) PG8_WAIT_V(8); PG8_WAIT_L(0); PG8_BAR; PG8_MMA2(1, At, B0, B1); PG8_BAR; PG8_SCHED;
            PG8_LDB(B0, 1, 0); PG8_LDB(B1, 1, 1); PG8_SCHED; PG8_LDA(At, 1, 0); PG8_STAGE(PG8_SA(0, 1), a2, w1);
            if (!relax) PG8_WAIT_V(8); PG8_WAIT_L(0); PG8_BAR; PG8_MMA(0, 0, At, B0); PG8_MMA(0, 1, At, B1); PG8_BAR; PG8_SCHED;
            PG8_LDA(At, 1, 1); PG8_STAGE(PG8_SB(1, 0), b3, voffB); PG8_STAGE(PG8_SB(1, 1), b3 + hstep, voffB); PG8_STAGE(PG8_SA(1, 0), a3, w0);
            PG8_WAIT_V(8); PG8_WAIT_L(0); PG8_BAR; PG8_MMA(1, 0, At, B0); PG8_MMA(1, 1, At, B1); PG8_BAR; PG8_SCHED;
            if constexpr (Prob::GATHER) { if (nt >= 6 && t + 4 == ntt && has_next) P.a_fin(nxt, Rr, Cc, tkr, vn); }
        }
        if (wr == 0) PG8_BAR;
        if constexpr (PRE11) PG8_STAGE(PG8_SA(1, 1), nA + kstep, vn[1]);
        if constexpr (FP8) asm volatile("s_nop 15\n\ts_nop 3" ::: "memory");
        { int l2 = 0; asm volatile("" : "+v"(l2)); l2 = (int)__builtin_amdgcn_mbcnt_hi(~0u, __builtin_amdgcn_mbcnt_lo(~0u, (unsigned)l2));
          E(acc, cur, wr, wc, l2 & 15, l2 >> 4);
#if PROBE_EPI2
          if ((PROBE_EPI2 == 1 && FP8) || (PROBE_EPI2 == 2 && !FP8 && P.nN == 14)) { int l3 = threadIdx.x & 63; asm volatile("" : "+v"(l3)); E(acc, cur, wr, wc, l3 & 15, l3 >> 4); }
#endif
        }
        if (!has_next) break;
        if constexpr (!FP8) {
#pragma unroll
        for (int a = 0; a < 2; ++a)
#pragma unroll
            for (int b = 0; b < 2; ++b)
#pragma unroll
                for (int m = 0; m < 4; ++m)
#pragma unroll
                    for (int n = 0; n < 2; ++n) acc[a][b][m][n] = (f32x4){0.f, 0.f, 0.f, 0.f}; }
        cur = nxt; cA = nA; cB = nB; ++ui;
#pragma unroll
        for (int h = 0; h < 2; ++h)
#pragma unroll
            for (int i = 0; i < 2; ++i) vc[h][i] = vn[h][i];
        if (wr == 1) PG8_BAR;
    }
    PG8_WAIT_V(0);
    PG8_BAR;
#undef PG8_SA
#undef PG8_SB
#undef PG8_STAGE
#undef PG8_LDA
#undef PG8_LDB
#undef PG8_MMA
#undef PG8_MMA_Z
#undef PG8_MMA2
#undef PG8_LO
#undef PG8_HI
#undef PG8_LD8
#undef PG8_WAIT_V
#undef PG8_WAIT_L
#undef PG8_BAR
#undef PG8_SCHED
}
}

using pg8::Unit;
__device__ __forceinline__ u32x4 pack8(const f32x4& a, const f32x4& b) { u32x4 w; w.x = pk2(a[0], a[1]); w.y = pk2(a[2], a[3]); w.z = pk2(b[0], b[1]); w.w = pk2(b[2], b[3]); return w; }
#define EPI_LOOP_AI_M _Pragma("unroll") for (int ai = 0; ai < 2; ++ai) _Pragma("unroll") for (int m = 0; m < 4; ++m)
#define EPI_LOADS_DONE() asm volatile("s_waitcnt vmcnt(0)" ::: "memory")

struct EpiInProj {
    static constexpr bool MID = false, LDSX = false;
    bf16* HG; bf16* QLAT; bf16* KVLAT; bf16* G; bf16* GR; const float* gate_b; float* KPESS; const float* RSX; float* SSQ; float* SSC;
    __device__ __forceinline__ void operator()(const f32x4 (&acc)[2][2][4][2], const Unit& u, int wr, int wc, int fr, int fq) const {
        const int rowu = u.pm * 256 + wr * 64, cwu = wc * 32, cw = cwu + 8 * fq;
        float rx[2][4];
        { const float* rxp = RSX + rowu; EPI_LOOP_AI_M rx[ai][m] = rxp[fr + 128 * ai + 16 * m]; }
        f32x4 bv[2][2];
        { const int cbg = 128 * (u.pn < 6 ? 0 : u.pn - 6) + cw;
#pragma unroll
          for (int bj = 0; bj < 2; ++bj)
#pragma unroll
              for (int n = 0; n < 2; ++n) bv[bj][n] = *(const f32x4*)(gate_b + 1024 * bj + cbg + 4 * n); }
        __builtin_amdgcn_sched_barrier(0);
        EPI_LOADS_DONE();
        asm volatile("" : "+v"(bv[0][0]), "+v"(bv[0][1]), "+v"(bv[1][0]), "+v"(bv[1][1]));
        if (u.pn < 4) {
            const int bb = rowu >> 12, tu = rowu & 4095;
            char* hb = (char*)HG + (((size_t)bb * LPC + HGOFF + tu) * CDIM + 128 * u.pn + cwu) * 2; const unsigned lo = (unsigned)(fr * CDIM + 8 * fq) * 2u;
            EPI_LOOP_AI_M {
                const f32x2 r2 = {rx[ai][m], rx[ai][m]}, nr2 = r2 * -1.4426950408889634f; f32x4 v[2];
#pragma unroll
                for (int n = 0; n < 2; ++n)
#pragma unroll
                    for (int h = 0; h < 2; ++h) { const f32x2 a2 = {acc[ai][0][m][n][2 * h], acc[ai][0][m][n][2 * h + 1]}, g2 = {acc[ai][1][m][n][2 * h], acc[ai][1][m][n][2 * h + 1]};
                        const f32x2 t = g2 * nr2; f32x2 d = {__builtin_amdgcn_exp2f(t[0]), __builtin_amdgcn_exp2f(t[1])}; d = d + 1.f;
                        const f32x2 rc = {__builtin_amdgcn_rcpf(d[0]), __builtin_amdgcn_rcpf(d[1])}, o = (a2 * r2) * rc; v[n][2 * h] = o[0]; v[n][2 * h + 1] = o[1]; }
                *(u32x4*)(hb + (size_t)(128 * ai + 16 * m) * (CDIM * 2) + lo) = pack8(v[0], v[1]); }
        } else if (u.pn < 6) {
            char* db = (char*)((u.pn == 4) ? QLAT : KVLAT) + ((size_t)rowu * 256 + cwu) * 2; const unsigned lo = (unsigned)(fr * 256 + 8 * fq) * 2u;
            EPI_LOOP_AI_M {
#pragma unroll
                for (int bj = 0; bj < 2; ++bj) *(u32x4*)(db + (size_t)(128 * ai + 16 * m) * 512 + 256 * bj + lo) = pack8(acc[ai][bj][m][0] * rx[ai][m], acc[ai][bj][m][1] * rx[ai][m]); }
            { float* ssd = ((u.pn == 4) ? SSQ : SSC) + (size_t)rowu * 4 + wc; const int nbj = (u.pn == 4) ? 2 : 1;
                EPI_LOOP_AI_M { float ss = 0.f;
#pragma unroll
                    for (int bj = 0; bj < 2; ++bj) if (bj < nbj) { const f32x4 a = acc[ai][bj][m][0], b = acc[ai][bj][m][1]; ss += ((a[0] * a[0] + a[1] * a[1]) + (a[2] * a[2] + a[3] * a[3])) + ((b[0] * b[0] + b[1] * b[1]) + (b[2] * b[2] + b[3] * b[3])); }
                    ss += __shfl_xor(ss, 16); ss += __shfl_xor(ss, 32);
                    if (fq == 0) ssd[(fr + 128 * ai + 16 * m) * 4] = ss * rx[ai][m] * rx[ai][m]; } }
            if (u.pn == 5 && wc == 0) {
                float* kp = KPESS + rowu;
                EPI_LOOP_AI_M { const f32x4 a = acc[ai][1][m][0], b = acc[ai][1][m][1];
                    float ss = ((a[0] * a[0] + a[1] * a[1]) + (a[2] * a[2] + a[3] * a[3])) + ((b[0] * b[0] + b[1] * b[1]) + (b[2] * b[2] + b[3] * b[3]));
                    ss += __shfl_xor(ss, 16); ss += __shfl_xor(ss, 32);
                    if (fq == 0) kp[fr + 128 * ai + 16 * m] = ss * rx[ai][m] * rx[ai][m]; } }
        } else {
            const size_t ub = ((size_t)rowu * 1024 + 128 * (u.pn - 6) + cwu) * 2; char* rb = (char*)GR + ub; char* gb = (char*)G + ub; const unsigned lo = (unsigned)(fr * 1024 + 8 * fq) * 2u;
#pragma unroll
            for (int bj = 0; bj < 2; ++bj)
#pragma unroll
                for (int n = 0; n < 2; ++n) bv[bj][n] = bv[bj][n] * -1.4426950408889634f;
            EPI_LOOP_AI_M { f32x4 rr[2], gg[2]; const float nr = rx[ai][m] * -1.4426950408889634f; const f32x2 nr2 = {nr, nr};
#pragma unroll
                for (int n = 0; n < 2; ++n)
#pragma unroll
                    for (int h = 0; h < 2; ++h) { const f32x2 z0 = {acc[ai][0][m][n][2 * h], acc[ai][0][m][n][2 * h + 1]}, z1 = {acc[ai][1][m][n][2 * h], acc[ai][1][m][n][2 * h + 1]};
                        const f32x2 b0 = {bv[0][n][2 * h], bv[0][n][2 * h + 1]}, b1 = {bv[1][n][2 * h], bv[1][n][2 * h + 1]};
                        const f32x2 t0 = z0 * nr2 + b0, t1 = z1 * nr2 + b1;
                        f32x2 d0 = {__builtin_amdgcn_exp2f(t0[0]), __builtin_amdgcn_exp2f(t0[1])}, d1 = {__builtin_amdgcn_exp2f(t1[0]), __builtin_amdgcn_exp2f(t1[1])}; d0 = d0 + 1.f; d1 = d1 + 1.f;
                        const f32x2 q0 = {__builtin_amdgcn_rcpf(d0[0]), __builtin_amdgcn_rcpf(d0[1])}, g1 = {__builtin_amdgcn_rcpf(d1[0]), __builtin_amdgcn_rcpf(d1[1])}, r = d1 * q0;
                        gg[n][2 * h] = g1[0]; gg[n][2 * h + 1] = g1[1]; rr[n][2 * h] = r[0]; rr[n][2 * h + 1] = r[1]; }
                *(u32x4*)(rb + (size_t)(128 * ai + 16 * m) * 2048 + lo) = pack8(rr[0], rr[1]); *(u32x4*)(gb + (size_t)(128 * ai + 16 * m) * 2048 + lo) = pack8(gg[0], gg[1]); }
        }
    }
};
template <bool REMAP> struct EpiRowScale {
    static constexpr bool MID = false, LDSX = false;
    bf16* O; const float* rs;
    __device__ __forceinline__ void operator()(const f32x4 (&acc)[2][2][4][2], const Unit& u, int wr, int wc, int fr, int fq) const {
        const int rowt = u.pm * 256 + wr * 64 + fr, cb = 256 * u.pn + 64 * wc + 16 * fq;
        float sv[2][4];
        EPI_LOOP_AI_M sv[ai][m] = rs[rowt + 128 * ai + 16 * m];
        __builtin_amdgcn_sched_barrier(0);
        EPI_LOADS_DONE();
        EPI_LOOP_AI_M { const int row = rowt + 128 * ai + 16 * m; const float s = sv[ai][m];
            const size_t orow = REMAP ? ((size_t)(row >> 12) * LPK + KOFF + (row & 4095)) : (size_t)row;
#pragma unroll
            for (int bj = 0; bj < 2; ++bj) *(u32x4*)(O + orow * 1024 + cb + 8 * bj) = pack8(acc[ai][bj][m][0] * s, acc[ai][bj][m][1] * s); }
    }
};
__device__ __forceinline__ void unpack8(const u32x4& w, f32x4& a, f32x4& b) { a[0] = bflo(w.x); a[1] = bfhi(w.x); a[2] = bflo(w.y); a[3] = bfhi(w.y); b[0] = bflo(w.z); b[1] = bfhi(w.z); b[2] = bflo(w.w); b[3] = bfhi(w.w); }
struct EpiQHead {
    static constexpr bool MID = false, LDSX = true;
    bf16* QF; const float* rs; const float* q_nw; const float* ROPE; LAS unsigned char* lds;
    __device__ __forceinline__ void operator()(const f32x4 (&acc)[2][2][4][2], const Unit& u, int wr, int wc, int fr, int fq) const {
        LAS float* S = (LAS float*)(lds + 3 * 16384);
        const int rowu = u.pm * 256 + wr * 64, rl0 = wr * 64 + fr;
        float sv[2][4];
        { f32x4 pp[2][4]; const char* rsb = (const char*)(rs + (size_t)rowu * 4); const unsigned lo = (unsigned)fr * 16u;
          EPI_LOOP_AI_M pp[ai][m] = *(const f32x4*)(rsb + (128 * ai + 16 * m) * 16 + lo);
          __builtin_amdgcn_sched_barrier(0);
          EPI_LOADS_DONE();
          EPI_LOOP_AI_M sv[ai][m] = 1.f / sqrtf(((pp[ai][m][0] + pp[ai][m][1]) + (pp[ai][m][2] + pp[ai][m][3])) * (1.f / QLR) + NORM_EPS); }
        EPI_LOOP_AI_M {
#pragma unroll
            for (int bj = 0; bj < 2; ++bj) { const f32x4 a = acc[ai][bj][m][0], b = acc[ai][bj][m][1];
                float ss = ((a[0] * a[0] + a[1] * a[1]) + (a[2] * a[2] + a[3] * a[3])) + ((b[0] * b[0] + b[1] * b[1]) + (b[2] * b[2] + b[3] * b[3]));
                ss += __shfl_xor(ss, 16); ss += __shfl_xor(ss, 32);
                if (fq == 0) S[((rl0 + 128 * ai + 16 * m) * 2 + bj) * 4 + wc] = ss; } }
        asm volatile("s_waitcnt lgkmcnt(0)\n\ts_barrier" ::: "memory");
        if (wc < 3) {
            const f32x4 w0 = *(const f32x4*)(q_nw + 32 * wc + 8 * fq), w1 = *(const f32x4*)(q_nw + 32 * wc + 8 * fq + 4);
            char* qb = (char*)QF + ((size_t)rowu * 768 + (size_t)(2 * u.pn) * DQK + 32 * wc) * 2; const unsigned qlo = (unsigned)(fr * 768 + 8 * fq) * 2u;
            const char* rb = (const char*)(ROPE + (size_t)(NMETA + (rowu & 4095)) * 32); const unsigned rlo = (unsigned)(fr * 32 + 16 * (fq & 1)) * 4u;
            f32x4 cn[4] = {{0.f, 0.f, 0.f, 0.f}, {0.f, 0.f, 0.f, 0.f}, {0.f, 0.f, 0.f, 0.f}, {0.f, 0.f, 0.f, 0.f}};
            if (wc == 2) { cn[0] = *(const f32x4*)(rb + rlo); cn[1] = *(const f32x4*)(rb + rlo + 16); cn[2] = *(const f32x4*)(rb + rlo + 32); cn[3] = *(const f32x4*)(rb + rlo + 48); }
            EPI_LOOP_AI_M { const int rl = rl0 + 128 * ai + 16 * m; const float rsq = sv[ai][m];
                const f32x4 c0 = cn[0], c1 = cn[1], c2 = cn[2], c3 = cn[3];
                if (wc == 2 && (ai * 4 + m) < 7) { const int q1 = ai * 4 + m + 1; const char* rp = rb + (128 * (q1 >> 2) + 16 * (q1 & 3)) * 128 + rlo;
                    cn[0] = *(const f32x4*)rp; cn[1] = *(const f32x4*)(rp + 16); cn[2] = *(const f32x4*)(rp + 32); cn[3] = *(const f32x4*)(rp + 48); }
#pragma unroll
                for (int bj = 0; bj < 2; ++bj) { const f32x4 pt = *(const LAS f32x4*)(S + (rl * 2 + bj) * 4);
                    const float tot = ((pt[0] + pt[1]) + (pt[2] + pt[3])) * rsq * rsq, sc = rsq * QSCALE / sqrtf(tot * (1.f / DQK) + NORM_EPS);
                    f32x4 o0 = acc[ai][bj][m][0] * sc * w0, o1 = acc[ai][bj][m][1] * sc * w1;
                    if (wc == 2) {
                        const float sg = (fq < 2) ? -1.f : 1.f; f32x4 p0, p1;
#pragma unroll
                        for (int e = 0; e < 4; ++e) { p0[e] = __shfl_xor(o0[e], 32); p1[e] = __shfl_xor(o1[e], 32); }
                        o0 = (f32x4){o0[0] * c0[0] + sg * p0[0] * c0[1], o0[1] * c0[2] + sg * p0[1] * c0[3], o0[2] * c1[0] + sg * p0[2] * c1[1], o0[3] * c1[2] + sg * p0[3] * c1[3]};
                        o1 = (f32x4){o1[0] * c2[0] + sg * p1[0] * c2[1], o1[1] * c2[2] + sg * p1[1] * c2[3], o1[2] * c3[0] + sg * p1[2] * c3[1], o1[3] * c3[2] + sg * p1[3] * c3[3]}; }
                    *(u32x4*)(qb + (size_t)(128 * ai + 16 * m) * 1536 + bj * (DQK * 2) + qlo) = pack8(o0, o1); } }
        }
        asm volatile("s_waitcnt lgkmcnt(0)\n\ts_barrier" ::: "memory");
    }
};
struct EpiKVHead {
    static constexpr bool MID = false, LDSX = true;
    bf16* KF; bf16* VO; const bf16* KVLAT; const float* rs; const float* kpess; const float* k_nw; const float* ROPE; LAS unsigned char* lds;
    __device__ __forceinline__ void operator()(const f32x4 (&acc)[2][2][4][2], const Unit& u, int wr, int wc, int fr, int fq) const {
        LAS float* S = (LAS float*)(lds + 3 * 16384);
        const int rowu = u.pm * 256 + wr * 64, rl0 = wr * 64 + fr, bb = rowu >> 12, tu = rowu & 4095;
        float sv[2][4];
        { f32x4 pp[2][4]; const char* rsb = (const char*)(rs + (size_t)rowu * 4); const unsigned lo = (unsigned)fr * 16u;
          EPI_LOOP_AI_M pp[ai][m] = *(const f32x4*)(rsb + (128 * ai + 16 * m) * 16 + lo);
          __builtin_amdgcn_sched_barrier(0);
          EPI_LOADS_DONE();
          EPI_LOOP_AI_M sv[ai][m] = 1.f / sqrtf(((pp[ai][m][0] + pp[ai][m][1]) + (pp[ai][m][2] + pp[ai][m][3])) * (1.f / KVLR) + NORM_EPS); }
        if (wc < 2) {
            EPI_LOOP_AI_M {
#pragma unroll
                for (int bj = 0; bj < 2; ++bj) { const f32x4 a = acc[ai][bj][m][0], b = acc[ai][bj][m][1];
                    float ss = ((a[0] * a[0] + a[1] * a[1]) + (a[2] * a[2] + a[3] * a[3])) + ((b[0] * b[0] + b[1] * b[1]) + (b[2] * b[2] + b[3] * b[3]));
                    ss += __shfl_xor(ss, 16); ss += __shfl_xor(ss, 32);
                    if (fq == 0) S[((rl0 + 128 * ai + 16 * m) * 2 + bj) * 4 + wc] = ss; } }
        } else if (fq == 0) { const float* kp = kpess + rowu;
            EPI_LOOP_AI_M { const float val = (wc == 2) ? sv[ai][m] : kp[fr + 128 * ai + 16 * m];
                S[((rl0 + 128 * ai + 16 * m) * 2 + 0) * 4 + wc] = val; S[((rl0 + 128 * ai + 16 * m) * 2 + 1) * 4 + wc] = val; }
        }
        asm volatile("s_waitcnt lgkmcnt(0)\n\ts_barrier" ::: "memory");
        const char* peb = (const char*)(KVLAT + (size_t)rowu * 256 + KVLR); const unsigned plo = (unsigned)(fr * 256 + 8 * fq) * 2u, ppo = (unsigned)(fr * 256 + 8 * (fq ^ 2)) * 2u;
        const char* rb = (const char*)(ROPE + (size_t)(NMETA + tu) * 32); const unsigned rlo = (unsigned)(fr * 32 + 16 * (fq & 1)) * 4u;
        u32x4 nxo = {0u, 0u, 0u, 0u}, nxp = nxo; f32x4 cn[4] = {{0.f, 0.f, 0.f, 0.f}, {0.f, 0.f, 0.f, 0.f}, {0.f, 0.f, 0.f, 0.f}, {0.f, 0.f, 0.f, 0.f}};
        if (wc == 2) { nxo = *(const u32x4*)(peb + plo); nxp = *(const u32x4*)(peb + ppo); cn[0] = *(const f32x4*)(rb + rlo); cn[1] = *(const f32x4*)(rb + rlo + 16); cn[2] = *(const f32x4*)(rb + rlo + 32); cn[3] = *(const f32x4*)(rb + rlo + 48); }
        char* kfb = (char*)KF + (((size_t)(bb * NH + 2 * u.pn) * LPK + KOFF + tu) * DQK) * 2; const unsigned klo = (unsigned)(fr * DQK + 8 * fq) * 2u;
        if (wc < 2) {
            const f32x4 w0 = *(const f32x4*)(k_nw + 32 * wc + 8 * fq), w1 = *(const f32x4*)(k_nw + 32 * wc + 8 * fq + 4);
            EPI_LOOP_AI_M { const int rl = rl0 + 128 * ai + 16 * m;
#pragma unroll
                for (int bj = 0; bj < 2; ++bj) { const f32x4 pt = *(const LAS f32x4*)(S + (rl * 2 + bj) * 4);
                    const float tot = (pt[0] + pt[1]) * pt[2] * pt[2] + pt[3], sc = pt[2] / sqrtf(tot * (1.f / DQK) + NORM_EPS);
                    *(u32x4*)(kfb + (size_t)bj * ((size_t)LPK * DQK * 2) + (size_t)(128 * ai + 16 * m) * (DQK * 2) + 64 * wc + klo) = pack8(acc[ai][bj][m][0] * sc * w0, acc[ai][bj][m][1] * sc * w1); } }
        } else {
            char* vb = (char*)VO + (((size_t)bb * LPK + KOFF + tu) * 1024 + (size_t)(2 * u.pn) * 128 + 64 + 32 * (wc - 2)) * 2; const unsigned vlo = (unsigned)(fr * 1024 + 8 * fq) * 2u;
            EPI_LOOP_AI_M { const float rsc = sv[ai][m];
#pragma unroll
                for (int bj = 0; bj < 2; ++bj) *(u32x4*)(vb + (size_t)(128 * ai + 16 * m) * 2048 + 256 * bj + vlo) = pack8(acc[ai][bj][m][0] * rsc, acc[ai][bj][m][1] * rsc); }
        }
        __builtin_amdgcn_sched_barrier(0);
        if (wc == 2) {
            const f32x4 wo0 = *(const f32x4*)(k_nw + 64 + 8 * fq), wo1 = *(const f32x4*)(k_nw + 68 + 8 * fq), wp0 = *(const f32x4*)(k_nw + 64 + 8 * (fq ^ 2)), wp1 = *(const f32x4*)(k_nw + 68 + 8 * (fq ^ 2));
            const float sg = (fq < 2) ? -1.f : 1.f;
#pragma unroll
            for (int q = 0; q < 8; ++q) { const int qo = 128 * (q >> 2) + 16 * (q & 3), rl = rl0 + qo;
                f32x4 xo0, xo1, xp0, xp1; unpack8(nxo, xo0, xo1); unpack8(nxp, xp0, xp1); const f32x4 c0 = cn[0], c1 = cn[1], c2 = cn[2], c3 = cn[3];
                if (q < 7) { const int q1 = 128 * ((q + 1) >> 2) + 16 * ((q + 1) & 3); const char* pe = peb + (size_t)q1 * 512; const char* rp = rb + (size_t)q1 * 128 + rlo;
                    nxo = *(const u32x4*)(pe + plo); nxp = *(const u32x4*)(pe + ppo); cn[0] = *(const f32x4*)rp; cn[1] = *(const f32x4*)(rp + 16); cn[2] = *(const f32x4*)(rp + 32); cn[3] = *(const f32x4*)(rp + 48); }
#pragma unroll
                for (int bj = 0; bj < 2; ++bj) { const f32x4 pt = *(const LAS f32x4*)(S + (rl * 2 + bj) * 4);
                    const float tot = (pt[0] + pt[1]) * pt[2] * pt[2] + pt[3], rh = 1.f / sqrtf(tot * (1.f / DQK) + NORM_EPS);
                    const f32x4 a0 = xo0 * rh * wo0, a1 = xo1 * rh * wo1, p0 = xp0 * rh * wp0, p1 = xp1 * rh * wp1;
                    const f32x4 o0 = {a0[0] * c0[0] + sg * p0[0] * c0[1], a0[1] * c0[2] + sg * p0[1] * c0[3], a0[2] * c1[0] + sg * p0[2] * c1[1], a0[3] * c1[2] + sg * p0[3] * c1[3]};
                    const f32x4 o1 = {a1[0] * c2[0] + sg * p1[0] * c2[1], a1[1] * c2[2] + sg * p1[1] * c2[3], a1[2] * c3[0] + sg * p1[2] * c3[1], a1[3] * c3[2] + sg * p1[3] * c3[3]};
                    *(u32x4*)(kfb + (size_t)bj * ((size_t)LPK * DQK * 2) + (size_t)qo * (DQK * 2) + 128 + klo) = pack8(o0, o1); } }
        }
        asm volatile("s_waitcnt lgkmcnt(0)\n\ts_barrier" ::: "memory");
    }
};
struct EpiMix {
    static constexpr bool MID = true, LDSX = false;
    bf16* O; const bf16* G1; const bf16* GR;
    __device__ __forceinline__ void mid(f32x4 (&acc)[2][2][4][2], const Unit& u, int wr, int wc, int fr, int fq) const {
        const char* gb = (const char*)GR + ((size_t)(u.pm * 256 + wr * 64) * 1024 + 256 * u.pn + 64 * wc) * 2; const unsigned lo = (unsigned)(fr * 1024 + 16 * fq) * 2u;
#pragma unroll
        for (int ai = 0; ai < 2; ++ai) { u32x4 gw[4][2];
#pragma unroll
            for (int m = 0; m < 4; ++m)
#pragma unroll
                for (int bj = 0; bj < 2; ++bj) gw[m][bj] = *(const u32x4*)(gb + (size_t)(128 * ai + 16 * m) * 2048 + lo + 16 * bj);
            __builtin_amdgcn_sched_barrier(0);
#pragma unroll
            for (int m = 0; m < 4; ++m)
#pragma unroll
                for (int bj = 0; bj < 2; ++bj) { f32x4 g0, g1; unpack8(gw[m][bj], g0, g1); acc[ai][bj][m][0] *= g0; acc[ai][bj][m][1] *= g1; }
            __builtin_amdgcn_sched_barrier(0); }
    }
    __device__ __forceinline__ void operator()(const f32x4 (&acc)[2][2][4][2], const Unit& u, int wr, int wc, int fr, int fq) const {
        const size_t ub = ((size_t)(u.pm * 256 + wr * 64) * 1024 + 256 * u.pn + 64 * wc) * 2; const unsigned lo = (unsigned)(fr * 1024 + 16 * fq) * 2u;
        const char* gb = (const char*)G1 + ub; char* ob = (char*)O + ub;
        u32x4 gw[2][4][2];
        EPI_LOOP_AI_M {
#pragma unroll
            for (int bj = 0; bj < 2; ++bj) gw[ai][m][bj] = *(const u32x4*)(gb + (size_t)(128 * ai + 16 * m) * 2048 + lo + 16 * bj); }
        __builtin_amdgcn_sched_barrier(0);
        EPI_LOADS_DONE();
        EPI_LOOP_AI_M {
#pragma unroll
            for (int bj = 0; bj < 2; ++bj) { f32x4 g0, g1; unpack8(gw[ai][m][bj], g0, g1);
                *(u32x4*)(ob + (size_t)(128 * ai + 16 * m) * 2048 + lo + 16 * bj) = pack8(g0 * acc[ai][bj][m][0], g1 * acc[ai][bj][m][1]); } }
    }
};
struct EpiResid {
    static constexpr bool MID = false, LDSX = false;
    const bf16* X; bf16* H1B; unsigned char* H1Q;
    __device__ __forceinline__ void operator()(const f32x4 (&acc)[2][2][4][2], const Unit& u, int wr, int wc, int fr, int fq) const {
        const size_t ue = (size_t)(u.pm * 256 + wr * 64) * 1024 + 256 * u.pn + 64 * wc; const unsigned le = (unsigned)(fr * 1024 + 16 * fq);
        const char* xb = (const char*)X + ue * 2; char* hb = (char*)H1B + ue * 2; unsigned char* qb = H1Q + ue;
        u32x4 xv[2][4][2];
        EPI_LOOP_AI_M {
#pragma unroll
            for (int bj = 0; bj < 2; ++bj) xv[ai][m][bj] = *(const u32x4*)(xb + (size_t)(128 * ai + 16 * m) * 2048 + le * 2u + 16 * bj); }
        __builtin_amdgcn_sched_barrier(0);
        EPI_LOADS_DONE();
        EPI_LOOP_AI_M {
#pragma unroll
            for (int bj = 0; bj < 2; ++bj) {
                f32x4 x0, x1; unpack8(xv[ai][m][bj], x0, x1); const f32x4 v0 = x0 + acc[ai][bj][m][0], v1 = x1 + acc[ai][bj][m][1];
                *(u32x4*)(hb + (size_t)(128 * ai + 16 * m) * 2048 + le * 2u + 16 * bj) = pack8(v0, v1);
                *(u32x2*)(qb + (size_t)(128 * ai + 16 * m) * 1024 + le + 8 * bj) = (u32x2){pk4_fp8(v0[0], v0[1], v0[2], v0[3]), pk4_fp8(v1[0], v1[1], v1[2], v1[3])}; } }
    }
};
struct EpiSwiGLU {
    static constexpr bool MID = false, LDSX = false;
    unsigned char* ACT; const float* bgu; const float* lrs; const volatile LAS int* tb;
    __device__ __forceinline__ void operator()(const f32x4 (&acc)[2][2][4][2], const Unit& u, int wr, int wc, int fr, int fq) const {
        const int r0 = wr * 64 + fr, cw = wc * 32 + 8 * fq, slot0 = (u.pm - __builtin_amdgcn_readfirstlane(tb[u.e])) * 256;
        const float* bg = bgu + (size_t)u.e * 2048 + 128 * u.pn + cw; const float* lr = lrs + (size_t)u.e * ECAP + slot0;
        const f32x4 bg0 = *(const f32x4*)(bg), bg1 = *(const f32x4*)(bg + 4), bu0 = *(const f32x4*)(bg + 1024), bu1 = *(const f32x4*)(bg + 1028);
        float sv[2][4];
        EPI_LOOP_AI_M sv[ai][m] = lr[r0 + 128 * ai + 16 * m];
        asm volatile("" : "+v"(sv[0][0]), "+v"(sv[0][1]), "+v"(sv[0][2]), "+v"(sv[0][3]), "+v"(sv[1][0]), "+v"(sv[1][1]), "+v"(sv[1][2]), "+v"(sv[1][3]));
        EPI_LOADS_DONE();
        constexpr float NC = -SW_ALPHA * 1.4426950408889634f;
        f32x4 bgv[2] = {bg0, bg1}, buv[2] = {bu0 + 1.f, bu1 + 1.f};
        EPI_LOOP_AI_M { const int r = r0 + 128 * ai + 16 * m; const float s = (r < u.cnt) ? sv[ai][m] * W8_INV : 0.f; const f32x2 s2 = {s, s};
            f32x4 v[2];
#pragma unroll
            for (int n = 0; n < 2; ++n)
#pragma unroll
                for (int h = 0; h < 2; ++h) {
                    const f32x2 ag = {acc[ai][0][m][n][2 * h], acc[ai][0][m][n][2 * h + 1]}, au = {acc[ai][1][m][n][2 * h], acc[ai][1][m][n][2 * h + 1]};
                    const f32x2 bg2 = {bgv[n][2 * h], bgv[n][2 * h + 1]}, bu2 = {buv[n][2 * h], buv[n][2 * h + 1]};
                    f32x2 g = ag * s2 + bg2; g[0] = fminf(g[0], SW_LIMIT); g[1] = fminf(g[1], SW_LIMIT);
                    f32x2 uu = au * s2 + bu2; uu[0] = __builtin_amdgcn_fmed3f(uu[0], 1.f - SW_LIMIT, 1.f + SW_LIMIT); uu[1] = __builtin_amdgcn_fmed3f(uu[1], 1.f - SW_LIMIT, 1.f + SW_LIMIT);
                    const f32x2 x = g * NC; f32x2 d = {__builtin_amdgcn_exp2f(x[0]), __builtin_amdgcn_exp2f(x[1])}; d = d + 1.f;
                    const f32x2 rc = {__builtin_amdgcn_rcpf(d[0]), __builtin_amdgcn_rcpf(d[1])};
                    const f32x2 o = (uu * g) * rc; v[n][2 * h] = o[0]; v[n][2 * h + 1] = o[1]; }
            *(u32x2*)(ACT + ((size_t)u.pm * 256 + r) * 1024 + 128 * u.pn + cw) = (u32x2){pk4_fp8(v[0][0], v[0][1], v[0][2], v[0][3]), pk4_fp8(v[1][0], v[1][1], v[1][2], v[1][3])}; }
    }
};
struct EpiDown {
    static constexpr bool MID = false, LDSX = false;
    unsigned char* Y; const float* bd; const float* lw; const volatile LAS int* tb;
    __device__ __forceinline__ void operator()(const f32x4 (&acc)[2][2][4][2], const Unit& u, int wr, int wc, int fr, int fq) const {
        const int r0 = wr * 64 + fr, cb = 256 * u.pn + 64 * wc + 16 * fq, slot0 = (u.pm - __builtin_amdgcn_readfirstlane(tb[u.e])) * 256;
        const float* bp = bd + (size_t)u.e * 1024 + cb; const float* lwp = lw + (size_t)u.e * ECAP + slot0;
        f32x4 bv[2][2];
#pragma unroll
        for (int bj = 0; bj < 2; ++bj)
#pragma unroll
            for (int n = 0; n < 2; ++n) bv[bj][n] = *(const f32x4*)(bp + 8 * bj + 4 * n);
        float wv[2][4];
        EPI_LOOP_AI_M wv[ai][m] = lwp[r0 + 128 * ai + 16 * m];
        asm volatile("" : "+v"(wv[0][0]), "+v"(wv[0][1]), "+v"(wv[0][2]), "+v"(wv[0][3]), "+v"(wv[1][0]), "+v"(wv[1][1]), "+v"(wv[1][2]), "+v"(wv[1][3]));
        EPI_LOADS_DONE();
        EPI_LOOP_AI_M { const int r = r0 + 128 * ai + 16 * m; const float w = (r < u.cnt) ? wv[ai][m] * Y8_SCALE : 0.f; u32x4 o;
            { const f32x4 v0 = (acc[ai][0][m][0] * W8_INV + bv[0][0]) * w, v1 = (acc[ai][0][m][1] * W8_INV + bv[0][1]) * w; o.x = pk4_fp8(v0[0], v0[1], v0[2], v0[3]); o.y = pk4_fp8(v1[0], v1[1], v1[2], v1[3]); }
            { const f32x4 v0 = (acc[ai][1][m][0] * W8_INV + bv[1][0]) * w, v1 = (acc[ai][1][m][1] * W8_INV + bv[1][1]) * w; o.z = pk4_fp8(v0[0], v0[1], v0[2], v0[3]); o.w = pk4_fp8(v1[0], v1[1], v1[2], v1[3]); }
            *(u32x4*)(Y + ((size_t)u.pm * 256 + r) * 1024 + cb) = o; }
    }
};

struct Ctx {
    LAS unsigned char* lds; gu32* ctl; unsigned char* ws;
    int tid, lane, wave, vcu, G;
    const float *x, *meta, *attn_nw, *w_in, *dw_w, *dw_b, *ln_w, *ln_b, *pw2_w, *qa_nw, *w_qb, *kva_nw, *w_kvb, *q_nw, *k_nw, *w_o, *gate_b, *w_out, *ffn_nw, *router_w, *router_b, *w_gu, *b_gu, *w_d, *b_d;
    float* out;
};
#define WSP(T, off) ((T*)(F.ws + (off)))

__device__ __forceinline__ void tr_item(const float* src, int ld_src, int k0, int colA, int colB, const float* ks, bf16* dst, int ld_dst, LAS unsigned* scr, int lane) {
    const int nq = lane & 15, kq = lane >> 4; const int col = (nq >> 3) ? colB : colA; const int c4 = col + 4 * (nq & 7);
#pragma unroll
    for (int i = 0; i < 8; ++i) { const int kp = 4 * i + kq; f32x4 a = {0.f, 0.f, 0.f, 0.f}, b = {0.f, 0.f, 0.f, 0.f};
        if (col >= 0) { a = *(const f32x4*)(src + (size_t)(k0 + 2 * kp) * ld_src + c4); b = *(const f32x4*)(src + (size_t)(k0 + 2 * kp + 1) * ld_src + c4); }
        if (ks) { a *= ks[k0 + 2 * kp]; b *= ks[k0 + 2 * kp + 1]; }
        LAS unsigned* p = scr + kp * 65 + 4 * nq; p[0] = pk2(a[0], b[0]); p[1] = pk2(a[1], b[1]); p[2] = pk2(a[2], b[2]); p[3] = pk2(a[3], b[3]); }
    LDS_WAIT(); asm volatile("" ::: "memory");
    const int c = lane & 7;
#pragma unroll
    for (int j = 0; j < 8; ++j) { const int n = (lane >> 3) + 8 * j; const LAS unsigned* s = scr + (4 * c) * 65 + n;
        u32x4 o; o.x = s[0]; o.y = s[65]; o.z = s[130]; o.w = s[195];
        *(u32x4*)(dst + (size_t)n * ld_dst + 8 * c) = o; }
    LDS_WAIT(); asm volatile("" ::: "memory");
}
__device__ __forceinline__ void tr_item8(const float* src, int ld_src, int k0, int colA, int colB, const float* ks, unsigned char* dst, int ld_dst, LAS unsigned* scr, int lane) {
    const int nq = lane & 15, kq = lane >> 4; const int col = (nq >> 3) ? colB : colA; const int c4 = col + 4 * (nq & 7);
#pragma unroll
    for (int i = 0; i < 8; ++i) { const int kg = 4 * i + kq; const float* sp = src + (size_t)(k0 + 4 * kg) * ld_src + c4;
        f32x4 a = {0.f, 0.f, 0.f, 0.f}, b = a, c = a, d = a;
        if (col >= 0) { a = __builtin_nontemporal_load((const f32x4*)sp); b = __builtin_nontemporal_load((const f32x4*)(sp + ld_src)); c = __builtin_nontemporal_load((const f32x4*)(sp + 2 * (size_t)ld_src)); d = __builtin_nontemporal_load((const f32x4*)(sp + 3 * (size_t)ld_src)); }
        float s0 = W8_SCALE, s1 = W8_SCALE, s2 = W8_SCALE, s3 = W8_SCALE;
        if (ks) { const f32x4 kv = *(const f32x4*)(ks + k0 + 4 * kg); s0 *= kv[0]; s1 *= kv[1]; s2 *= kv[2]; s3 *= kv[3]; }
        a *= s0; b *= s1; c *= s2; d *= s3;
        LAS unsigned* p = scr + kg * 65 + 4 * nq;
        p[0] = pk4_fp8(a[0], b[0], c[0], d[0]); p[1] = pk4_fp8(a[1], b[1], c[1], d[1]); p[2] = pk4_fp8(a[2], b[2], c[2], d[2]); p[3] = pk4_fp8(a[3], b[3], c[3], d[3]); }
    LDS_WAIT(); asm volatile("" ::: "memory");
    const int c = lane & 7;
#pragma unroll
    for (int j = 0; j < 8; ++j) { const int n = (lane >> 3) + 8 * j; const LAS unsigned* s = scr + (4 * c) * 65 + n;
        u32x4 o; o.x = s[0]; o.y = s[65]; o.z = s[130]; o.w = s[195];
        *(u32x4*)(dst + (size_t)n * ld_dst + 16 * c) = o; }
    LDS_WAIT(); asm volatile("" ::: "memory");
}
__device__ __forceinline__ int colmap_in(int n32) { const int tile = n32 >> 3, j = n32 & 7;
    if (tile < 4) return (j < 4) ? 128 * tile + 32 * j : 512 + 128 * tile + 32 * (j - 4);
    if (tile == 4) return 1024 + 32 * j;
    if (tile == 5) return (j < 5) ? 1280 + 32 * j : -1;
    return (j < 4) ? 1440 + 128 * (tile - 6) + 32 * j : 1440 + 1024 + 128 * (tile - 6) + 32 * (j - 4); }
__device__ __forceinline__ int colmap_gu(int n32) { const int tile = n32 >> 3, j = n32 & 7; return (j < 4) ? 128 * tile + 32 * j : 1024 + 128 * tile + 32 * (j - 4); }
__device__ __forceinline__ int colmap_qb(int n32) { const int h = n32 >> 2, j = n32 & 3; return (j < 3) ? 96 * h + 32 * j : -1; }

__device__ __forceinline__ void p0_item(Ctx& F, int it, LAS unsigned* scr) {
    constexpr int I_GU = 256, I_D = 128, N_GU = NE * I_GU, N_D = NE * I_D, N_WIN = INPROJ_FP8 ? 56 * 8 : 56 * 16, N_WOUT = 256, N_PW2 = 128, N_WO = 128, N_QB = 64;
    int r = it;
    if (r < N_GU) { const int e = r / I_GU, q = r % I_GU, nb = q & 31, kb = q >> 5;
        tr_item8(F.w_gu + (size_t)e * 1024 * 2048, 2048, 128 * kb, colmap_gu(2 * nb), colmap_gu(2 * nb + 1), F.ffn_nw, WSP(unsigned char, WS_WGU) + ((size_t)e * 2048 + 64 * nb) * 1024 + 128 * kb, 1024, scr, F.lane); return; }
    r -= N_GU;
    if (r < N_D) { const int e = r / I_D, q = r % I_D, nb = q & 15, kb = q >> 4;
        tr_item8(F.w_d + (size_t)e * 1024 * 1024, 1024, 128 * kb, 64 * nb, 64 * nb + 32, nullptr, WSP(unsigned char, WS_WD) + ((size_t)e * 1024 + 64 * nb) * 1024 + 128 * kb, 1024, scr, F.lane); return; }
    r -= N_D;
#if INPROJ_FP8
    if (r < N_WIN) { const int nb = r >> 3, kb = r & 7;
        tr_item8(F.w_in, INC, 128 * kb, colmap_in(2 * nb), colmap_in(2 * nb + 1), F.attn_nw, WSP(unsigned char, WS_WIN) + (size_t)(64 * nb) * 1024 + 128 * kb, 1024, scr, F.lane); return; }
#else
    if (r < N_WIN) { const int nb = r >> 4, kb = r & 15;
        tr_item(F.w_in, INC, 64 * kb, colmap_in(2 * nb), colmap_in(2 * nb + 1), F.attn_nw, WSP(bf16, WS_WIN) + (size_t)(64 * nb) * 1024 + 64 * kb, 1024, scr, F.lane); return; }
#endif
    r -= N_WIN;
    if (r < N_WOUT) { const int nb = r >> 4, kb = r & 15;
        tr_item(F.w_out, 1024, 64 * kb, 64 * nb, 64 * nb + 32, nullptr, WSP(bf16, WS_WOUT) + (size_t)(64 * nb) * 1024 + 64 * kb, 1024, scr, F.lane); return; }
    r -= N_WOUT;
    if (r < N_PW2) { const int nb = r >> 3, kb = r & 7;
        tr_item(F.pw2_w, 1024, 64 * kb, 64 * nb, 64 * nb + 32, nullptr, WSP(bf16, WS_W2T) + (size_t)(64 * nb) * 1024 + 64 * kb, 1024, scr, F.lane); return; }
    r -= N_PW2;
    if (r < N_WO) { const int nb = r >> 3, kb = r & 7;
        tr_item(F.w_o, 1024, 64 * kb, 64 * nb, 64 * nb + 32, nullptr, WSP(bf16, WS_W2T) + (size_t)(64 * nb) * 1024 + 512 + 64 * kb, 1024, scr, F.lane); return; }
    r -= N_WO;
    if (r < N_QB) { const int nb = r >> 2, kb = r & 3;
        tr_item(F.w_qb, 768, 64 * kb, colmap_qb(2 * nb), colmap_qb(2 * nb + 1), F.qa_nw, WSP(bf16, WS_WQB) + (size_t)(64 * nb) * 256 + 64 * kb, 256, scr, F.lane); return; }
    r -= N_QB;
    { const int nb = r >> 2, kb = r & 3; const bool real = kb < 2;
        tr_item(F.w_kvb, 1024, real ? 64 * kb : 0, real ? 64 * nb : -1, real ? 64 * nb + 32 : -1, real ? F.kva_nw : nullptr, WSP(bf16, WS_WKVB) + (size_t)(64 * nb) * 256 + 64 * kb, 256, scr, F.lane); }
}
constexpr int P0_NITEMS = NE * 256 + NE * 128 + (INPROJ_FP8 ? 56 * 8 : 56 * 16) + 256 + 128 + 128 + 64 + 64;

__device__ __forceinline__ void p0_prologue(Ctx& F) {
    LAS unsigned* scr = (LAS unsigned*)F.lds + F.wave * 2080;
    const int gw = F.vcu * 8 + F.wave, NGW = F.G * 8, gth = gw * 64 + F.lane, NGT = NGW * 64;
    for (int it = gw; it < P0_NITEMS; it += NGW) p0_item(F, it, scr);
    bf16* XN = WSP(bf16, WS_XN);
    for (int m2 = gw; m2 < MT / 2; m2 += NGW) {
        f32x4 v[2][4]; float ss[2];
#pragma unroll
        for (int q = 0; q < 2; ++q) { const f32x4* xr = (const f32x4*)(F.x + (size_t)(2 * m2 + q) * DM) + F.lane;
#pragma unroll
            for (int j = 0; j < 4; ++j) v[q][j] = __builtin_nontemporal_load(xr + 64 * j); }
#pragma unroll
        for (int q = 0; q < 2; ++q) { float sq = 0.f;
#pragma unroll
            for (int j = 0; j < 4; ++j) sq += (v[q][j][0] * v[q][j][0] + v[q][j][1] * v[q][j][1]) + (v[q][j][2] * v[q][j][2] + v[q][j][3] * v[q][j][3]);
            ss[q] = sq; }
        ss[0] = wave_sum(ss[0]); ss[1] = wave_sum(ss[1]);
#pragma unroll
        for (int q = 0; q < 2; ++q) { if (F.lane == 0) WSP(float, WS_RSX)[2 * m2 + q] = (INPROJ_FP8 ? 1.f / (XQ_SCALE * W8_SCALE) : 1.f) / sqrtf(ss[q] * (1.f / DM) + NORM_EPS);
            u32x2* o8 = (u32x2*)(XN + (size_t)(2 * m2 + q) * DM) + F.lane;
#pragma unroll
            for (int j = 0; j < 4; ++j) { u32x2 o; o.x = pk2(v[q][j][0], v[q][j][1]); o.y = pk2(v[q][j][2], v[q][j][3]); o8[64 * j] = o; }
#if INPROJ_FP8
            unsigned* o4 = (unsigned*)(WSP(unsigned char, WS_XQ) + (size_t)(2 * m2 + q) * DM) + F.lane;
#pragma unroll
            for (int j = 0; j < 4; ++j) o4[64 * j] = pk4_fp8(v[q][j][0] * XQ_SCALE, v[q][j][1] * XQ_SCALE, v[q][j][2] * XQ_SCALE, v[q][j][3] * XQ_SCALE);
#endif
        }
    }
    float* PMP = WSP(float, WS_PMP);
    if (F.wave == 7)
    for (int task = F.vcu; task < 19 * 8; task += F.G) { const int cg = task >> 3, kc = task & 7, cp = 64 * cg + F.lane; const bool valid = cp < PMC;
        const int sc = (cp < 1024) ? cp : 1280 + (cp - 1024);
        LAS float* ms = (LAS float*)scr;
#pragma unroll
        for (int r = 0; r < 16; ++r) { ms[r * 128 + F.lane] = F.meta[r * DM + kc * 128 + F.lane] * F.attn_nw[kc * 128 + F.lane]; ms[r * 128 + 64 + F.lane] = F.meta[r * DM + kc * 128 + 64 + F.lane] * F.attn_nw[kc * 128 + 64 + F.lane]; }
        LDS_WAIT(); asm volatile("" ::: "memory");
        float acc[16];
#pragma unroll
        for (int r = 0; r < 16; ++r) acc[r] = 0.f;
        const float* wp = F.w_in + (size_t)(kc * 128) * INC + (valid ? sc : 0);
        for (int k = 0; k < 128; k += 4) { const float w0 = wp[(size_t)k * INC], w1 = wp[(size_t)(k + 1) * INC], w2 = wp[(size_t)(k + 2) * INC], w3 = wp[(size_t)(k + 3) * INC];
#pragma unroll
            for (int r = 0; r < 16; ++r) { const f32x4 mv = *(const LAS f32x4*)(ms + r * 128 + k); acc[r] += (mv[0] * w0 + mv[1] * w1) + (mv[2] * w2 + mv[3] * w3); } }
        if (valid) {
#pragma unroll
            for (int r = 0; r < 16; ++r) PMP[(kc * 16 + r) * PMC + cp] = acc[r]; }
        LDS_WAIT(); asm volatile("" ::: "memory");
    }
    float* ROPE = WSP(float, WS_ROPE);
    for (int idx = gth; idx < (SEQ + NMETA) * 16; idx += NGT) { const int pos = idx >> 4, i = idx & 15;
        const double invf[16] = {1, 0.56234132519034907, 0.31622776601683794, 0.17782794100389229, 0.10000000000000001, 0.056234132519034911, 0.031622776601683791, 0.017782794100389229, 0.01, 0.005623413251903491, 0.0031622776601683794, 0.0017782794100389228, 0.001, 0.0005623413251903491, 0.00031622776601683794, 0.00017782794100389227};
        double fq = invf[0];
#pragma unroll
        for (int q = 1; q < 16; ++q) fq = (i == q) ? invf[q] : fq;
        const double ang = (double)pos * fq, red = ang - 6.283185307179586477 * __builtin_rint(ang * 0.15915494309189533577);
        float sn, cs; sincosf((float)red, &sn, &cs);
        ROPE[2 * idx] = cs; ROPE[2 * idx + 1] = sn; }
    for (int r = gw; r < NMETA; r += NGW) { float s = 0.f;
        for (int k = F.lane; k < DM; k += 64) { const float v = F.meta[r * DM + k]; s += v * v; }
        s = wave_sum(s); if (F.lane == 0) WSP(float, WS_METARS)[r] = 1.f / sqrtf(s * (1.f / DM) + NORM_EPS); }
    { unsigned short* RW3 = WSP(unsigned short, WS_RW3);
      for (int idx = gth; idx < DM * NE; idx += NGT) { const int k = idx >> 5, e = idx & 31; const float w = F.ffn_nw[k] * F.router_w[idx];
          const unsigned h = pk2(w, 0.f) & 0xffffu; const float r1 = w - __builtin_bit_cast(float, h << 16);
          const unsigned m = pk2(r1, 0.f) & 0xffffu; const float r2 = r1 - __builtin_bit_cast(float, m << 16);
          const unsigned l = pk2(r2, 0.f) & 0xffffu;
          const size_t o = ((size_t)((k >> 3) * NE + e)) * 8 + (k & 7);
          RW3[o] = (unsigned short)h; RW3[(size_t)NE * DM + o] = (unsigned short)m; RW3[(size_t)2 * NE * DM + o] = (unsigned short)l; } }
}

__device__ __forceinline__ float pm_sum(const float* PMP, int r, int c) { float s = 0.f;
#pragma unroll
    for (int kc = 0; kc < 8; ++kc) s += PMP[(kc * 16 + r) * PMC + c];
    return s; }
__device__ __forceinline__ void p1_meta(Ctx& F) {
    const float* PMP = WSP(float, WS_PMP); float* MRS = WSP(float, WS_METARS);
    const int bx = blockIdx.x;
    if (bx < 16) { const int rm = bx, c = F.tid; bf16* HG = WSP(bf16, WS_HG);
        const float rs = MRS[rm]; const float val = rs * pm_sum(PMP, rm, c) * sigmoid_f(rs * pm_sum(PMP, rm, 512 + c)); const bf16 hv = (bf16)f2bf(val);
#pragma unroll
        for (int b = 0; b < NB; ++b) { HG[((size_t)b * LPC + rm) * CDIM + c] = (bf16)0; HG[((size_t)b * LPC + 16 + rm) * CDIM + c] = hv; }
    } else if (bx == 16) {
#pragma unroll
        for (int q = 0; q < 2; ++q) { const int r = 2 * F.wave + q; const float rs = MRS[r];
            const float v0 = rs * pm_sum(PMP, r, 1024 + F.lane), v1 = rs * pm_sum(PMP, r, 1024 + 64 + F.lane);
            const float ss = wave_sum(v0 * v0 + v1 * v1); if (F.lane == 0) MRS[16 + r] = 1.f / sqrtf(ss * (1.f / KVLR) + NORM_EPS); }
    } else if (bx < 17 + 37) { float* PMF = WSP(float, WS_PMF);
        const int idx = (bx - 17) * 512 + F.tid; if (idx < 16 * PMC) PMF[idx] = pm_sum(PMP, idx / PMC, idx % PMC);
    } else if (bx < 54 + 8) {
        const int q = bx - 54, n = (q & 1) * 512 + F.tid, r0 = 4 * (q >> 1); LAS float* cs = (LAS float*)F.lds;
        { const int r = F.tid >> 7, k = F.tid & 127; cs[F.tid] = MRS[r0 + r] * pm_sum(PMP, r0 + r, 1024 + k); }
        __syncthreads();
        if (F.tid < 256) { const int r = F.tid >> 6, l = F.tid & 63; const float v0 = cs[r * 128 + l], v1 = cs[r * 128 + 64 + l]; const float ss = wave_sum(v0 * v0 + v1 * v1);
            if (l == 0) cs[512 + r] = 1.f / sqrtf(ss * (1.f / KVLR) + NORM_EPS); }
        __syncthreads();
        { const int r = F.tid >> 7, k = F.tid & 127; cs[F.tid] *= cs[512 + r] * F.kva_nw[k]; }
        __syncthreads();
        float acc[4] = {0.f, 0.f, 0.f, 0.f};
#pragma unroll 8
        for (int k = 0; k < KVLR; k += 4) { const float w0 = F.w_kvb[k * 1024 + n], w1 = F.w_kvb[(k + 1) * 1024 + n], w2 = F.w_kvb[(k + 2) * 1024 + n], w3 = F.w_kvb[(k + 3) * 1024 + n];
#pragma unroll
            for (int r = 0; r < 4; ++r) { const f32x4 c = *(const LAS f32x4*)(cs + r * 128 + k); acc[r] += (c[0] * w0 + c[1] * w1) + (c[2] * w2 + c[3] * w3); } }
#pragma unroll
        for (int r = 0; r < 4; ++r) WSP(float, WS_KVMETA)[(r0 + r) * 1024 + n] = acc[r];
        __syncthreads();
    }
}

__device__ __forceinline__ void p2_thin(Ctx& F) {
    {
        const bf16* HG = WSP(bf16, WS_HG); bf16* HC = WSP(bf16, WS_HCO);
        LAS unsigned char* lin = F.lds; LAS float* lout = (LAS float*)(F.lds + 63488);
        const int cp = F.tid & 255, th = F.tid >> 8;
        float wlo[CWID], whi[CWID];
#pragma unroll
        for (int j = 0; j < CWID; ++j) { const f32x2 w = *(const f32x2*)(F.dw_w + j * CDIM + 2 * cp); wlo[j] = w[0]; whi[j] = w[1]; }
        const f32x2 cb = *(const f32x2*)(F.dw_b + 2 * cp);
#define P2_LBAR() asm volatile("s_waitcnt lgkmcnt(0)\n\ts_barrier" ::: "memory")
        for (int rp = 0; rp < 1 + PROBE_P2A; ++rp) {
        u32x4 nx[8];
        if (F.vcu < NB * (SEQ / 32)) { const int b = F.vcu >> 7, t0 = (F.vcu & 127) * 32;
#pragma unroll
            for (int i = 0; i < 8; ++i) { const int p = F.tid + 512 * i; nx[i] = (u32x4){0u, 0u, 0u, 0u}; if (p < 62 * 64) nx[i] = *(const u32x4*)(HG + ((size_t)b * LPC + t0 + 2 + (p >> 6)) * CDIM + (p & 63) * 8); } }
        for (int un = F.vcu; un < NB * (SEQ / 32); un += F.G) { const int b = un >> 7, t0 = (un & 127) * 32;
#pragma unroll
            for (int i = 0; i < 8; ++i) { const int p = F.tid + 512 * i; if (p < 62 * 64) { const int row = p >> 6, ch = p & 63; *(LAS u32x4*)(lin + row * 1024 + ch * 16) = nx[i]; } }
            P2_LBAR();
            if (un + F.G < NB * (SEQ / 32)) { const int un1 = un + F.G, b1 = un1 >> 7, t1 = (un1 & 127) * 32;
#pragma unroll
                for (int i = 0; i < 8; ++i) { const int p = F.tid + 512 * i; if (p < 62 * 64) nx[i] = *(const u32x4*)(HG + ((size_t)b1 * LPC + t1 + 2 + (p >> 6)) * CDIM + (p & 63) * 8); } }
#pragma unroll
            for (int g = 0; g < 2; ++g) { const int tl0 = th * 16 + g * 8; float a0[8], a1[8];
#pragma unroll
                for (int o = 0; o < 8; ++o) { a0[o] = cb[0]; a1[o] = cb[1]; }
#pragma unroll
                for (int jj = 0; jj < 38; ++jj) { const unsigned v = *(const LAS unsigned*)(lin + (tl0 + jj) * 1024 + 4 * cp); const float lo = bflo(v), hi = bfhi(v);
#pragma unroll
                    for (int o = 0; o < 8; ++o) { const int j = jj - o; if (j >= 0 && j < CWID) { a0[o] += wlo[j] * lo; a1[o] += whi[j] * hi; } } }
#pragma unroll
                for (int o = 0; o < 8; ++o) *(LAS f32x2*)(lout + (tl0 + o) * CDIM + 2 * cp) = (f32x2){a0[o], a1[o]}; }
            P2_LBAR();
            { const int tok = 4 * F.wave + (F.lane >> 4), l16 = F.lane & 15;
                f32x4 v[4][2]; float sm = 0.f;
#pragma unroll
                for (int j = 0; j < 4; ++j) { const LAS float* lr = lout + tok * CDIM + 128 * j + 8 * l16; v[j][0] = *(const LAS f32x4*)lr; v[j][1] = *(const LAS f32x4*)(lr + 4);
                    sm += (v[j][0][0] + v[j][0][1]) + (v[j][0][2] + v[j][0][3]) + (v[j][1][0] + v[j][1][1]) + (v[j][1][2] + v[j][1][3]); }
                const float mean = sum16(sm) * (1.f / CDIM); float sv = 0.f;
#pragma unroll
                for (int j = 0; j < 4; ++j)
#pragma unroll
                    for (int q = 0; q < 2; ++q) { v[j][q] = v[j][q] - mean; sv += (v[j][q][0] * v[j][q][0] + v[j][q][1] * v[j][q][1]) + (v[j][q][2] * v[j][q][2] + v[j][q][3] * v[j][q][3]); }
                const float rstd = 1.f / sqrtf(sum16(sv) * (1.f / CDIM) + NORM_EPS);
#pragma unroll
                for (int j = 0; j < 4; ++j) { const int c0 = 128 * j + 8 * l16;
                    const f32x4 w0 = *(const f32x4*)(F.ln_w + c0), w1 = *(const f32x4*)(F.ln_w + c0 + 4), b0 = *(const f32x4*)(F.ln_b + c0), b1 = *(const f32x4*)(F.ln_b + c0 + 4);
                    f32x4 y0 = v[j][0] * rstd * w0 + b0, y1 = v[j][1] * rstd * w1 + b1;
#pragma unroll
                    for (int e = 0; e < 4; ++e) { y0[e] = y0[e] * sigmoid_f(y0[e]); y1[e] = y1[e] * sigmoid_f(y1[e]); }
                    *(u32x4*)(HC + ((size_t)b * SEQ + t0 + tok) * 1024 + c0) = pack8(y0, y1); } }
            P2_LBAR();
        }
        }
#undef P2_LBAR
    }
}

__device__ __forceinline__ void norm_rope_store(float (&v)[48], int part, const float* nw, const float* rp, float scale, bf16* dst) {
    float ss = 0.f;
#pragma unroll
    for (int d = 0; d < 48; ++d) ss += v[d] * v[d];
    ss += __shfl_xor(ss, 1);
    const float r = scale / sqrtf(ss * (1.f / DQK) + NORM_EPS);
    const float* nwp = nw + 48 * part;
#pragma unroll
    for (int d = 0; d < 48; ++d) v[d] *= r * nwp[d];
    if (part) {
#pragma unroll
        for (int i = 0; i < 16; ++i) { const float c = rp[2 * i], s = rp[2 * i + 1], x1 = v[16 + i], x2 = v[32 + i]; v[16 + i] = x1 * c - x2 * s; v[32 + i] = x2 * c + x1 * s; }
    }
#pragma unroll
    for (int q = 0; q < 6; ++q) { u32x4 w; w.x = pk2(v[8 * q], v[8 * q + 1]); w.y = pk2(v[8 * q + 2], v[8 * q + 3]); w.z = pk2(v[8 * q + 4], v[8 * q + 5]); w.w = pk2(v[8 * q + 6], v[8 * q + 7]); *(u32x4*)(dst + 8 * q) = w; }
}
__device__ __forceinline__ void ld8(const bf16* p, float* v) { const u32x4 w = *(const u32x4*)p; v[0] = bflo(w.x); v[1] = bfhi(w.x); v[2] = bflo(w.y); v[3] = bfhi(w.y); v[4] = bflo(w.z); v[5] = bfhi(w.z); v[6] = bflo(w.w); v[7] = bfhi(w.w); }

__device__ __forceinline__ void p4_headnorm(Ctx& F) {
    const int gw = F.vcu * 8 + F.wave, NGW = F.G * 8;
    const bf16* QRAW = WSP(bf16, WS_QRAW); bf16* KVRAW = WSP(bf16, WS_KVRAW); const bf16* KVLAT = WSP(bf16, WS_KVLAT);
    bf16* QF = WSP(bf16, WS_QF); bf16* KF = WSP(bf16, WS_KF); const float* ROPE = WSP(float, WS_ROPE);
    const float* PM = WSP(float, WS_PMF); const float* MRS = WSP(float, WS_METARS); const float* KVM = WSP(float, WS_KVMETA);
    constexpr int T_REAL = 0, T_META = NB * 4, T_DUMMY = NB * 48;
    const int part = F.lane & 1, h = (F.lane >> 1) & 7, tl = F.lane >> 4;
    for (int wt = gw; wt < T_REAL + T_META + T_DUMMY; wt += NGW) {
        if (false) {
        } else if (wt < T_REAL + T_META) {
            const int q = wt - T_REAL, b = q >> 2, r = tl + 4 * (q & 3); const float* rp = ROPE + (size_t)r * 32;
            float v[48]; const float* src = KVM + r * 1024 + h * 128; const float rs = MRS[r];
            if (part == 0) {
#pragma unroll
                for (int d = 0; d < 48; ++d) v[d] = src[d];
            } else {
#pragma unroll
                for (int d = 0; d < 16; ++d) v[d] = src[48 + d];
#pragma unroll
                for (int i = 0; i < 32; ++i) v[16 + i] = rs * PM[r * PMC + 1152 + i];
            }
            const size_t kr = (size_t)b * LPK + r;
            norm_rope_store(v, part, F.k_nw, rp, 1.f, KF + ((size_t)(b * NH + h) * LPK + r) * DQK + 48 * part);
            bf16* vd = KVRAW + kr * 1024 + h * 128 + 64 + 32 * part; const float* vs = src + 64 + 32 * part;
#pragma unroll
            for (int q8 = 0; q8 < 4; ++q8) { u32x4 w; w.x = pk2(vs[8 * q8], vs[8 * q8 + 1]); w.y = pk2(vs[8 * q8 + 2], vs[8 * q8 + 3]); w.z = pk2(vs[8 * q8 + 4], vs[8 * q8 + 5]); w.w = pk2(vs[8 * q8 + 6], vs[8 * q8 + 7]); *(u32x4*)(vd + 8 * q8) = w; }
        } else {
            const int q = wt - T_REAL - T_META, b = q / 48, r = 16 + q % 48; const size_t kr = (size_t)b * LPK + r; const u32x4 z = {0u, 0u, 0u, 0u};
            u32x4* vd = (u32x4*)(KVRAW + kr * 1024); vd[F.lane] = z; vd[64 + F.lane] = z;
            for (int q2 = F.lane; q2 < NH * 12; q2 += 64) { const int hh = q2 / 12, c = q2 % 12; *(u32x4*)(KF + ((size_t)(b * NH + hh) * LPK + r) * DQK + 8 * c) = z; }
        }
    }
}

namespace att {
constexpr int KSLOT = 16384, VSLOT = 8192, SLOT = KSLOT + VSLOT, NSLOT = 4, L_WS = NSLOT * SLOT, L_OST = 0, L_END = L_WS + 8 * 256;
static_assert(8 * 4096 <= 2 * SLOT && L_END <= RING_BYTES, "attention LDS map");
constexpr float THR = 8.f;
__device__ __forceinline__ int crow(int r, int hi) { return (r & 3) + 8 * (r >> 2) + 4 * hi; }
__device__ __forceinline__ float max3f(float a, float b, float c) { float r; asm("v_max3_f32 %0, %1, %2, %3" : "=v"(r) : "v"(a), "v"(b), "v"(c)); return r; }
__device__ __forceinline__ float max2f(float a, float b) { float r; asm("v_max_f32_e32 %0, %1, %2" : "=v"(r) : "v"(a), "v"(b)); return r; }
__device__ __forceinline__ void glds16(const void* gsrc, unsigned lds_dst) { unsigned keep;
    asm volatile("s_mov_b32 %0, m0\n\ts_mov_b32 m0, %2\n\ts_nop 0\n\tglobal_load_lds_dwordx4 %1, off\n\ts_mov_b32 m0, %0" : "=&s"(keep) : "v"(gsrc), "s"(lds_dst) : "memory"); }
typedef short v4i16_t __attribute__((ext_vector_type(4)));
__device__ __forceinline__ s16x4 vtr(const LAS unsigned char* p) { return __builtin_bit_cast(s16x4, __builtin_amdgcn_ds_read_tr16_b64_v4i16((LAS v4i16_t*)p)); }
__device__ __forceinline__ void pv(f32x16* o, const LAS unsigned char* vp, bf16x8 pa0, bf16x8 pa1, bf16x8 pa2, bf16x8 pa3) {
#pragma unroll
    for (int d0 = 0; d0 < 2; ++d0) { s16x4 lo[4], hi[4];
#pragma unroll
        for (int ks = 0; ks < 4; ++ks) { lo[ks] = vtr(vp + d0 * 4096 + ks * 1024); hi[ks] = vtr(vp + d0 * 4096 + ks * 1024 + 512); }
#define PK(k) (bf16x8){lo[k][0], lo[k][1], lo[k][2], lo[k][3], hi[k][0], hi[k][1], hi[k][2], hi[k][3]}
        o[d0] = __builtin_amdgcn_mfma_f32_32x32x16_bf16(pa0, PK(0), o[d0], 0, 0, 0);
        o[d0] = __builtin_amdgcn_mfma_f32_32x32x16_bf16(pa1, PK(1), o[d0], 0, 0, 0);
        o[d0] = __builtin_amdgcn_mfma_f32_32x32x16_bf16(pa2, PK(2), o[d0], 0, 0, 0);
        o[d0] = __builtin_amdgcn_mfma_f32_32x32x16_bf16(pa3, PK(3), o[d0], 0, 0, 0);
#undef PK
    }
}
__device__ __forceinline__ void attn_unit(Ctx& F, int b, int h, int qb) {
    const int lane = F.lane, r32 = lane & 31, hi = lane >> 5, wid = F.wave;
    const bf16* QF = WSP(bf16, WS_QF); const bf16* KF = WSP(bf16, WS_KF); const bf16* KVRAW = WSP(bf16, WS_KVRAW); bf16* O = WSP(bf16, WS_HCO) + 512;
    const size_t rowq0 = (size_t)b * SEQ + 256 * qb + 32 * wid;
    const bf16* Kh = KF + (size_t)(b * NH + h) * LPK * DQK; const bf16* Vh = KVRAW + (size_t)b * LPK * 1024 + h * 128 + 64;
    const unsigned lds0 = (unsigned)(uintptr_t)F.lds;
    const int NT = 4 * qb + 5;
    const bf16* ksrc0; const bf16* ksrc1;
    { const int row0 = 8 * wid + (lane >> 4), row1 = row0 + 4; int c0 = (lane & 15) ^ (row0 & 15), c1 = (lane & 15) ^ (row1 & 15); c0 -= (c0 >= 12) ? 4 : 0; c1 -= (c1 >= 12) ? 4 : 0;
      ksrc0 = Kh + (size_t)row0 * DQK + c0 * 8; ksrc1 = Kh + (size_t)row1 * DQK + c1 * 8; }
    const bf16* vsrc = Vh + (size_t)(16 * (wid & 3) + (lane >> 2)) * 1024 + (wid >> 2) * 32 + (lane & 3) * 8;
#define ATT_TIX(i) (((i) == 0) ? 0 : (((i) < 5) ? 4 * qb + (i) : (i) - 4))
#define ATT_DMA(i, slot) do { const int _t = ATT_TIX(i); const unsigned _s = lds0 + (slot); glds16(ksrc0 + (size_t)_t * 64 * DQK, (unsigned)__builtin_amdgcn_readfirstlane(_s + wid * 2048)); \
        glds16(ksrc1 + (size_t)_t * 64 * DQK, (unsigned)__builtin_amdgcn_readfirstlane(_s + wid * 2048 + 1024)); \
        glds16(vsrc + (size_t)_t * 64 * 1024, (unsigned)__builtin_amdgcn_readfirstlane(_s + KSLOT + wid * 1024)); } while (0)
#define ATT_BAR() asm volatile("s_waitcnt vmcnt(0) lgkmcnt(0)\n\ts_barrier" ::: "memory")
#define ATT_BARC(issued) do { if (issued) asm volatile("s_waitcnt vmcnt(3) lgkmcnt(0)\n\ts_barrier" ::: "memory"); else ATT_BAR(); } while (0)
#define ATT_KLD(slot, hh) do { const LAS unsigned char* kb_ = kp0 + (slot) + (hh) * 8192; int xk_ = xk; asm volatile("" : "+v"(xk_));     \
        _Pragma("unroll") for (int d0 = 0; d0 < 6; ++d0) kf[d0] = *(const LAS bf16x8*)(kb_ + (((2 * d0 + hi) ^ xk_) << 4)); } while (0)
#define ATT_QKM(S) do { S = __builtin_amdgcn_mfma_f32_32x32x16_bf16(kf[0], qr[0], negm, 0, 0, 0); _Pragma("unroll") for (int d0 = 1; d0 < 6; ++d0) S = __builtin_amdgcn_mfma_f32_32x32x16_bf16(kf[d0], qr[d0], S, 0, 0, 0); } while (0)
#define ATT_RMAX(S, RM) do { float a_ = max3f(S[0], S[1], S[2]), b_ = max3f(S[3], S[4], S[5]); a_ = max3f(a_, S[6], S[7]); b_ = max3f(b_, S[8], S[9]); a_ = max3f(a_, S[10], S[11]); b_ = max3f(b_, S[12], S[13]); a_ = max3f(a_, S[14], S[15]); a_ = max2f(a_, b_); \
        { const auto rr = __builtin_amdgcn_permlane32_swap(__float_as_uint(a_), __float_as_uint(a_), false, false); RM = max2f(__uint_as_float(rr[0]), __uint_as_float(rr[1])); } } while (0)
#define ATT_RESC(S, rm) do { \
        if (__any(rm > THR)) { const float dl = fmaxf(rm, 0.f), f = __builtin_amdgcn_exp2f(-dl); m_run += dl; l_run *= f; if (hi == 0) wsf[r32] = f; \
            _Pragma("unroll") for (int r = 0; r < 16; ++r) { const float fr_ = wsf[crow(r, hi)]; o[0][r] *= fr_; o[1][r] *= fr_; } \
            _Pragma("unroll") for (int r = 0; r < 16; ++r) { S[r] -= dl; negm[r] = -m_run; } } } while (0)
#define ATT_SMA(S) do { float rm_; ATT_RMAX(S, rm_); ATT_RESC(S, rm_); } while (0)
#define ATT_VLD(slot, hh) do { const LAS unsigned char* vp_ = vp0 + (slot) + (hh) * 2048; \
        _Pragma("unroll") for (int d0 = 0; d0 < 2; ++d0) _Pragma("unroll") for (int kk = 0; kk < 2; ++kk) { vl[d0 * 2 + kk] = vtr(vp_ + d0 * 4096 + kk * 1024); vh[d0 * 2 + kk] = vtr(vp_ + d0 * 4096 + kk * 1024 + 512); } } while (0)
#define ATT_VF(x) ((bf16x8){vl[x][0], vl[x][1], vl[x][2], vl[x][3], vh[x][0], vh[x][1], vh[x][2], vh[x][3]})
#define ATT_PVM(PA, PB) do { _Pragma("unroll") for (int d0 = 0; d0 < 2; ++d0) { \
            o[d0] = __builtin_amdgcn_mfma_f32_32x32x16_bf16(__builtin_bit_cast(bf16x8, PA), ATT_VF(d0 * 2), o[d0], 0, 0, 0); \
            o[d0] = __builtin_amdgcn_mfma_f32_32x32x16_bf16(__builtin_bit_cast(bf16x8, PB), ATT_VF(d0 * 2 + 1), o[d0], 0, 0, 0); } } while (0)
#define ATT_SMB(S, PA, PB) do { float sacc = 0.f; \
        _Pragma("unroll") for (int r = 0; r < 16; ++r) { S[r] = __builtin_amdgcn_exp2f(S[r]); sacc += S[r]; } \
        l_run += sacc; \
        PA = (u32x4){pk2(S[0], S[1]), pk2(S[2], S[3]), pk2(S[4], S[5]), pk2(S[6], S[7])}; PB = (u32x4){pk2(S[8], S[9]), pk2(S[10], S[11]), pk2(S[12], S[13]), pk2(S[14], S[15])}; } while (0)
#define ATT_PVH(slot, hh, PA, PB) do { const LAS unsigned char* vp_ = vp0 + (slot) + (hh) * 2048; \
        _Pragma("unroll") for (int d0 = 0; d0 < 2; ++d0) { const s16x4 l0_ = vtr(vp_ + d0 * 4096), h0_ = vtr(vp_ + d0 * 4096 + 512), l1_ = vtr(vp_ + d0 * 4096 + 1024), h1_ = vtr(vp_ + d0 * 4096 + 1536); \
            o[d0] = __builtin_amdgcn_mfma_f32_32x32x16_bf16(__builtin_bit_cast(bf16x8, PA), ((bf16x8){l0_[0], l0_[1], l0_[2], l0_[3], h0_[0], h0_[1], h0_[2], h0_[3]}), o[d0], 0, 0, 0); \
            o[d0] = __builtin_amdgcn_mfma_f32_32x32x16_bf16(__builtin_bit_cast(bf16x8, PB), ((bf16x8){l1_[0], l1_[1], l1_[2], l1_[3], h1_[0], h1_[1], h1_[2], h1_[3]}), o[d0], 0, 0, 0); } } while (0)
    ATT_DMA(0, 0); ATT_DMA(1, SLOT); if (2 < NT) ATT_DMA(2, 2 * SLOT);
    bf16x8 qr[6], kf[6];
    { const bf16* Qw = QF + (rowq0 + r32) * 768 + h * DQK + hi * 8;
#pragma unroll
        for (int d0 = 0; d0 < 6; ++d0) qr[d0] = *(const bf16x8*)(Qw + 16 * d0); }
    LAS float* wsf = (LAS float*)(F.lds + L_WS) + wid * 64;
    float m_run = 0.f, l_run = 0.f; f32x16 o[2]; o[0] = f32x16{}; o[1] = f32x16{}; f32x16 negm = f32x16{};
    const LAS unsigned char* kp0 = F.lds + r32 * 256;
    const int xk = r32 & 15;
    const LAS unsigned char* vp0 = F.lds + KSLOT + ((lane >> 4) & 1) * 32 + (lane & 3) * 8 + (4 * hi + ((lane & 15) >> 2)) * 64;
    u32x4 pw0, pw1; f32x16 sa, sb;
    ATT_BAR();
    int sl = 0, sl3 = 3 * SLOT;
#define ATT_ROT() do { sl = (sl == 3 * SLOT) ? 0 : sl + SLOT; sl3 = (sl3 == 3 * SLOT) ? 0 : sl3 + SLOT; } while (0)
#pragma unroll 1
    for (int i = 0; i < 5; ++i) {
        if (i + 3 < NT) ATT_DMA(i + 3, sl3);
        const int jb = i - 1;
#pragma unroll
        for (int hh = 0; hh < 2; ++hh) {
            const bool skip = (i == 0) ? (hh == 1) : (64 * jb + 32 * hh > 32 * wid + 31);
            if (!skip) {
                ATT_KLD(sl, hh); ATT_QKM(sa);
                if (i == 0) {
#pragma unroll
                    for (int r = 0; r < 16; ++r) if (crow(r, hi) >= NMETA) sa[r] = -INFINITY;
                } else if (64 * jb + 32 * hh + 31 > 32 * wid) {
                    const int qrel = 32 * wid + r32 - 64 * jb - 32 * hh;
#pragma unroll
                    for (int r = 0; r < 16; ++r) if (crow(r, hi) > qrel) sa[r] = -INFINITY;
                }
                ATT_SMA(sa); ATT_SMB(sa, pw0, pw1); ATT_PVH(sl, hh, pw0, pw1);
            }
        }
        ATT_BARC(i + 3 < NT); ATT_ROT();
    }
    if (NT > 5) {
        s16x4 vl[4], vh[4]; float rm;
        ATT_KLD(sl, 0); ATT_QKM(sa);
        ATT_KLD(sl, 1); __builtin_amdgcn_sched_barrier(0);
        ATT_RMAX(sa, rm); ATT_RESC(sa, rm);
        ATT_QKM(sb); ATT_SMB(sa, pw0, pw1);
        ATT_VLD(sl, 0);
#pragma unroll 1
        for (int i = 5; i < NT - 1; ++i) {
            if (i + 3 < NT) ATT_DMA(i + 3, sl3);
            const int sln = (sl == 3 * SLOT) ? 0 : sl + SLOT;
            ATT_KLD(sln, 0); __builtin_amdgcn_sched_barrier(0);
            ATT_PVM(pw0, pw1); ATT_RMAX(sb, rm);
            ATT_RESC(sb, rm);
            ATT_QKM(sa); ATT_SMB(sb, pw0, pw1);
            ATT_VLD(sl, 1);
            ATT_BARC(i + 3 < NT); ATT_ROT();
            ATT_KLD(sl, 1); __builtin_amdgcn_sched_barrier(0);
            ATT_PVM(pw0, pw1); ATT_RMAX(sa, rm);
            ATT_RESC(sa, rm);
            ATT_QKM(sb); ATT_SMB(sa, pw0, pw1);
            ATT_VLD(sl, 0);
        }
        ATT_PVM(pw0, pw1); ATT_RMAX(sb, rm);
        ATT_RESC(sb, rm);
        ATT_SMB(sb, pw0, pw1);
        ATT_VLD(sl, 1);
        ATT_PVM(pw0, pw1);
        ATT_BAR();
    }
    { const auto rr = __builtin_amdgcn_permlane32_swap(__float_as_uint(l_run), __float_as_uint(l_run), false, false); l_run = __uint_as_float(rr[0]) + __uint_as_float(rr[1]); }
    if (hi == 0) wsf[32 + r32] = l_run;
    float rli[16];
#pragma unroll
    for (int r = 0; r < 16; ++r) rli[r] = __builtin_amdgcn_rcpf(wsf[32 + crow(r, hi)]);
    { LAS bf16* stg = (LAS bf16*)(F.lds + L_OST) + wid * 2048;
#pragma unroll
        for (int r = 0; r < 16; ++r) { const int orow = crow(r, hi);
#pragma unroll
            for (int d0 = 0; d0 < 2; ++d0) stg[orow * 64 + d0 * 32 + r32] = (bf16)f2bf(o[d0][r] * rli[r]); }
        asm volatile("s_waitcnt lgkmcnt(0)" ::: "memory");
#pragma unroll
        for (int i = 0; i < 4; ++i) { const int row = i * 8 + (lane >> 3), ch = lane & 7; const u32x4 v = *(const LAS u32x4*)(stg + row * 64 + ch * 8);
            *(u32x4*)(O + (rowq0 + row) * 1024 + h * DV + ch * 8) = v; } }
    asm volatile("s_waitcnt lgkmcnt(0)\n\ts_barrier" ::: "memory");
#undef ATT_TIX
#undef ATT_DMA
#undef ATT_BAR
#undef ATT_BARC
#undef ATT_KLD
#undef ATT_QKM
#undef ATT_SMA
#undef ATT_RMAX
#undef ATT_RESC
#undef ATT_VLD
#undef ATT_VF
#undef ATT_PVM
#undef ATT_SMB
#undef ATT_PVH
#undef ATT_ROT
}
__device__ __forceinline__ void attn_phase(Ctx& F) {
    for (int v = F.vcu; v < 256; v += F.G) { const int bh = v >> 2, s = v & 3;
#pragma unroll 1
        for (int i = 0; i < 4; ++i) { const int qb = (i == 0) ? s : (i == 1) ? 7 - s : (i == 2) ? 8 + s : 15 - s; attn_unit(F, bh >> 3, bh & 7, qb); } }
}
}

__device__ __forceinline__ void p8_router(Ctx& F) {
    LAS float* xch = (LAS float*)F.lds;
    volatile LAS int* cnt_l = (volatile LAS int*)(F.lds + LDSCTL_OFF + 1024); volatile LAS int* base_l = cnt_l + 32;
    const bf16* H1 = WSP(bf16, WS_H1B);
    int* gcount = (int*)(F.ctl + CW_CNT); int* LTOK = WSP(int, WS_LTOK); float* LW = WSP(float, WS_LW); float* LRS = WSP(float, WS_LRS); int* TOKPOS = WSP(int, WS_TOKPOS);
    for (int un = F.vcu; un < MT / 128; un += F.G) {
        if (F.tid < 32) cnt_l[F.tid] = 0;
        const int j = F.lane & 31, kh = F.lane >> 5, grp = F.wave & 3, kq = F.wave >> 2; const int token = un * 128 + 32 * grp + j;
        int te[4] = {0, 0, 0, 0}, sl[4] = {0, 0, 0, 0}; float tg[4] = {0.f, 0.f, 0.f, 0.f}; float rstd = 0.f;
        f32x16 acc = f32x16{}; float ss = 0.f;
        { const bf16* row = H1 + (size_t)token * DM + 512 * kq + 32 * kh;
          const bf16* a0 = WSP(bf16, WS_RW3) + ((size_t)(64 * kq + 4 * kh) * NE + j) * 8;
#pragma unroll 4
            for (int st = 0; st < 32; ++st) { const u32x4 hw = *(const u32x4*)(row + 64 * (st >> 2) + 8 * (st & 3)); f32x4 h0, h1; unpack8(hw, h0, h1);
                ss += ((h0[0] * h0[0] + h0[1] * h0[1]) + (h0[2] * h0[2] + h0[3] * h0[3])) + ((h1[0] * h1[0] + h1[1] * h1[1]) + (h1[2] * h1[2] + h1[3] * h1[3]));
                const bf16x8 hb = __builtin_bit_cast(bf16x8, hw);
                const int ao = (8 * (st >> 2) + (st & 3)) * (NE * 8);
                const bf16x8 ah = *(const bf16x8*)(a0 + ao), am = *(const bf16x8*)(a0 + (size_t)NE * DM + ao), al = *(const bf16x8*)(a0 + (size_t)2 * NE * DM + ao);
                acc = __builtin_amdgcn_mfma_f32_32x32x16_bf16(al, hb, acc, 0, 0, 0); acc = __builtin_amdgcn_mfma_f32_32x32x16_bf16(am, hb, acc, 0, 0, 0); acc = __builtin_amdgcn_mfma_f32_32x32x16_bf16(ah, hb, acc, 0, 0, 0); } }
        if (kq == 1) { LAS float* xp = xch + grp * 17 * 64 + F.lane;
#pragma unroll
            for (int r = 0; r < 16; ++r) xp[r * 64] = acc[r];
            xp[16 * 64] = ss; }
        __syncthreads();
        if (kq == 0) {
            { const LAS float* xp = xch + grp * 17 * 64 + F.lane;
#pragma unroll
                for (int r = 0; r < 16; ++r) acc[r] += xp[r * 64];
                ss += xp[16 * 64]; }
            ss += __shfl_xor(ss, 32);
            rstd = 1.f / sqrtf(ss * (1.f / DM) + NORM_EPS);
            float cv[8]; int ci[8];
            float lv[16];
#pragma unroll
            for (int r = 0; r < 16; ++r) lv[r] = acc[r] * rstd + F.router_b[att::crow(r, kh)];
#pragma unroll
            for (int k = 0; k < 4; ++k) { float bv = -INFINITY; int bi = 0;
#pragma unroll
                for (int r = 0; r < 16; ++r) { const bool better = lv[r] > bv; bv = better ? lv[r] : bv; bi = better ? r : bi; }
#pragma unroll
                for (int r = 0; r < 16; ++r) if (r == bi) lv[r] = -INFINITY;
                cv[k] = bv; ci[k] = att::crow(bi, kh); }
#pragma unroll
            for (int k = 0; k < 4; ++k) { cv[4 + k] = __shfl_xor(cv[k], 32); ci[4 + k] = __shfl_xor(ci[k], 32); }
#pragma unroll
            for (int k = 0; k < 4; ++k) { float bv = -INFINITY; int bi = 1 << 20, bp = 0;
#pragma unroll
                for (int c = 0; c < 8; ++c) { const bool better = (cv[c] > bv) || (cv[c] == bv && ci[c] < bi); bv = better ? cv[c] : bv; bi = better ? ci[c] : bi; bp = better ? c : bp; }
#pragma unroll
                for (int c = 0; c < 8; ++c) if (c == bp) cv[c] = -INFINITY;
                tg[k] = bv; te[k] = bi; }
            { const float e1 = __expf(tg[1] - tg[0]), e2 = __expf(tg[2] - tg[0]), e3 = __expf(tg[3] - tg[0]); const float inv = 1.f / (1.f + e1 + e2 + e3); tg[0] = inv; tg[1] = e1 * inv; tg[2] = e2 * inv; tg[3] = e3 * inv; }
            if (kh == 0) {
#pragma unroll
                for (int k = 0; k < 4; ++k) sl[k] = __hip_atomic_fetch_add((LAS int*)&cnt_l[te[k]], 1, __ATOMIC_RELAXED, __HIP_MEMORY_SCOPE_WORKGROUP); }
        }
        __syncthreads();
        if (F.tid < 32) base_l[F.tid] = atomicAdd(gcount + F.tid, cnt_l[F.tid]);
        __syncthreads();
        if (kq == 0 && kh == 0) {
#pragma unroll
            for (int k = 0; k < 4; ++k) { const int slot = base_l[te[k]] + sl[k]; const size_t li = (size_t)te[k] * ECAP + slot;
                LTOK[li] = token; LW[li] = tg[k]; LRS[li] = rstd; TOKPOS[token * 4 + k] = te[k] * ECAP + slot; } }
        __syncthreads();
    }
}

__device__ __forceinline__ void moe_table(Ctx& F) {
    volatile LAS int* tb = (volatile LAS int*)(F.lds + LDSCTL_OFF); volatile LAS int* cnt = (volatile LAS int*)(F.lds + LDSCTL_OFF + 256);
    if (F.tid < 64) { const int* gcount = (const int*)(F.ctl + CW_CNT); const int c = (F.lane < NE) ? gcount[F.lane] : 0; const int nt = (c + 255) >> 8;
        int incl = nt;
#pragma unroll
        for (int o = 1; o < 32; o <<= 1) { const int v = __shfl_up(incl, o); if ((F.lane & 31) >= o) incl += v; }
        if (F.lane < NE) { cnt[F.lane] = c; tb[F.lane] = incl - nt; if (F.lane == NE - 1) tb[NE] = incl; } }
    __syncthreads();
    { const int TT = tb[NE];
      for (int mt = F.tid; mt < TT; mt += 512) { int e = 0;
#pragma unroll
          for (int st = 16; st >= 1; st >>= 1) if (e + st < NE && tb[e + st] <= mt) e += st;
          tb[512 + mt] = e; } }
    __syncthreads();
}

__device__ __forceinline__ void p11_combine(Ctx& F) {
    const volatile LAS int* tb = (const volatile LAS int*)(F.lds + LDSCTL_OFF);
    const int gw = F.vcu * 8 + F.wave, NGW = F.G * 8;
    const bf16* H1 = WSP(bf16, WS_H1B); const unsigned char* Y = WSP(unsigned char, WS_Y); const int* TOKPOS = WSP(int, WS_TOKPOS);
    typedef int i32x4v __attribute__((ext_vector_type(4)));
    const i32x4v* TP4 = (const i32x4v*)TOKPOS;
    i32x4v tp[2]; { const int m0 = gw, m1 = gw + NGW; tp[0] = TP4[m0 < MT ? m0 : 0]; tp[1] = TP4[m1 < MT ? m1 : 0]; }
    for (int mb = gw; mb < MT; mb += 2 * NGW) {
        i32x4v tn[2]; { const int n0 = mb + 2 * NGW, n1 = mb + 3 * NGW; tn[0] = TP4[n0 < MT ? n0 : 0]; tn[1] = TP4[n1 < MT ? n1 : 0]; }
        u32x4 hw[2][2], yw[2][4];
#pragma unroll
        for (int q = 0; q < 2; ++q) { const int m = mb + q * NGW; const int mm = m < MT ? m : mb;
            const u32x4* hp = (const u32x4*)(H1 + (size_t)mm * DM + 16 * F.lane); hw[q][0] = __builtin_nontemporal_load(hp); hw[q][1] = __builtin_nontemporal_load(hp + 1);
#pragma unroll
            for (int k = 0; k < 4; ++k) { const int p = tp[q][k], e = p >> 15, slot = p & (ECAP - 1); const size_t yr = (size_t)tb[e] * 256 + slot;
                yw[q][k] = __builtin_nontemporal_load((const u32x4*)(Y + yr * DM + 16 * F.lane)); } }
#pragma unroll
        for (int q = 0; q < 2; ++q) { const int m = mb + q * NGW; if (m < MT) {
            f32x4 a0, a1, a2, a3; unpack8(hw[q][0], a0, a1); unpack8(hw[q][1], a2, a3);
            f32x4 s0 = {0.f, 0.f, 0.f, 0.f}, s1 = s0, s2 = s0, s3 = s0;
#pragma unroll
            for (int k = 0; k < 4; ++k) { const u32x4 y = yw[q][k];
                { const f32x2 p0 = __builtin_amdgcn_cvt_pk_f32_fp8((int)y.x, false), p1 = __builtin_amdgcn_cvt_pk_f32_fp8((int)y.x, true); s0[0] += p0[0]; s0[1] += p0[1]; s0[2] += p1[0]; s0[3] += p1[1]; }
                { const f32x2 p0 = __builtin_amdgcn_cvt_pk_f32_fp8((int)y.y, false), p1 = __builtin_amdgcn_cvt_pk_f32_fp8((int)y.y, true); s1[0] += p0[0]; s1[1] += p0[1]; s1[2] += p1[0]; s1[3] += p1[1]; }
                { const f32x2 p0 = __builtin_amdgcn_cvt_pk_f32_fp8((int)y.z, false), p1 = __builtin_amdgcn_cvt_pk_f32_fp8((int)y.z, true); s2[0] += p0[0]; s2[1] += p0[1]; s2[2] += p1[0]; s2[3] += p1[1]; }
                { const f32x2 p0 = __builtin_amdgcn_cvt_pk_f32_fp8((int)y.w, false), p1 = __builtin_amdgcn_cvt_pk_f32_fp8((int)y.w, true); s3[0] += p0[0]; s3[1] += p0[1]; s3[2] += p1[0]; s3[3] += p1[1]; } }
            a0 += s0 * Y8_INV; a1 += s1 * Y8_INV; a2 += s2 * Y8_INV; a3 += s3 * Y8_INV;
            f32x4* op = (f32x4*)(F.out + (size_t)m * DM + 16 * F.lane); op[0] = a0; op[1] = a1; op[2] = a2; op[3] = a3; } }
        tp[0] = tn[0]; tp[1] = tn[1];
    }
}

#define LDS_TB ((const volatile LAS int*)(F.lds + LDSCTL_OFF))
#define LDS_CNT ((const volatile LAS int*)(F.lds + LDSCTL_OFF + 256))
__device__ __forceinline__ void ph1_inproj(Ctx& F) { p1_meta(F);
    pg8::Dense P; P.init(WSP(bf16, INPROJ_FP8 ? WS_XQ : WS_XN), WSP(bf16, WS_WIN), MT, NINP, INPROJ_FP8 ? DM / 2 : DM, F.G, (int)blockIdx.x);
    EpiInProj E{WSP(bf16, WS_HG), WSP(bf16, WS_QLAT), WSP(bf16, WS_KVLAT), WSP(bf16, WS_G), WSP(bf16, WS_G) + (size_t)MT * 1024, F.gate_b, WSP(float, WS_KPESS), WSP(float, WS_RSX), WSP(float, WS_RSQ), WSP(float, WS_RSC)};
    pg8::gemm_phase<pg8::Dense, EpiInProj, INPROJ_FP8 != 0>(F.lds, P, E); }
#ifndef PROBE_P3
#define PROBE_P3 0
#endif
__device__ __forceinline__ void ph3_smallgemms(Ctx& F) { p2_thin(F); p4_headnorm(F);
#if PROBE_P3 == 1
    __syncthreads(); p2_thin(F); p4_headnorm(F);
#endif
    { pg8::Dense P; P.init(WSP(bf16, WS_QLAT), WSP(bf16, WS_WQB), MT, 1024, 256, F.G, (int)blockIdx.x); EpiQHead E{WSP(bf16, WS_QF), WSP(float, WS_RSQ), F.q_nw, WSP(float, WS_ROPE), F.lds}; pg8::gemm_phase(F.lds, P, E); }
    { pg8::Dense P; P.init(WSP(bf16, WS_KVLAT), WSP(bf16, WS_WKVB), MT, 1024, KVLR, F.G, (int)blockIdx.x, 256); EpiKVHead E{WSP(bf16, WS_KF), WSP(bf16, WS_KVRAW), WSP(bf16, WS_KVLAT), WSP(float, WS_RSC), WSP(float, WS_KPESS), F.k_nw, WSP(float, WS_ROPE), F.lds}; pg8::gemm_phase(F.lds, P, E); }
 }
__device__ __forceinline__ void ph6_wo(Ctx& F) { pg8::Dense P; P.init(WSP(bf16, WS_HCO), WSP(bf16, WS_W2T), MT, 1024, 1024, F.G, (int)blockIdx.x); EpiMix E{WSP(bf16, WS_MIX), WSP(bf16, WS_G), WSP(bf16, WS_G) + (size_t)MT * 1024}; pg8::gemm_phase<pg8::Dense, EpiMix, false, true>(F.lds, P, E); }
__device__ __forceinline__ void ph7_wout(Ctx& F) { pg8::Dense P; P.init(WSP(bf16, WS_MIX), WSP(bf16, WS_WOUT), MT, 1024, 1024, F.G, (int)blockIdx.x); EpiResid E{WSP(bf16, WS_XN), WSP(bf16, WS_H1B), WSP(unsigned char, WS_H1Q)}; pg8::gemm_phase<pg8::Dense, EpiResid, false, true>(F.lds, P, E); }
__device__ __forceinline__ void ph9_moe1(Ctx& F) { moe_table(F);
    pg8::Moe<true> P{WSP(bf16, WS_H1Q), WSP(bf16, WS_WGU), DM / 2, 8, F.G, F.vcu, WSP(int, WS_LTOK), LDS_TB, LDS_CNT};
    EpiSwiGLU E{WSP(unsigned char, WS_ACT), F.b_gu, WSP(float, WS_LRS), LDS_TB}; pg8::gemm_phase<pg8::Moe<true>, EpiSwiGLU, true>(F.lds, P, E); }
__device__ __forceinline__ void ph10_moe2(Ctx& F) {
#if !MK_ONE_LAUNCH
    moe_table(F);
#endif
    pg8::Moe<false> P{WSP(bf16, WS_ACT), WSP(bf16, WS_WD), DFF / 2, 4, F.G, F.vcu, nullptr, LDS_TB, LDS_CNT};
    EpiDown E{WSP(unsigned char, WS_Y), F.b_d, WSP(float, WS_LW), LDS_TB}; pg8::gemm_phase<pg8::Moe<false>, EpiDown, true, true>(F.lds, P, E); }
__device__ __forceinline__ void ph11_combine(Ctx& F) {
#if !MK_ONE_LAUNCH
    moe_table(F);
#endif
    p11_combine(F); }

struct Args { const float* in[25]; float* out; unsigned char* ws; int ph_lo, ph_hi; };
__global__ void __launch_bounds__(512, 2) mk_fwd(Args args) {
    extern __shared__ __attribute__((aligned(16))) unsigned char lds_raw[];
    Ctx F;
    F.lds = (LAS unsigned char*)lds_raw; F.ws = args.ws; F.ctl = (gu32*)(args.ws + WS_CTL);
    F.tid = threadIdx.x; F.lane = F.tid & 63; F.wave = __builtin_amdgcn_readfirstlane(F.tid >> 6);
    F.G = gridDim.x; { const int bx = blockIdx.x; F.vcu = (F.G % 8 == 0) ? (bx % 8) * (F.G / 8) + bx / 8 : bx; }
    F.x = args.in[0]; F.meta = args.in[1]; F.attn_nw = args.in[2]; F.w_in = args.in[3]; F.dw_w = args.in[4]; F.dw_b = args.in[5]; F.ln_w = args.in[6]; F.ln_b = args.in[7]; F.pw2_w = args.in[8];
    F.qa_nw = args.in[9]; F.w_qb = args.in[10]; F.kva_nw = args.in[11]; F.w_kvb = args.in[12]; F.q_nw = args.in[13]; F.k_nw = args.in[14]; F.w_o = args.in[15]; F.gate_b = args.in[16]; F.w_out = args.in[17];
    F.ffn_nw = args.in[18]; F.router_w = args.in[19]; F.router_b = args.in[20]; F.w_gu = args.in[21]; F.b_gu = args.in[22]; F.w_d = args.in[23]; F.b_d = args.in[24]; F.out = args.out;
    for (int u = F.tid; u < (LDS_BYTES - LDSCTL_OFF) / 4; u += 512) ((LAS unsigned*)(F.lds + LDSCTL_OFF))[u] = 0u;
    __syncthreads();
    const int lo = args.ph_lo, hi = args.ph_hi;
    XcdBarrier bar; bar.bar = (unsigned*)(F.ctl + CW_BAR); bar.x = 0; bar.st = nullptr;
    if (hi - lo > 1) bar = xcd_barrier_post((unsigned*)(F.ctl + CW_BAR), (volatile LAS unsigned*)(F.lds + LDSCTL_OFF + 512));
#ifdef ONLY_PHASE
#define IN(k) ((k) == ONLY_PHASE && lo <= (k) && (k) < hi)
#else
#define IN(k) (lo <= (k) && (k) < hi)
#endif
#define SEAM(k) do { if (IN(k) && IN((k) + 1)) xcd_barrier(bar); } while (0)
#if USE_REFRESH
#define REFRESH() do { int _t = threadIdx.x; asm volatile("" : "+v"(_t)); F.tid = _t; F.lane = _t & 63; F.wave = __builtin_amdgcn_readfirstlane(_t >> 6); } while (0)
#else
#define REFRESH() do { } while (0)
#endif
#define PHASE(k, call) do { if (IN(k)) { REFRESH(); call; if (PROBE_REPEAT == (k)) { xcd_barrier(bar); call; } } SEAM(k); } while (0)

    PHASE(0, p0_prologue(F));
    PHASE(1, ph1_inproj(F));
    PHASE(3, ph3_smallgemms(F));
    PHASE(5, att::attn_phase(F));
    PHASE(6, ph6_wo(F));
    PHASE(7, ph7_wout(F));
#if PROBE_REPEAT == 8
    if (IN(8)) { REFRESH(); p8_router(F); xcd_barrier(bar); if (blockIdx.x == 0 && F.tid < NE) ((int*)(F.ctl + CW_CNT))[F.tid] = 0; xcd_barrier(bar); p8_router(F); } SEAM(8);
#else
    PHASE(8, p8_router(F));
#endif
    PHASE(9, ph9_moe1(F));
    PHASE(10, ph10_moe2(F));
    PHASE(11, ph11_combine(F));
#undef IN
#undef SEAM
#undef PHASE
}

extern "C" void kernel_launch(void* const* d_in, const int* in_sizes, int n_in, void* d_out, int out_size, void* d_ws, size_t ws_size, hipStream_t stream) {
    static int grid = 0;
    if (grid == 0) {
        if (n_in != 25 || in_sizes[0] != MT * DM || out_size != MT * DM || ws_size < WS_END) { fprintf(stderr, "kernel_launch: unexpected shapes (n_in %d, in0 %d, out %d, ws %zu < %zu); nothing launched\n", n_in, n_in > 0 ? in_sizes[0] : -1, out_size, ws_size, (size_t)WS_END); grid = -1; return; }
        int dev = 0, cus = 0, per_cu = 0;
        if (hipGetDevice(&dev) != hipSuccess || hipDeviceGetAttribute(&cus, hipDeviceAttributeMultiprocessorCount, dev) != hipSuccess) { grid = -1; return; }
        if (hipFuncSetAttribute((const void*)mk_fwd, hipFuncAttributeMaxDynamicSharedMemorySize, LDS_BYTES) != hipSuccess) { fprintf(stderr, "kernel_launch: hipFuncSetAttribute failed\n"); grid = -1; return; }
        if (hipOccupancyMaxActiveBlocksPerMultiprocessor(&per_cu, (const void*)mk_fwd, 512, LDS_BYTES) != hipSuccess || per_cu < 1) fprintf(stderr, "kernel_launch: note: occupancy query reports %d\n", per_cu);
        (void)hipGetLastError();
        grid = cus;
    }
    if (grid < 0) return;
    if (hipMemsetAsync((char*)d_ws + WS_CTL, 0, CTL_ZERO_BYTES, stream) != hipSuccess) return;
    Args a{};
    for (int i = 0; i < 25; ++i) a.in[i] = (const float*)d_in[i];
    a.out = (float*)d_out; a.ws = (unsigned char*)d_ws;
#if MK_ONE_LAUNCH
    a.ph_lo = 0; a.ph_hi = NPH;
    hipLaunchKernelGGL(mk_fwd, dim3(grid), dim3(512), LDS_BYTES, stream, a);
#else
    for (int p = 0; p < NPH; ++p) { a.ph_lo = p; a.ph_hi = p + 1; hipLaunchKernelGGL(mk_fwd, dim3(grid), dim3(512), LDS_BYTES, stream, a); }
#endif
}
```
